# Optimizing an MI355X kernel written in HIP

```python
import jax
import jax.numpy as jnp
from jax import lax
import numpy as np

D_MODEL = 2048
BATCH = 2
SEQ = 4096
DEPTH = 4
DEC_BATCH = 16
DEC_SEQ = 32
PAST_LEN = 1024

CHUNK = 64
N_MIXERS = 3
N_A = (DEPTH + 2) // 3
N_B = (DEPTH + 1) // 3
N_C = DEPTH // 3
D_FF = 4 * D_MODEL
H_A = 16
DH_A = D_MODEL // H_A
LEFT_CHUNKS = 8
REL_CLIP = 128
H_B = 16
KV_B = 4
DH_B = D_MODEL // H_B
H_IDX = 16
D_IDX = 64
TOPK_MAX = 256
Q_BLOCK = 128
B_SIZES = (H_B * DH_B, KV_B * DH_B, KV_B * DH_B, H_IDX * D_IDX, D_IDX, H_IDX)
B_IN_DIM = sum(B_SIZES)
HK_C = 16
HV_C = 32
DK_C = 128
DV_C = 128
CONV_W = 4
C_QK_DIM = HK_C * DK_C
C_V_DIM = HV_C * DV_C
C_CONV_DIM = 2 * C_QK_DIM + C_V_DIM
C_IN_DIM = C_CONV_DIM + C_V_DIM + 2 * HV_C
ALPHA = (2.0 * DEPTH) ** 0.25
BETA_INIT = (8.0 * DEPTH) ** -0.25
LN_EPS = 1e-5
RMS_EPS = 1e-6

kernel_name = 'hybrid_streaming_encoder_step'


def _split(y, sizes):
    out, off = [], 0
    for s in sizes:
        out.append(y[..., off:off + s])
        off += s
    return out


def _layer_norm(x, g, b):
    xf = x.astype(jnp.float32)
    mu = jnp.mean(xf, axis=-1, keepdims=True)
    var = jnp.mean(jnp.square(xf - mu), axis=-1, keepdims=True)
    return ((xf - mu) * lax.rsqrt(var + LN_EPS)).astype(x.dtype) * g + b


def _sq_relu_mlp(x, w1, w2):
    h = jax.nn.relu(x @ w1)
    return (h * h) @ w2


def _band_attention(q, k, v, q_pos, k_pos, rel_bias):
    s = jnp.einsum('bqhd,bkhd->bhqk', q, k, preferred_element_type=jnp.float32) * (DH_A ** -0.5)
    rel = jnp.clip(q_pos[:, None] - k_pos[None, :], -REL_CLIP, REL_CLIP) + REL_CLIP
    s = s + rel_bias[:, rel].astype(jnp.float32)[None]
    q_chunk = q_pos // CHUNK
    k_chunk = k_pos // CHUNK
    visible = ((k_pos[None, :] >= 0)
               & (k_chunk[None, :] <= q_chunk[:, None])
               & (k_chunk[None, :] >= q_chunk[:, None] - LEFT_CHUNKS))
    s = jnp.where(visible[None, None], s, -jnp.inf)
    p = jax.nn.softmax(s, axis=-1)
    return jnp.einsum('bhqk,bkhd->bqhd', p.astype(v.dtype), v)


def _a_project(x, w_in):
    B, T, _ = x.shape
    q, k, v = _split(x @ w_in, (D_MODEL, D_MODEL, D_MODEL))
    return (q.reshape(B, T, H_A, DH_A), k.reshape(B, T, H_A, DH_A), v.reshape(B, T, H_A, DH_A))


def _mixer_a_prompt(x, w_in, rel_bias, w_out):
    B, T, _ = x.shape
    q, k, v = _a_project(x, w_in)
    pad = LEFT_CHUNKS * CHUNK
    band = pad + CHUNK
    kp = jnp.pad(k, ((0, 0), (pad, 0), (0, 0), (0, 0)))
    vp = jnp.pad(v, ((0, 0), (pad, 0), (0, 0), (0, 0)))

    def one_chunk(c):
        start = c * CHUNK
        q_c = lax.dynamic_slice_in_dim(q, start, CHUNK, axis=1)
        k_c = lax.dynamic_slice_in_dim(kp, start, band, axis=1)
        v_c = lax.dynamic_slice_in_dim(vp, start, band, axis=1)
        q_pos = start + jnp.arange(CHUNK)
        k_pos = start - pad + jnp.arange(band)
        return _band_attention(q_c, k_c, v_c, q_pos, k_pos, rel_bias)

    o = lax.map(one_chunk, jnp.arange(T // CHUNK))
    o = jnp.moveaxis(o, 0, 1).reshape(B, T, D_MODEL)
    keep = min(pad, T)
    return o @ w_out, k[:, T - keep:], v[:, T - keep:]


def _mixer_a_sample(x, k_cache, v_cache, w_in, rel_bias, w_out):
    B, S, _ = x.shape
    past = k_cache.shape[1]
    q, k, v = _a_project(x, w_in)
    kk = jnp.concatenate([k_cache, k], axis=1)
    vv = jnp.concatenate([v_cache, v], axis=1)
    q_pos = PAST_LEN + jnp.arange(S)
    k_pos = PAST_LEN - past + jnp.arange(past + S)
    o = _band_attention(q, kk, vv, q_pos, k_pos, rel_bias)
    return o.reshape(B, S, D_MODEL) @ w_out, k, v


def _b_project(x, w_in):
    B, T, _ = x.shape
    q, k, v, qi, ki, wi = _split(x @ w_in, B_SIZES)
    return (q.reshape(B, T, H_B, DH_B), k.reshape(B, T, KV_B, DH_B), v.reshape(B, T, KV_B, DH_B),
            qi.reshape(B, T, H_IDX, D_IDX), ki, wi)


def _dsa_attend(q, qi, wi, q_pos, k_all, v_all, ki_all, n_sel):
    B, Tq = q.shape[0], q.shape[1]
    L = k_all.shape[1]
    k_pos = jnp.arange(L)
    logits = jnp.einsum('bqhd,bsd->bqhs', qi, ki_all, preferred_element_type=jnp.float32) * (D_IDX ** -0.5)
    score = jnp.einsum('bqh,bqhs->bqs', wi.astype(jnp.float32) * (H_IDX ** -0.5), jax.nn.relu(logits))
    admissible = (k_pos[None, :] // CHUNK) <= (q_pos[:, None] // CHUNK)
    score = jnp.where(admissible[None], score, -jnp.inf)
    top_val, top_idx = lax.top_k(score, n_sel)
    sel_ok = jnp.isfinite(top_val)
    gather = jax.vmap(lambda rows, idx: rows[idx])
    k_sel = gather(k_all, top_idx)
    v_sel = gather(v_all, top_idx)
    qg = q.reshape(B, Tq, KV_B, H_B // KV_B, DH_B)
    s = jnp.einsum('bqhgd,bqshd->bqhgs', qg, k_sel, preferred_element_type=jnp.float32) * (DH_B ** -0.5)
    s = jnp.where(sel_ok[:, :, None, None, :], s, -jnp.inf)
    p = jax.nn.softmax(s, axis=-1)
    o = jnp.einsum('bqhgs,bqshd->bqhgd', p.astype(v_sel.dtype), v_sel)
    return o.reshape(B, Tq, H_B * DH_B)


def _mixer_b_prompt(x, w_in, w_out):
    B, T, _ = x.shape
    q, k, v, qi, ki, wi = _b_project(x, w_in)
    n_sel = min(TOPK_MAX, T // 4)

    def one_block(c):
        start = c * Q_BLOCK
        sl = lambda a: lax.dynamic_slice_in_dim(a, start, Q_BLOCK, axis=1)
        return _dsa_attend(sl(q), sl(qi), sl(wi), start + jnp.arange(Q_BLOCK), k, v, ki, n_sel)

    o = lax.map(one_block, jnp.arange(T // Q_BLOCK))
    o = jnp.moveaxis(o, 0, 1).reshape(B, T, D_MODEL)
    return o @ w_out, k, v, ki


def _mixer_b_sample(x, k_cache, v_cache, ki_cache, w_in, w_out):
    B, S, _ = x.shape
    q, k, v, qi, ki, wi = _b_project(x, w_in)
    kk = jnp.concatenate([k_cache, k], axis=1)
    vv = jnp.concatenate([v_cache, v], axis=1)
    kki = jnp.concatenate([ki_cache, ki], axis=1)
    n_sel = min(TOPK_MAX, kk.shape[1] // 4)
    o = _dsa_attend(q, qi, wi, PAST_LEN + jnp.arange(S), kk, vv, kki, n_sel)
    return o @ w_out, k, v, ki


def _causal_conv_silu(u, buf, w):
    T = u.shape[1]
    ext = jnp.concatenate([buf, u], axis=1)
    out = ext[:, 0:T] * w[0]
    for j in range(1, CONV_W):
        out = out + ext[:, j:j + T] * w[j]
    return jax.nn.silu(out), ext[:, ext.shape[1] - (CONV_W - 1):]


def _l2norm(a):
    af = a.astype(jnp.float32)
    return af * lax.rsqrt(jnp.sum(af * af, axis=-1, keepdims=True) + RMS_EPS)


def _gated_delta_rule(q, k, v, g, beta, s0):
    B, T, H, DK = q.shape
    DV = v.shape[-1]
    C = min(CHUNK, T)
    n = T // C

    def chunks(a):
        return jnp.moveaxis(a.reshape((B, n, C) + a.shape[2:]), 1, 0)

    incl = jnp.tril(jnp.ones((C, C), dtype=bool))
    strict = jnp.tril(jnp.ones((C, C), dtype=bool), k=-1)

    def step(S, blk):
        qc, kc, vc, gc, bc = blk
        qh = qc.transpose(0, 2, 1, 3)
        kh = kc.transpose(0, 2, 1, 3)
        vh = vc.transpose(0, 2, 1, 3)
        G = jnp.cumsum(gc.transpose(0, 2, 1), axis=-1)
        bh = bc.transpose(0, 2, 1)[..., None]
        diff = G[..., :, None] - G[..., None, :]
        d_incl = jnp.exp(jnp.where(incl, diff, -jnp.inf))
        d_strict = jnp.where(strict, d_incl, 0.0)
        kb = kh * bh
        m = jnp.einsum('bhid,bhjd->bhij', kb, kh) * d_strict
        rhs = jnp.concatenate([vh * bh, kb * jnp.exp(G)[..., None]], axis=-1)
        sol = lax.linalg.triangular_solve(m + jnp.eye(C, dtype=m.dtype), rhs,
                                          left_side=True, lower=True, unit_diagonal=True)
        u = sol[..., :DV] - sol[..., DV:] @ S
        o = (qh * jnp.exp(G)[..., None]) @ S + (jnp.einsum('bhid,bhjd->bhij', qh, kh) * d_incl) @ u
        g_last = G[..., -1:]
        S = S * jnp.exp(g_last)[..., None] + jnp.einsum(
            'bhcd,bhce->bhde', kh * jnp.exp(g_last - G)[..., None], u)
        return S, o.transpose(0, 2, 1, 3)

    S, o = lax.scan(step, s0, (chunks(q), chunks(k), chunks(v), chunks(g), chunks(beta)))
    return jnp.moveaxis(o, 0, 1).reshape(B, T, H, DV), S


def _mixer_c(x, conv_buf, s0, w_in, conv_w, a_log, dt_bias, norm_w, w_out):
    B, T, _ = x.shape
    qkv, z, b_raw, a_raw = _split(x @ w_in, (C_CONV_DIM, C_V_DIM, HV_C, HV_C))
    qkv, new_buf = _causal_conv_silu(qkv, conv_buf, conv_w)
    q, k, v = _split(qkv, (C_QK_DIM, C_QK_DIM, C_V_DIM))
    rep = HV_C // HK_C
    q = jnp.repeat(_l2norm(q.reshape(B, T, HK_C, DK_C)) * (DK_C ** -0.5), rep, axis=2)
    k = jnp.repeat(_l2norm(k.reshape(B, T, HK_C, DK_C)), rep, axis=2)
    v = v.reshape(B, T, HV_C, DV_C).astype(jnp.float32)
    beta = jax.nn.sigmoid(b_raw.astype(jnp.float32))
    g = -jnp.exp(a_log.astype(jnp.float32)) * jax.nn.softplus(a_raw.astype(jnp.float32) + dt_bias.astype(jnp.float32))
    o, s_new = _gated_delta_rule(q, k, v, g, beta, s0.astype(jnp.float32))
    o = o * lax.rsqrt(jnp.mean(o * o, axis=-1, keepdims=True) + RMS_EPS) * norm_w.astype(jnp.float32)
    o = o * jax.nn.silu(z.reshape(B, T, HV_C, DV_C).astype(jnp.float32))
    return o.astype(x.dtype).reshape(B, T, C_V_DIM) @ w_out, new_buf, s_new


def setup_inputs(seed: int = 0) -> dict:
    key = jax.random.key(seed)
    ks = jax.random.split(key, 26)
    f32 = jnp.float32

    def nrm(i, shape, scale):
        return scale * jax.random.normal(ks[i], shape, f32)

    a_band = min(LEFT_CHUNKS * CHUNK, PAST_LEN)
    return {
        'x_prompt': nrm(0, (BATCH, SEQ, D_MODEL), 1.0),
        'x_sample': nrm(1, (DEC_BATCH, DEC_SEQ, D_MODEL), 1.0),
        'cache_a_k': nrm(2, (N_A, DEC_BATCH, a_band, H_A, DH_A), 1.0),
        'cache_a_v': nrm(3, (N_A, DEC_BATCH, a_band, H_A, DH_A), 1.0),
        'cache_b_k': nrm(4, (N_B, DEC_BATCH, PAST_LEN, KV_B, DH_B), 1.0),
        'cache_b_v': nrm(5, (N_B, DEC_BATCH, PAST_LEN, KV_B, DH_B), 1.0),
        'cache_b_kidx': nrm(6, (N_B, DEC_BATCH, PAST_LEN, D_IDX), 1.0),
        'state_c_conv': nrm(7, (N_C, DEC_BATCH, CONV_W - 1, C_CONV_DIM), 1.0),
        'state_c_ssm': nrm(8, (N_C, DEC_BATCH, HV_C, DK_C, DV_C), 0.1),
        'a_w_in': nrm(9, (N_A, D_MODEL, 3 * D_MODEL), D_MODEL ** -0.5),
        'a_rel_bias': nrm(10, (N_A, H_A, 2 * REL_CLIP + 1), 0.2),
        'a_w_out': nrm(11, (N_A, D_MODEL, D_MODEL), BETA_INIT * D_MODEL ** -0.5),
        'b_w_in': nrm(12, (N_B, D_MODEL, B_IN_DIM), D_MODEL ** -0.5),
        'b_w_out': nrm(13, (N_B, D_MODEL, D_MODEL), BETA_INIT * D_MODEL ** -0.5),
        'c_w_in': nrm(14, (N_C, D_MODEL, C_IN_DIM), D_MODEL ** -0.5),
        'c_conv_w': nrm(15, (N_C, CONV_W, C_CONV_DIM), CONV_W ** -0.5),
        'c_a_log': jnp.log(jax.random.uniform(ks[16], (N_C, HV_C), f32, minval=1.0, maxval=16.0)),
        'c_dt_bias': nrm(17, (N_C, HV_C), 0.1),
        'c_norm_w': 1.0 + nrm(18, (N_C, DV_C), 0.05),
        'c_w_out': nrm(19, (N_C, C_V_DIM, D_MODEL), BETA_INIT * C_V_DIM ** -0.5),
        'ln1_g': 1.0 + nrm(20, (DEPTH, D_MODEL), 0.05),
        'ln1_b': nrm(21, (DEPTH, D_MODEL), 0.02),
        'mlp_w1': nrm(22, (DEPTH, D_MODEL, D_FF), D_MODEL ** -0.5),
        'mlp_w2': nrm(23, (DEPTH, D_FF, D_MODEL), BETA_INIT * D_FF ** -0.5),
        'ln2_g': 1.0 + nrm(24, (DEPTH, D_MODEL), 0.05),
        'ln2_b': nrm(25, (DEPTH, D_MODEL), 0.02),
    }


def reference(x_prompt, x_sample, cache_a_k, cache_a_v, cache_b_k, cache_b_v, cache_b_kidx,
              state_c_conv, state_c_ssm, a_w_in, a_rel_bias, a_w_out, b_w_in, b_w_out,
              c_w_in, c_conv_w, c_a_log, c_dt_bias, c_norm_w, c_w_out,
              ln1_g, ln1_b, mlp_w1, mlp_w2, ln2_g, ln2_b):
    yp, ys = x_prompt, x_sample
    akp, avp, aks, avs = [], [], [], []
    bkp, bvp, bip, bks, bvs, bis = [], [], [], [], [], []
    ccp, csp, ccs, css = [], [], [], []
    for i in range(DEPTH):
        kind, j = i % N_MIXERS, i // N_MIXERS
        if kind == 0:
            mp, k_, v_ = _mixer_a_prompt(yp, a_w_in[j], a_rel_bias[j], a_w_out[j])
            akp.append(k_)
            avp.append(v_)
            ms, k_, v_ = _mixer_a_sample(ys, cache_a_k[j], cache_a_v[j], a_w_in[j], a_rel_bias[j], a_w_out[j])
            aks.append(k_)
            avs.append(v_)
        elif kind == 1:
            mp, k_, v_, ki_ = _mixer_b_prompt(yp, b_w_in[j], b_w_out[j])
            bkp.append(k_)
            bvp.append(v_)
            bip.append(ki_)
            ms, k_, v_, ki_ = _mixer_b_sample(ys, cache_b_k[j], cache_b_v[j], cache_b_kidx[j], b_w_in[j], b_w_out[j])
            bks.append(k_)
            bvs.append(v_)
            bis.append(ki_)
        else:
            nb = yp.shape[0]
            buf0 = jnp.zeros((nb, CONV_W - 1, C_CONV_DIM), yp.dtype)
            st0 = jnp.zeros((nb, HV_C, DK_C, DV_C), jnp.float32)
            mp, cb_, st_ = _mixer_c(yp, buf0, st0, c_w_in[j], c_conv_w[j], c_a_log[j], c_dt_bias[j], c_norm_w[j], c_w_out[j])
            ccp.append(cb_)
            csp.append(st_)
            ms, cb_, st_ = _mixer_c(ys, state_c_conv[j], state_c_ssm[j], c_w_in[j], c_conv_w[j], c_a_log[j], c_dt_bias[j], c_norm_w[j], c_w_out[j])
            ccs.append(cb_)
            css.append(st_)
        yp = _layer_norm(ALPHA * yp + mp, ln1_g[i], ln1_b[i])
        ys = _layer_norm(ALPHA * ys + ms, ln1_g[i], ln1_b[i])
        yp = _layer_norm(ALPHA * yp + _sq_relu_mlp(yp, mlp_w1[i], mlp_w2[i]), ln2_g[i], ln2_b[i])
        ys = _layer_norm(ALPHA * ys + _sq_relu_mlp(ys, mlp_w1[i], mlp_w2[i]), ln2_g[i], ln2_b[i])
    return (yp, ys,
            jnp.stack(akp), jnp.stack(avp), jnp.stack(aks), jnp.stack(avs),
            jnp.stack(bkp), jnp.stack(bvp), jnp.stack(bip), jnp.stack(bks), jnp.stack(bvs), jnp.stack(bis),
            jnp.stack(ccp), jnp.stack(csp), jnp.stack(ccs), jnp.stack(css))
```

```cpp
#include <hip/hip_runtime.h>
#include <cstdio>
#include <cstdint>
namespace pg8 {
#define PG8_LAS __attribute__((address_space(3)))
typedef unsigned short bf16_t;
typedef short bf16x8 __attribute__((ext_vector_type(8)));
typedef float f32x4 __attribute__((ext_vector_type(4)));
typedef unsigned u32x4 __attribute__((ext_vector_type(4)));
constexpr int BM = 256, BK = 64, HALF = 128, HTB = HALF * BK * 2  , STAGE_BYTES = 8 * HTB, NXCD = 8, WGM = 8;

__host__ __device__ __forceinline__ int lds_byte(int r, int c) { const int st = (r >> 4) * 2 + (c >> 5), rr = r & 15, cc = c & 31, ob = rr * 64 + cc * 2; return st * 1024 + (ob ^ (((ob >> 9) & 1) << 5)); }
__host__ __device__ __forceinline__ void stage_rc(int b, int& R, int& C) { const int st = b / 1024, sb = b % 1024, swz = sb ^ (((sb >> 9) & 1) << 5); R = (st >> 1) * 16 + swz / 64; C = (st & 1) * 32 + (swz % 64) / 2; }
__host__ __device__ __forceinline__ int perm32(int rho) { const int n = rho >> 4, i = rho & 15; return 8 * (i >> 2) + 4 * n + (i & 3); }

struct Unit { int pm, pn, k0, nt, ks; };
struct Gemm { const bf16_t* A; const bf16_t* Bt; int M, N, K; };

struct StaticOrder {
    int nM, nN, nwg, G, c, Kt;
    __host__ __device__ void init(int M, int N, int G_, int c_, int K_) { nM = M / BM; nN = N / BM; nwg = nM * nN; G = G_; c = c_; Kt = K_ / BK; }
    __host__ __device__ bool next(int i, Unit& u) const {
        const long L = (long)i * G + c; if (L >= nwg) return false;
        int wgid = (int)L; { const int q = nwg / NXCD, r = nwg % NXCD, xcd = wgid % NXCD, off = wgid / NXCD; wgid = (xcd < r ? xcd * (q + 1) : r * (q + 1) + (xcd - r) * q) + off; }
        const int nig = WGM * nN, gid = wgid / nig, fm = gid * WGM, gsz = (nM - fm) < WGM ? (nM - fm) : WGM;
        u.pm = fm + ((wgid % nig) % gsz); u.pn = (wgid % nig) / gsz; u.k0 = 0; u.nt = Kt; u.ks = 0; return true;
    }
    __device__ __forceinline__ void a_ready(const Unit&) const {}
    __device__ __forceinline__ void done(const Unit&) const {}
};


struct SplitOrder {
    int c, Kt;
    __host__ __device__ void init(int c_, int K_) { c = c_; Kt = K_ / BK; }
    __host__ __device__ bool next(int i, Unit& u) const {
        if (i == 0) { const int xcd = c & 7, off = c >> 3;
            const int w = xcd * 32 + off; u.pm = (w >> 5) * 4 + (w & 3); u.pn = (w >> 2) & 7; u.k0 = 0; u.nt = Kt; u.ks = 0; return true; }
        if (i == 1) { u.pm = 32 + (c >> 7); u.pn = (c >> 4) & 7; u.ks = c & 15; u.nt = Kt / 16; u.k0 = u.ks * u.nt * BK; return true; }
        return false;
    }
    __device__ __forceinline__ void a_ready(const Unit&) const {}
    __device__ __forceinline__ void done(const Unit&) const {}
};
__device__ __forceinline__ unsigned cvt_pk_bf16(float lo, float hi) { unsigned r; asm volatile("v_cvt_pk_bf16_f32 %0, %1, %2" : "=v"(r) : "v"(lo), "v"(hi)); return r; }
template <class F> struct EpiF {
    static constexpr bool PERM = true, AFTER_DRAIN = false;
    F f;
    __device__ __forceinline__ void operator()(const f32x4 (&acc)[2][2][4][2], const Unit& u, int wr, int wc, int fr, int fq) const {
        const int row0 = u.pm * BM + wr * 64 + fr, col0 = u.pn * BM + wc * 32 + 8 * fq;
#pragma unroll
        for (int ai = 0; ai < 2; ++ai)
#pragma unroll
            for (int m = 0; m < 4; ++m)
#pragma unroll
                for (int bj = 0; bj < 2; ++bj) f(row0 + ai * HALF + m * 16, col0 + bj * HALF, acc[ai][bj][m][0], acc[ai][bj][m][1], u);
    }
};
template <class Epi, class Sched, bool ALIGN_EPI = false, bool SP2 = false>
__device__ __forceinline__ void gemm_phase(PG8_LAS unsigned char* lds, const Gemm g, const Sched& S, const Epi& E, const int tid  ) {
    const int wid = __builtin_amdgcn_readfirstlane(tid >> 6), lane = tid & 63, wr = wid >> 2, wc = wid & 3, fr = lane & 15, fq = lane >> 4;
    const int K = g.K;
    unsigned voffA[2], voffB[2];
#pragma unroll
    for (int i = 0; i < 2; ++i) { int R, C; stage_rc(tid * 16 + i * 8192, R, C); const int Rb = Epi::PERM ? ((R & ~31) + perm32(R & 31)) : R;
        voffA[i] = (unsigned)(R * K + C) * 2u; voffB[i] = (unsigned)(Rb * K + C) * 2u; }
    const size_t kstep = (size_t)(BK * 2);
    const size_t hstep = (size_t)HALF * K * 2;
    const size_t tstep = 2 * hstep;
    const unsigned ldsw = (unsigned)wid * 1024u;
    const int aoff = lds_byte(wr * 64 + fr, fq * 8), boff = lds_byte(wc * 32 + fr, fq * 8);
#define PG8_SA(b, h) (((b) * 2 + (h)) * HTB)
#define PG8_SB(b, h) ((4 + (b) * 2 + (h)) * HTB)
#define PG8_STAGE(bufoff, gbase, voff) do { _Pragma("unroll") for (int _i = 0; _i < 2; ++_i) \
        __builtin_amdgcn_global_load_lds((const unsigned*)((const char*)(gbase) + (voff)[_i]), (PG8_LAS unsigned*)(lds + (bufoff) + ldsw + _i * 8192), 16, 0, 0); } while (0)
#define PG8_LDA(dst, b, h) do { _Pragma("unroll") for (int m = 0; m < 4; ++m) _Pragma("unroll") for (int k = 0; k < 2; ++k) dst[m][k] = *(const PG8_LAS bf16x8*)(lds + PG8_SA(b, h) + aoff + m * 2048 + k * 1024); } while (0)
#define PG8_LDB(dst, b, h) do { _Pragma("unroll") for (int n = 0; n < 2; ++n) _Pragma("unroll") for (int k = 0; k < 2; ++k) dst[n][k] = *(const PG8_LAS bf16x8*)(lds + PG8_SB(b, h) + boff + n * 2048 + k * 1024); } while (0)
#define PG8_MMA(ai, bj, At, Bt) do { __builtin_amdgcn_s_setprio(1); _Pragma("unroll") for (int m = 0; m < 4; ++m) _Pragma("unroll") for (int n = 0; n < 2; ++n) _Pragma("unroll") for (int k = 0; k < 2; ++k) \
        acc[ai][bj][m][n] = __builtin_amdgcn_mfma_f32_16x16x32_bf16(Bt[n][k], At[m][k], acc[ai][bj][m][n], 0, 0, 0); __builtin_amdgcn_s_setprio(0); } while (0)
#define PG8_WAIT_V(n) asm volatile("s_waitcnt vmcnt(" #n ")" ::: "memory")
#define PG8_WAIT_L(n) asm volatile("s_waitcnt lgkmcnt(" #n ")" ::: "memory")
#define PG8_BAR __builtin_amdgcn_s_barrier()
#define PG8_SCHED __builtin_amdgcn_sched_barrier(0)
    Unit cur, nxt; int ui = 0;
    if (!S.next(0, cur)) return;
    f32x4 acc[2][2][4][2];
#pragma unroll
    for (int a = 0; a < 2; ++a)
#pragma unroll
        for (int b = 0; b < 2; ++b)
#pragma unroll
            for (int m = 0; m < 4; ++m)
#pragma unroll
                for (int n = 0; n < 2; ++n) acc[a][b][m][n] = (f32x4){0.f, 0.f, 0.f, 0.f};
    bf16x8 At[4][2], B0[2][2], B1[2][2];
    const char* cA = (const char*)g.A + (size_t)cur.pm * tstep + (size_t)cur.k0 * 2; const char* cB = (const char*)g.Bt + (size_t)cur.pn * tstep + (size_t)cur.k0 * 2;
    S.a_ready(cur);
    if constexpr (SP2) {
        PG8_STAGE(PG8_SB(0, 0), cB, voffB); PG8_STAGE(PG8_SB(0, 1), cB + hstep, voffB); PG8_STAGE(PG8_SA(0, 0), cA, voffA); PG8_STAGE(PG8_SA(0, 1), cA + hstep, voffA);
        if (wr == 1) PG8_BAR;
        PG8_WAIT_V(2); PG8_BAR;
        PG8_STAGE(PG8_SB(1, 0), cB + kstep, voffB); PG8_STAGE(PG8_SA(1, 0), cA + kstep, voffA); PG8_STAGE(PG8_SB(1, 1), cB + hstep + kstep, voffB);
        PG8_WAIT_V(6); PG8_BAR;
    } else {
        PG8_STAGE(PG8_SB(0, 0), cB, voffB); PG8_STAGE(PG8_SA(0, 0), cA, voffA); PG8_STAGE(PG8_SB(0, 1), cB + hstep, voffB); PG8_STAGE(PG8_SA(0, 1), cA + hstep, voffA);
        if (wr == 1) PG8_BAR;
        PG8_WAIT_V(4); PG8_BAR;
        PG8_STAGE(PG8_SB(1, 0), cB + kstep, voffB); PG8_STAGE(PG8_SA(1, 0), cA + kstep, voffA); PG8_STAGE(PG8_SB(1, 1), cB + hstep + kstep, voffB);
        PG8_WAIT_V(6); PG8_BAR;
    }
    for (;;) {
        const bool has_next = S.next(ui + 1, nxt);
        const char* nA = has_next ? (const char*)g.A + (size_t)nxt.pm * tstep + (size_t)nxt.k0 * 2 : cA; const char* nB = has_next ? (const char*)g.Bt + (size_t)nxt.pn * tstep + (size_t)nxt.k0 * 2 : cB;
        const int nt = cur.nt;
        for (int t = 0; t < nt; t += 2) {
            const bool last = (t == nt - 2);
            const char* a1 = cA + (size_t)(t + 1) * kstep;
            const char* a2 = last ? nA : cA + (size_t)(t + 2) * kstep; const char* b2 = last ? nB : cB + (size_t)(t + 2) * kstep;
            const char* a3 = a2 + kstep; const char* b3 = b2 + kstep;
            if (last && has_next) S.a_ready(nxt);
            if constexpr (SP2) {
            PG8_LDB(B0, 0, 0); PG8_LDB(B1, 0, 1); PG8_SCHED; PG8_LDA(At, 0, 0); PG8_STAGE(PG8_SA(1, 1), a1 + hstep, voffA);
            PG8_WAIT_V(8); PG8_WAIT_L(0); PG8_BAR; PG8_MMA(0, 0, At, B0); PG8_MMA(0, 1, At, B1); PG8_BAR; PG8_SCHED;
            PG8_LDA(At, 0, 1); PG8_STAGE(PG8_SB(0, 0), b2, voffB); PG8_STAGE(PG8_SB(0, 1), b2 + hstep, voffB); PG8_STAGE(PG8_SA(0, 0), a2, voffA);
            PG8_WAIT_V(8); PG8_WAIT_L(0); PG8_BAR; PG8_MMA(1, 0, At, B0); PG8_MMA(1, 1, At, B1); PG8_BAR; PG8_SCHED;
            PG8_LDB(B0, 1, 0); PG8_LDB(B1, 1, 1); PG8_SCHED; PG8_LDA(At, 1, 0); PG8_STAGE(PG8_SA(0, 1), a2 + hstep, voffA);
            PG8_WAIT_V(8); PG8_WAIT_L(0); PG8_BAR; PG8_MMA(0, 0, At, B0); PG8_MMA(0, 1, At, B1); PG8_BAR; PG8_SCHED;
            PG8_LDA(At, 1, 1); PG8_STAGE(PG8_SB(1, 0), b3, voffB); PG8_STAGE(PG8_SB(1, 1), b3 + hstep, voffB); PG8_STAGE(PG8_SA(1, 0), a3, voffA);
            PG8_WAIT_V(8); PG8_WAIT_L(0); PG8_BAR; PG8_MMA(1, 0, At, B0); PG8_MMA(1, 1, At, B1); PG8_BAR; PG8_SCHED;
            } else {
            PG8_LDB(B0, 0, 0); PG8_SCHED; PG8_LDA(At, 0, 0); PG8_STAGE(PG8_SA(1, 1), a1 + hstep, voffA);
            PG8_WAIT_L(8); PG8_BAR; PG8_WAIT_L(0); PG8_MMA(0, 0, At, B0); PG8_BAR; PG8_SCHED;
            PG8_LDB(B1, 0, 1); PG8_STAGE(PG8_SB(0, 0), b2, voffB);
            PG8_BAR; PG8_WAIT_L(0); PG8_MMA(0, 1, At, B1); PG8_BAR;
            PG8_LDA(At, 0, 1); PG8_STAGE(PG8_SA(0, 0), a2, voffA);
            PG8_BAR; PG8_WAIT_L(0); PG8_MMA(1, 0, At, B0); PG8_BAR; PG8_SCHED;
            PG8_STAGE(PG8_SB(0, 1), b2 + hstep, voffB);
            PG8_WAIT_V(6); PG8_BAR; PG8_MMA(1, 1, At, B1); PG8_BAR;
            PG8_LDB(B0, 1, 0); PG8_SCHED; PG8_LDA(At, 1, 0); PG8_STAGE(PG8_SA(0, 1), a2 + hstep, voffA);
            PG8_WAIT_L(8); PG8_BAR; PG8_WAIT_L(0); PG8_MMA(0, 0, At, B0); PG8_BAR; PG8_SCHED;
            PG8_LDB(B1, 1, 1); PG8_STAGE(PG8_SB(1, 0), b3, voffB);
            PG8_BAR; PG8_WAIT_L(0); PG8_MMA(0, 1, At, B1); PG8_BAR;
            PG8_LDA(At, 1, 1); PG8_STAGE(PG8_SA(1, 0), a3, voffA);
            PG8_BAR; PG8_WAIT_L(0); PG8_MMA(1, 0, At, B0); PG8_BAR; PG8_SCHED;
            PG8_STAGE(PG8_SB(1, 1), b3 + hstep, voffB);
            PG8_WAIT_V(6); PG8_BAR; PG8_MMA(1, 1, At, B1); PG8_BAR;
            }
        }
        if constexpr (ALIGN_EPI) { if (wr == 0) PG8_BAR; }
        if constexpr (!Epi::AFTER_DRAIN) { E(acc, cur, wr, wc, fr, fq); S.done(cur); }
        if (!has_next) break;
#pragma unroll
        for (int a = 0; a < 2; ++a)
#pragma unroll
            for (int b = 0; b < 2; ++b)
#pragma unroll
                for (int m = 0; m < 4; ++m)
#pragma unroll
                    for (int n = 0; n < 2; ++n) acc[a][b][m][n] = (f32x4){0.f, 0.f, 0.f, 0.f};
        cur = nxt; cA = nA; cB = nB; ++ui;
        if constexpr (ALIGN_EPI) { if (wr == 1) PG8_BAR; }
    }
    PG8_WAIT_V(0);
    if constexpr (!ALIGN_EPI) { if (wr == 0) PG8_BAR; }
    PG8_BAR;
    if constexpr (Epi::AFTER_DRAIN) { E.fused(acc, cur, wr, wc, fr, fq, lds, wid, lane); S.done(cur); }
#undef PG8_SA
#undef PG8_SB
#undef PG8_STAGE
#undef PG8_LDA
#undef PG8_LDB
#undef PG8_MMA
#undef PG8_WAIT_V
#undef PG8_WAIT_L
#undef PG8_BAR
#undef PG8_SCHED
}
}

constexpr int NP = 8192, NS = 512, NTOK = NP + NS, DM = 2048, DFF = 8192, SEQ = 4096, DEPTH = 4;
constexpr int A_N = 6144, B_N = 4176, B_NP = 4352, C_N = 12352, C_NP = 12544, C_VD = 4096;
constexpr int A_LD = A_N + 128, B_LD = B_NP + 128;
constexpr float ALPHA = 1.681792830507429f;
constexpr float LN_EPS = 1e-5f, RMS_EPS = 1e-6f;
constexpr size_t O_YP = 0, O_YS = O_YP + (size_t)NP * DM, O_AKP = O_YS + (size_t)NS * DM, O_AVP = O_AKP + 2ull * 2 * 512 * 2048, O_AKS = O_AVP + 2ull * 2 * 512 * 2048,
    O_AVS = O_AKS + 2ull * 16 * 32 * 2048, O_BKP = O_AVS + 2ull * 16 * 32 * 2048, O_BVP = O_BKP + (size_t)NP * 512, O_BIP = O_BVP + (size_t)NP * 512, O_BKS = O_BIP + (size_t)NP * 64,
    O_BVS = O_BKS + (size_t)NS * 512, O_BIS = O_BVS + (size_t)NS * 512, O_CCP = O_BIS + (size_t)NS * 64, O_CSP = O_CCP + 2ull * 3 * 8192, O_CCS = O_CSP + 2ull * 32 * 128 * 128,
    O_CSS = O_CCS + 16ull * 3 * 8192, O_END = O_CSS + 16ull * 32 * 128 * 128;
enum { I_XP = 0, I_XS, I_CAK, I_CAV, I_CBK, I_CBV, I_CBI, I_SCC, I_SCS, I_AWIN, I_ABIAS, I_AWOUT, I_BWIN, I_BWOUT, I_CWIN, I_CCONVW, I_CALOG, I_CDT, I_CNORM, I_CWOUT,
       I_LN1G, I_LN1B, I_W1, I_W2, I_LN2G, I_LN2B, N_IN };

constexpr size_t MiB = 1u << 20;
constexpr size_t WS_CTL = 0, CTL_ZERO_BYTES = 1 * MiB;
constexpr size_t WS_WA_IN = 1 * MiB;
constexpr size_t WS_WA_OUT = WS_WA_IN + 48 * MiB;
constexpr size_t WS_WB_IN = WS_WA_OUT + 16 * MiB;
constexpr size_t WS_WB_OUT = WS_WB_IN + 17 * MiB;
constexpr size_t WS_WC_IN = WS_WB_OUT + 8 * MiB;
constexpr size_t WS_WC_OUT = WS_WC_IN + 49 * MiB;
constexpr size_t WS_W1 = WS_WC_OUT + 16 * MiB;
constexpr size_t WS_W2 = WS_W1 + 128 * MiB;
constexpr size_t WS_XN = WS_W2 + 128 * MiB;
constexpr size_t WS_BIG = WS_XN + 34 * MiB;
constexpr size_t WS_ATT = WS_BIG + 209 * MiB;
constexpr size_t WS_MIX = WS_ATT + 68 * MiB;
constexpr size_t WS_SIDE = WS_MIX + 68 * MiB;
constexpr size_t WS_SCR = WS_SIDE + 4 * MiB;
constexpr size_t WS_S0COPY = WS_SCR + 330 * MiB;
constexpr size_t WS_PART = WS_S0COPY + 32 * MiB;
constexpr size_t WS_END = WS_PART + 64 * MiB;
constexpr int A_CATROWS = 640;
constexpr size_t SA_CATK = WS_SCR, SA_CATV = SA_CATK + 16ull * A_CATROWS * 2048 * 2;
constexpr int B_CATROWS = 1152;
constexpr size_t SB_CATK = WS_SCR, SB_CATV = SB_CATK + 16ull * B_CATROWS * 512 * 2, SB_CATI = SB_CATV + 16ull * B_CATROWS * 512 * 2,
    SB_SCORE = SB_CATI + 16ull * B_CATROWS * 64 * 2 + MiB / 2, SB_MASK = SB_SCORE + (size_t)NTOK * 4096 * 4, SB_END = SB_MASK + (size_t)NTOK * 512;
static_assert(SB_END <= WS_S0COPY && SA_CATV + 16ull * A_CATROWS * 2048 * 2 <= WS_S0COPY, "scratch map");
constexpr int CW_BAR = 4096, CW_QB = 8192, CW_TF = 16384;

#define GAS __attribute__((address_space(1)))
#define LAS __attribute__((address_space(3)))
typedef unsigned short bf16;
typedef unsigned v4u __attribute__((ext_vector_type(4)));
typedef unsigned v2u __attribute__((ext_vector_type(2)));
typedef float f32x4 __attribute__((ext_vector_type(4)));
typedef float f32x2 __attribute__((ext_vector_type(2)));
typedef short bf16x8 __attribute__((ext_vector_type(8)));
typedef GAS unsigned gu32;
#define LDS_WAIT() asm volatile("s_waitcnt lgkmcnt(0)" ::: "memory")
#define VM_WAIT() asm volatile("s_waitcnt vmcnt(0)" ::: "memory")
constexpr int NWAVES = 8, NTHR = 512;
__device__ __forceinline__ unsigned pk2(float lo, float hi) { return pg8::cvt_pk_bf16(lo, hi); }
__device__ __forceinline__ float bf2f(bf16 b) { return __uint_as_float((unsigned)b << 16); }
__device__ __forceinline__ float wave_sum(float v) {
#pragma unroll
    for (int o = 1; o < 64; o <<= 1) v += __shfl_xor(v, o);
    return v;
}
__device__ __forceinline__ void store8_bf16(bf16* p, f32x4 v0, f32x4 v1) { v4u w; w.x = pk2(v0[0], v0[1]); w.y = pk2(v0[2], v0[3]); w.z = pk2(v1[0], v1[1]); w.w = pk2(v1[2], v1[3]); *(v4u*)p = w; }
__device__ __forceinline__ void store8_f32(float* p, f32x4 v0, f32x4 v1) { *(f32x4*)p = v0; *(f32x4*)(p + 4) = v1; }

#define XB_TMO      128
#define XB_XCNT(j)  (256  + 64 * (j))
#define XB_XSUB(j)  (1280 + 64 * (j))
#define XB_XGEN(j)  (2304 + 64 * (j))
#define XB_TOP      3328
#define XB_TOPGEN   3392
#define XCD_BAR_WORDS 3456
#define XB_SPIN_CAP (1u << 18)

__device__ __forceinline__ unsigned xb_ld(unsigned* p)              { return __hip_atomic_load(p, __ATOMIC_RELAXED, __HIP_MEMORY_SCOPE_AGENT); }
__device__ __forceinline__ unsigned xb_add(unsigned* p, unsigned v) { return __hip_atomic_fetch_add(p, v, __ATOMIC_RELAXED, __HIP_MEMORY_SCOPE_AGENT); }
__device__ __forceinline__ unsigned xb_xcc_id() { return (unsigned)__builtin_amdgcn_s_getreg((3 << 11) | 20) & 0xFu; }
#define XB_SPIN(cond, bar) do { unsigned _sp = 0; while (cond) { __builtin_amdgcn_s_sleep(1); \
    if ((++_sp & 255u) == 0u) { if (xb_ld(&(bar)[XB_TMO])) break; if (_sp > XB_SPIN_CAP) { atomicAdd(&(bar)[XB_TMO], 1u); break; } } } } while (0)

struct XcdBarrier {
    unsigned* bar; unsigned x;
    volatile LAS unsigned* st;
};

__device__ __forceinline__ XcdBarrier xcd_barrier_post(unsigned* bar, volatile LAS unsigned* st) {
    XcdBarrier b; b.bar = bar; b.x = xb_xcc_id(); b.st = st;
    if (threadIdx.x == 0) (void)xb_add(&bar[XB_XCNT(b.x)], 1u);
    return b;
}
__device__ __forceinline__ void xcd_barrier_complete(unsigned* bar, unsigned x, unsigned& nloc, unsigned& nx) {
    const unsigned G = gridDim.x * gridDim.y * gridDim.z;
    unsigned sum, cnt, mine, sp = 0u;
    for (;;) {
        sum = 0u; cnt = 0u; mine = 0u;
#pragma unroll
        for (unsigned j = 0; j < 16; ++j) { const unsigned c = xb_ld(&bar[XB_XCNT(j)]); sum += c; cnt += (c > 0u) ? 1u : 0u; mine = (j == x) ? c : mine; }
        if (sum == G) break;
        __builtin_amdgcn_s_sleep(1);
        if ((++sp & 255u) == 0u) { if (xb_ld(&bar[XB_TMO])) break; if (sp > XB_SPIN_CAP) { atomicAdd(&bar[XB_TMO], 1u); break; } }
    }
    nloc = mine > 0u ? mine : 1u; nx = cnt > 0u ? cnt : 1u;
}

__device__ __forceinline__ void xcd_barrier(const XcdBarrier& b) {
    asm volatile("s_waitcnt vmcnt(0)" ::: "memory");
    __syncthreads();
    if (threadIdx.x == 0) {
        unsigned* bar = b.bar;
        __builtin_amdgcn_s_waitcnt(0);
        unsigned nloc = b.st[0], nx = b.st[1];
        if (nloc == 0u) { xcd_barrier_complete(bar, b.x, nloc, nx); b.st[0] = nloc; b.st[1] = nx; }
        const unsigned old = xb_add(&bar[XB_XSUB(b.x)], 1u);
        const unsigned gen = old / nloc;
        if (old + 1u == (gen + 1u) * nloc) {
            __builtin_amdgcn_fence(__ATOMIC_RELEASE, "agent");
            asm volatile("s_waitcnt vmcnt(0)" ::: "memory");
            const unsigned og = xb_add(&bar[XB_TOP], 1u);
            const unsigned tg = og / nx;
            if (og + 1u == (tg + 1u) * nx) xb_add(&bar[XB_TOPGEN], 1u);
            else XB_SPIN(xb_ld(&bar[XB_TOPGEN]) == tg, bar);
            __builtin_amdgcn_fence(__ATOMIC_ACQUIRE, "agent");
            xb_add(&bar[XB_XGEN(b.x)], 1u);
            asm volatile("s_waitcnt vmcnt(0)" ::: "memory");
        } else {
            XB_SPIN(xb_ld(&bar[XB_XGEN(b.x)]) == gen, bar);
            __builtin_amdgcn_fence(__ATOMIC_ACQUIRE, "agent");
            asm volatile("s_waitcnt vmcnt(0)" ::: "memory");
        }
    }
    __syncthreads();
}

namespace att {
constexpr int D = 128, NW = 8, QBLK = 32, KVBLK = 64;
constexpr float SCALE = 0.088388347648318440f;
constexpr float THR = 8.f;
constexpr size_t SHM_V = KVBLK * D * 2, SHM_K = KVBLK * D * 2, SHM_ATTN = 2 * SHM_V + 2 * SHM_K + NW * 64 * 4;
constexpr size_t SHM_BIAS = SHM_ATTN;
using s16x4  = __attribute__((ext_vector_type(4))) short;
using f32x16 = __attribute__((ext_vector_type(16))) float;
using u32x4  = __attribute__((ext_vector_type(4))) unsigned;
#define KSWZ(row, colB) ((row) * 256 + ((colB) ^ (((row) & 7) << 4)))
#define SBAR() __builtin_amdgcn_sched_barrier(0)
__device__ __forceinline__ int crow(int r, int hi) { return (r & 3) + 8 * (r >> 2) + 4 * hi; }
__device__ __forceinline__ unsigned cvtpk(float lo, float hi) { unsigned r; asm volatile("v_cvt_pk_bf16_f32 %0, %1, %2" : "=v"(r) : "v"(lo), "v"(hi)); return r; }

__device__ __forceinline__ void partialSM(f32x16& p0, f32x16& p1, float& m_reg, float& mn, float& alpha) {
  constexpr float C = SCALE * 1.4426950408889634f;
  float pmax = p0[0];
#pragma unroll
  for (int r = 1; r < 16; ++r) pmax = fmaxf(pmax, p0[r]);
#pragma unroll
  for (int r = 0; r < 16; ++r) pmax = fmaxf(pmax, p1[r]);
  { auto rr = __builtin_amdgcn_permlane32_swap(__float_as_uint(pmax), __float_as_uint(pmax), false, false);
    pmax = fmaxf(__uint_as_float(rr[0]), __uint_as_float(rr[1])); }
  if (__builtin_expect(__all(pmax - m_reg <= THR / SCALE), 1)) { mn = m_reg; alpha = 1.f; }
  else { mn = fmaxf(m_reg, pmax); alpha = __builtin_amdgcn_exp2f((m_reg - mn) * C); m_reg = mn; }
  float mnC = -mn * C;
#pragma unroll
  for (int r = 0; r < 16; ++r) p0[r] = fmaf(p0[r], C, mnC);
#pragma unroll
  for (int r = 0; r < 16; ++r) p1[r] = fmaf(p1[r], C, mnC);
#pragma unroll
  for (int r = 0; r < 16; ++r) p0[r] = __builtin_amdgcn_exp2f(p0[r]);
}
__device__ __forceinline__ void finishSM(f32x16& p0, f32x16& p1, float alpha, float& l_reg, bf16x8& pa0, bf16x8& pa1, bf16x8& pa2, bf16x8& pa3) {
#pragma unroll
  for (int r = 0; r < 16; ++r) p1[r] = __builtin_amdgcn_exp2f(p1[r]);
  float ps = 0;
#pragma unroll
  for (int r = 0; r < 16; ++r) ps += p0[r];
#pragma unroll
  for (int r = 0; r < 16; ++r) ps += p1[r];
  { auto rr = __builtin_amdgcn_permlane32_swap(__float_as_uint(ps), __float_as_uint(ps), false, false);
    ps = __uint_as_float(rr[0]) + __uint_as_float(rr[1]); }
  l_reg = l_reg * alpha + ps;
#define PK4(P, BASE, OUT) do { unsigned a0 = cvtpk(P[BASE + 0], P[BASE + 1]), a1 = cvtpk(P[BASE + 2], P[BASE + 3]);   \
    unsigned b0 = cvtpk(P[BASE + 4], P[BASE + 5]), b1 = cvtpk(P[BASE + 6], P[BASE + 7]);                              \
    auto r0 = __builtin_amdgcn_permlane32_swap(a0, b0, false, false); auto r1 = __builtin_amdgcn_permlane32_swap(a1, b1, false, false); \
    u32x4 w = {r0[0], r1[0], r0[1], r1[1]}; OUT = *reinterpret_cast<bf16x8*>(&w); } while (0)
  PK4(p0, 0, pa0); PK4(p0, 8, pa1); PK4(p1, 0, pa2); PK4(p1, 8, pa3);
#undef PK4
}
__device__ __forceinline__ void qkt(f32x16& p0, f32x16& p1, const bf16* Ks, const bf16x8* qr, int r32, int hi) {
  p0 = f32x16{}; p1 = f32x16{};
#pragma unroll
  for (int d0 = 0; d0 < 8; ++d0) { int cb = (d0 * 16 + hi * 8) * 2;
    bf16x8 b0 = *reinterpret_cast<const bf16x8*>((const char*)Ks + KSWZ(r32, cb));
    bf16x8 b1 = *reinterpret_cast<const bf16x8*>((const char*)Ks + KSWZ(32 + r32, cb));
    p0 = __builtin_amdgcn_mfma_f32_32x32x16_bf16(b0, qr[d0], p0, 0, 0, 0);
    p1 = __builtin_amdgcn_mfma_f32_32x32x16_bf16(b1, qr[d0], p1, 0, 0, 0); }
}
__device__ __forceinline__ int v_st(int k, int c) { const int kk = (k & ~0xC) | ((k & 4) << 1) | ((k & 8) >> 1); return ((kk >> 3) * 4 + (c >> 5)) * 512 + ((kk & 7) * 32 + (c & 31)) * 2; }
__device__ __forceinline__ int v_rd_base(int lane) { return ((lane & 3) << 3) | (((lane >> 2) & 3) << 6) | (((lane >> 4) & 1) << 5) | (((lane >> 5) & 1) << 8); }
constexpr int v_rd_off(int d0, int ks, int half) { return d0 * 512 + ks * 4096 + half * 2048; }
template <int OFF> __device__ __forceinline__ s16x4 tr_read(int vb) {
  s16x4 r; asm volatile("ds_read_b64_tr_b16 %0, %1 offset:%2" : "=&v"(r) : "v"(vb), "i"(OFF) : "memory"); return r;
}
template <int D0> __device__ __forceinline__ void pv_one(f32x16& od, int vb, bf16x8 pa0, bf16x8 pa1, bf16x8 pa2, bf16x8 pa3) {
  const s16x4 l0 = tr_read<v_rd_off(D0, 0, 0)>(vb), h0 = tr_read<v_rd_off(D0, 0, 1)>(vb), l1 = tr_read<v_rd_off(D0, 1, 0)>(vb), h1 = tr_read<v_rd_off(D0, 1, 1)>(vb);
  const s16x4 l2 = tr_read<v_rd_off(D0, 2, 0)>(vb), h2 = tr_read<v_rd_off(D0, 2, 1)>(vb), l3 = tr_read<v_rd_off(D0, 3, 0)>(vb), h3 = tr_read<v_rd_off(D0, 3, 1)>(vb);
  asm volatile("s_waitcnt lgkmcnt(0)" ::: "memory"); SBAR();
#define PK(L, H) (bf16x8){L[0], L[1], L[2], L[3], H[0], H[1], H[2], H[3]}
  od = __builtin_amdgcn_mfma_f32_32x32x16_bf16(pa0, PK(l0, h0), od, 0, 0, 0);
  od = __builtin_amdgcn_mfma_f32_32x32x16_bf16(pa1, PK(l1, h1), od, 0, 0, 0);
  od = __builtin_amdgcn_mfma_f32_32x32x16_bf16(pa2, PK(l2, h2), od, 0, 0, 0);
  od = __builtin_amdgcn_mfma_f32_32x32x16_bf16(pa3, PK(l3, h3), od, 0, 0, 0);
#undef PK
}
__device__ __forceinline__ void pv_d0(f32x16* o, int vb, bf16x8 pa0, bf16x8 pa1, bf16x8 pa2, bf16x8 pa3) {
  pv_one<0>(o[0], vb, pa0, pa1, pa2, pa3); pv_one<1>(o[1], vb, pa0, pa1, pa2, pa3); pv_one<2>(o[2], vb, pa0, pa1, pa2, pa3); pv_one<3>(o[3], vb, pa0, pa1, pa2, pa3);
}

template <class Mask>
__device__ __forceinline__ void attn_body(const bf16* __restrict__ Qw, int ldq, const bf16* __restrict__ Kh, const bf16* __restrict__ Vh, int ldk,
                                          bf16* __restrict__ Ow, int ldo, bool active, int NT, char* lds, const Mask& Mk, int tid) {
  const int wid = tid >> 6, lane = tid & 63, r32 = lane & 31, hi = lane >> 5;
  bf16* V_lds = (bf16*)lds; bf16* K_lds = (bf16*)(lds + 2 * SHM_V);
  float* ws = (float*)(lds + 2 * SHM_V + 2 * SHM_K) + wid * 64; float* li_l = ws; float* al_l = ws + 32;
  float m_reg = -1e30f, l_reg = 0; f32x16 o[4] = {}; bf16x8 qr[8];
  const bf16* Qp = Qw + (long)r32 * ldq + hi * 8;
#pragma unroll
  for (int d0 = 0; d0 < 8; ++d0) qr[d0] = *reinterpret_cast<const bf16x8*>(Qp + d0 * 16);
  const int sr = tid >> 4, sc = (tid & 15) * 8, vst0 = v_st(sr, sc), vst1 = v_st(32 + sr, sc);
  const int vb0 = (int)(uintptr_t)V_lds + v_rd_base(lane);
  struct { bf16x8 vs0, vs1, ks0, ks1; } sr_[1];
#define SLOAD(i, k0) do { sr_[i].vs0 = *reinterpret_cast<const bf16x8*>(&Vh[(long)((k0) + sr) * ldk + sc]); sr_[i].vs1 = *reinterpret_cast<const bf16x8*>(&Vh[(long)((k0) + 32 + sr) * ldk + sc]); \
    sr_[i].ks0 = *reinterpret_cast<const bf16x8*>(&Kh[(long)((k0) + sr) * ldk + sc]); sr_[i].ks1 = *reinterpret_cast<const bf16x8*>(&Kh[(long)((k0) + 32 + sr) * ldk + sc]); } while (0)
#define SWRITE(b, i) do { *(bf16x8*)((char*)V_lds + (b) * SHM_V + vst0) = sr_[i].vs0;          \
    *(bf16x8*)((char*)V_lds + (b) * SHM_V + vst1) = sr_[i].vs1; int kc = sc * 2;               \
    *(bf16x8*)((char*)K_lds + (b) * SHM_K + KSWZ(sr, kc)) = sr_[i].ks0;                       \
    *(bf16x8*)((char*)K_lds + (b) * SHM_K + KSWZ(32 + sr, kc)) = sr_[i].ks1; } while (0)
#define SWAIT() asm volatile("s_waitcnt vmcnt(0)" ::: "memory")
#define RESC(a) do { if (__any((a) < 1.f)) { if (hi == 0) al_l[r32] = (a); asm volatile("s_waitcnt lgkmcnt(0)" ::: "memory"); \
    _Pragma("unroll") for (int d = 0; d < 4; ++d) _Pragma("unroll") for (int r = 0; r < 16; ++r) o[d][r] *= al_l[crow(r, hi)]; } } while (0)
  f32x16 pA0, pA1, pB0, pB1; float mnA, mnB, alA, alB; bf16x8 pa0, pa1, pa2, pa3;
  constexpr int SE = 0, SO = 0;
  SLOAD(SE, 0); asm volatile("s_waitcnt vmcnt(0)" ::: "memory"); SWRITE(0, SE); __syncthreads();
  qkt(pA0, pA1, K_lds, qr, r32, hi); Mk.apply(pA0, pA1, 0, r32, hi); partialSM(pA0, pA1, m_reg, mnA, alA);
  SLOAD(SO, KVBLK);
  SWAIT(); SWRITE(1, SO); __syncthreads();
  for (int j = 1; j + 1 < NT; j += 2) {
    SBAR(); qkt(pB0, pB1, (bf16*)((char*)K_lds + SHM_K), qr, r32, hi); Mk.apply(pB0, pB1, j, r32, hi);
    finishSM(pA0, pA1, alA, l_reg, pa0, pa1, pa2, pa3); SBAR();
    SLOAD(SO, (j + 1) * KVBLK); SBAR();
    pv_d0(o, vb0, pa0, pa1, pa2, pa3); partialSM(pB0, pB1, m_reg, mnB, alB);
    __syncthreads(); SWAIT(); SWRITE(0, SE);
    RESC(alB); __syncthreads();
    SBAR(); qkt(pA0, pA1, K_lds, qr, r32, hi); Mk.apply(pA0, pA1, j + 1, r32, hi);
    finishSM(pB0, pB1, alB, l_reg, pa0, pa1, pa2, pa3); SBAR();
    SLOAD(SE, (j + 2) * KVBLK); SBAR();
    pv_d0(o, vb0 + (int)SHM_V, pa0, pa1, pa2, pa3); partialSM(pA0, pA1, m_reg, mnA, alA);
    __syncthreads(); SWAIT(); SWRITE(1, SO);
    RESC(alA); __syncthreads();
  }
  SBAR(); qkt(pB0, pB1, (bf16*)((char*)K_lds + SHM_K), qr, r32, hi); Mk.apply(pB0, pB1, NT - 1, r32, hi);
  finishSM(pA0, pA1, alA, l_reg, pa0, pa1, pa2, pa3); SBAR();
  pv_d0(o, vb0, pa0, pa1, pa2, pa3); partialSM(pB0, pB1, m_reg, mnB, alB);
  __syncthreads(); RESC(alB);
  finishSM(pB0, pB1, alB, l_reg, pa0, pa1, pa2, pa3); SBAR();
  pv_d0(o, vb0 + (int)SHM_V, pa0, pa1, pa2, pa3);
  if (hi == 0) li_l[r32] = l_reg; asm volatile("s_waitcnt lgkmcnt(0)" ::: "memory");
  float rli[16];
#pragma unroll
  for (int r = 0; r < 16; ++r) rli[r] = __builtin_amdgcn_rcpf(li_l[crow(r, hi)]);
  if (active) {
    bf16* Ob = Ow + r32; int hi_e = hi; asm volatile("" : "+v"(Ob), "+v"(hi_e));
#pragma unroll
    for (int r = 0; r < 16; ++r) { const int orow = crow(r, hi_e);
#pragma unroll
      for (int d0 = 0; d0 < 4; ++d0) { const float v = o[d0][r] * rli[r]; Ob[(long)orow * ldo + d0 * 32] = (bf16)(cvtpk(v, v) & 0xffffu); } }
  }
  __syncthreads();
#undef SLOAD
#undef SWRITE
#undef SWAIT
#undef RESC
}

struct MaskAPrompt {
  const float* bias;
  int qc, kc0, qoff;
  __device__ __forceinline__ void apply(f32x16& p0, f32x16& p1, int j, int r32, int hi) const {
    const int dc = qc - (kc0 + j);
    if (dc < 0 || dc > 8) {
#pragma unroll
      for (int r = 0; r < 16; ++r) { p0[r] = -INFINITY; p1[r] = -INFINITY; }
    } else if (dc >= 3) { const float b = bias[256];
#pragma unroll
      for (int r = 0; r < 16; ++r) { p0[r] += b; p1[r] += b; }
    } else { int base = dc * 64 + qoff + r32 + 128; asm volatile("" : "+v"(base));
#pragma unroll
      for (int r = 0; r < 16; ++r) { const int i0 = base - crow(r, hi), i1 = i0 - 32;
        p0[r] += bias[min(max(i0, 0), 256)]; p1[r] += bias[min(max(i1, 0), 256)]; }
    }
  }
};
struct MaskASample {
  const float* bias;
  __device__ __forceinline__ void apply(f32x16& p0, f32x16& p1, int j, int r32, int hi) const {
    int base = 512 + r32 + 128 - 64 * j; asm volatile("" : "+v"(base));
#pragma unroll
    for (int r = 0; r < 16; ++r) { const int k0 = crow(r, hi), i0 = base - k0, i1 = i0 - 32;
      p0[r] = (64 * j + k0 < 544) ? p0[r] + bias[min(max(i0, 0), 256)] : -INFINITY;
      p1[r] = (64 * j + 32 + k0 < 544) ? p1[r] + bias[min(max(i1, 0), 256)] : -INFINITY; }
  }
};
struct MaskBits {
  const unsigned* mrow;
  __device__ __forceinline__ void apply(f32x16& p0, f32x16& p1, int j, int r32, int hi) const {
    const unsigned w0 = mrow[2 * j], w1 = mrow[2 * j + 1];
#pragma unroll
    for (int r = 0; r < 16; ++r) { const int k0 = crow(r, hi);
      p0[r] = ((w0 >> k0) & 1u) ? p0[r] : -INFINITY; p1[r] = ((w1 >> k0) & 1u) ? p1[r] : -INFINITY; }
  }
};
#undef KSWZ
#undef SBAR
}

struct Args { const float* in[N_IN]; float* out; unsigned char* ws; int ph_lo, ph_hi; };
typedef const __attribute__((address_space(4))) Args* KArgs;
__device__ __forceinline__ KArgs kargs() { KArgs k = (KArgs)__builtin_amdgcn_kernarg_segment_ptr(); asm volatile("" : "+s"(k)); return k; }
struct Frame {
    LAS unsigned char* lds;
    int tid, lane, wave, G, vcu;
};
__device__ __forceinline__ Frame relaunder(Frame F) { int l = __builtin_amdgcn_mbcnt_hi(~0u, __builtin_amdgcn_mbcnt_lo(~0u, 0u)); asm volatile("" : "+v"(l)); F.lane = l; F.tid = F.wave * 64 + l; return F; }
__device__ __forceinline__ int launder_s(int x) { asm volatile("" : "+s"(x)); return x; }
#ifndef EXP_WJ
#define EXP_WJ j
#endif
#ifndef EXP_S0MUL
#define EXP_S0MUL
#endif
#ifndef PROBE_SCALE
#define PROBE_SCALE 1.0f
#endif

__device__ __forceinline__ void transpose_item(const float* __restrict__ W, int K, int N, bf16* __restrict__ WT, LAS float* scr, int item, int nblk, int lane) {
    const int kb = item / nblk, nb = item - kb * nblk, k0 = 64 * kb, n0 = 32 * nb;
    const int kr = lane >> 3, nq = (lane & 7) * 4; const bool ok = n0 + nq < N;
    f32x4 v[8];
#pragma unroll
    for (int i = 0; i < 8; ++i) v[i] = ok ? *(const f32x4*)(W + (size_t)(k0 + 8 * i + kr) * N + n0 + nq) : (f32x4){0.f, 0.f, 0.f, 0.f};
#pragma unroll
    for (int i = 0; i < 8; ++i) { LAS float* d = scr + (8 * i + kr) * 33 + nq; d[0] = v[i][0]; d[1] = v[i][1]; d[2] = v[i][2]; d[3] = v[i][3]; }
    LDS_WAIT(); asm volatile("" ::: "memory");
    const int c = lane & 7;
#pragma unroll
    for (int j = 0; j < 4; ++j) { const int nn = (lane >> 3) + 8 * j; const LAS float* s = scr + (8 * c) * 33 + nn;
        v4u o; o.x = pk2(s[0 * 33], s[1 * 33]); o.y = pk2(s[2 * 33], s[3 * 33]); o.z = pk2(s[4 * 33], s[5 * 33]); o.w = pk2(s[6 * 33], s[7 * 33]);
        *(v4u*)(WT + (size_t)(n0 + nn) * K + k0 + 8 * c) = o; }
    LDS_WAIT(); asm volatile("" ::: "memory");
}
__device__ __forceinline__ void transpose_item2(const float* __restrict__ W, int K, int N, bf16* __restrict__ WT, LAS float* scr, int item, int nblk, int lane) {
    const int kb = item / nblk, nb = item - kb * nblk, k0 = 64 * kb, n0 = 32 * nb;
    const int kr = lane >> 3, nq = (lane & 7) * 4; const bool ok0 = n0 + nq < N, ok1 = n0 + 32 + nq < N;
    f32x4 v[2][8];
#pragma unroll
    for (int i = 0; i < 8; ++i) { const float* src = W + (size_t)(k0 + 8 * i + kr) * N + n0 + nq;
        v[0][i] = ok0 ? *(const f32x4*)src : (f32x4){0.f, 0.f, 0.f, 0.f}; v[1][i] = ok1 ? *(const f32x4*)(src + 32) : (f32x4){0.f, 0.f, 0.f, 0.f}; }
#pragma unroll
    for (int hh = 0; hh < 2; ++hh)
#pragma unroll
        for (int i = 0; i < 8; ++i) { LAS float* d = scr + hh * 2112 + (8 * i + kr) * 33 + nq; d[0] = v[hh][i][0]; d[1] = v[hh][i][1]; d[2] = v[hh][i][2]; d[3] = v[hh][i][3]; }
    LDS_WAIT(); asm volatile("" ::: "memory");
    const int c = lane & 7;
#pragma unroll
    for (int hh = 0; hh < 2; ++hh)
#pragma unroll
        for (int j = 0; j < 4; ++j) { const int nn = (lane >> 3) + 8 * j; const LAS float* sp = scr + hh * 2112 + (8 * c) * 33 + nn;
            v4u o; o.x = pk2(sp[0 * 33], sp[1 * 33]); o.y = pk2(sp[2 * 33], sp[3 * 33]); o.z = pk2(sp[4 * 33], sp[5 * 33]); o.w = pk2(sp[6 * 33], sp[7 * 33]);
            *(v4u*)(WT + (size_t)(n0 + 32 * hh + nn) * K + k0 + 8 * c) = o; }
    LDS_WAIT(); asm volatile("" ::: "memory");
}
__device__ __forceinline__ void cvt_rows(const Frame& F0, const float* __restrict__ src, bf16* __restrict__ dst, size_t n8) {
    const Frame F = relaunder(F0);
    for (size_t i = (size_t)blockIdx.x * NTHR + F.tid; i < n8; i += (size_t)F.G * NTHR) {
        const f32x4 a = *(const f32x4*)(src + i * 8), b = *(const f32x4*)(src + i * 8 + 4); store8_bf16(dst + i * 8, a, b); }
}
__device__ __forceinline__ void copy_f32(const Frame& F0, const float* __restrict__ src, float* __restrict__ dst, size_t n4) {
    const Frame F = relaunder(F0);
    for (size_t i = (size_t)blockIdx.x * NTHR + F.tid; i < n4; i += (size_t)F.G * NTHR) *(f32x4*)(dst + i * 4) = *(const f32x4*)(src + i * 4);
}
__device__ __forceinline__ void cat_rows(const Frame& F0, const float* __restrict__ src, bf16* __restrict__ dst, int nb, int rows, int w, int dst_rows, int zero_lo) {
    const Frame F = relaunder(F0);
    const int w8 = w / 8; const size_t per_b = (size_t)rows * w8, n = per_b * nb;
    for (size_t i = (size_t)blockIdx.x * NTHR + F.tid; i < n; i += (size_t)F.G * NTHR) {
        const size_t b = i / per_b, r = i - b * per_b;
        const f32x4 x = *(const f32x4*)(src + i * 8), y = *(const f32x4*)(src + i * 8 + 4); store8_bf16(dst + (b * dst_rows) * w + r * 8, x, y); }
    const size_t zper = (size_t)(dst_rows - zero_lo) * w8, zn = zper * nb;
    unsigned z0 = 0u; asm volatile("" : "+v"(z0)); const v4u zz = {z0, z0, z0, z0};
    for (size_t i = (size_t)blockIdx.x * NTHR + F.tid; i < zn; i += (size_t)F.G * NTHR) {
        const size_t b = i / zper, r = i - b * zper; *(v4u*)(dst + (b * dst_rows + zero_lo) * w + r * 8) = zz; }
}

template <bool DEFERRED> __device__ __forceinline__ void convert_weights(const Frame& F, KArgs a, const int gw, const int NGW) {
    LAS float* scr = (LAS float*)(F.lds + F.wave * 18432);
    unsigned char* ws = a->ws;
    constexpr int I_AIN = 32 * 192, I_AOUT = 32 * 64, I_BIN = 32 * (B_NP / 32), I_BOUT = 32 * 64, I_CIN = 32 * (C_NP / 32), I_COUT = 64 * 64, I_M1 = 32 * 256, I_M2 = 128 * 64;
    if constexpr (!DEFERRED) {
        constexpr int NITEMS = I_AIN + I_AOUT + I_BIN + I_BOUT + I_CIN + 2 * I_M1 + 2 * I_M2;
        for (int it = 2 * gw; it < NITEMS; it += 2 * NGW) {
            int r = it;
            if (r < I_AIN) { transpose_item2(a->in[I_AWIN], DM, A_N, (bf16*)(ws + WS_WA_IN), scr, r, 192, F.lane); continue; } r -= I_AIN;
            if (r < I_AOUT) { transpose_item2(a->in[I_AWOUT], DM, DM, (bf16*)(ws + WS_WA_OUT), scr, r, 64, F.lane); continue; } r -= I_AOUT;
            if (r < I_BIN) { transpose_item2(a->in[I_BWIN], DM, B_N, (bf16*)(ws + WS_WB_IN), scr, r, B_NP / 32, F.lane); continue; } r -= I_BIN;
            if (r < I_BOUT) { transpose_item2(a->in[I_BWOUT], DM, DM, (bf16*)(ws + WS_WB_OUT), scr, r, 64, F.lane); continue; } r -= I_BOUT;
            if (r < I_CIN) { transpose_item2(a->in[I_CWIN], DM, C_N, (bf16*)(ws + WS_WC_IN), scr, r, C_NP / 32, F.lane); continue; } r -= I_CIN;
            if (r < 2 * I_M1) { const int j = r / I_M1; r -= j * I_M1; transpose_item2(a->in[I_W1] + (size_t)j * DM * DFF, DM, DFF, (bf16*)(ws + WS_W1) + (size_t)j * DFF * DM, scr, r, 256, F.lane); continue; } r -= 2 * I_M1;
            { const int j = r / I_M2; r -= j * I_M2; transpose_item2(a->in[I_W2] + (size_t)j * DFF * DM, DFF, DM, (bf16*)(ws + WS_W2) + (size_t)j * DM * DFF, scr, r, 64, F.lane); }
        }
    } else {
        constexpr int NITEMS = I_COUT + I_AIN + I_AOUT + 2 * I_M1 + 2 * I_M2;
        for (int it = 2 * gw; it < NITEMS; it += 2 * NGW) {
            int r = it;
            if (r < I_COUT) { transpose_item2(a->in[I_CWOUT], C_VD, DM, (bf16*)(ws + WS_WC_OUT), scr, r, 64, F.lane); continue; } r -= I_COUT;
            if (r < I_AIN) { transpose_item2(a->in[I_AWIN] + (size_t)DM * A_N, DM, A_N, (bf16*)(ws + WS_WA_IN) + (size_t)A_N * DM, scr, r, 192, F.lane); continue; } r -= I_AIN;
            if (r < I_AOUT) { transpose_item2(a->in[I_AWOUT] + (size_t)DM * DM, DM, DM, (bf16*)(ws + WS_WA_OUT) + (size_t)DM * DM, scr, r, 64, F.lane); continue; } r -= I_AOUT;
            if (r < 2 * I_M1) { const int j = 2 + r / I_M1; r -= (j - 2) * I_M1; transpose_item2(a->in[I_W1] + (size_t)j * DM * DFF, DM, DFF, (bf16*)(ws + WS_W1) + (size_t)j * DFF * DM, scr, r, 256, F.lane); continue; } r -= 2 * I_M1;
            { const int j = 2 + r / I_M2; r -= (j - 2) * I_M2; transpose_item2(a->in[I_W2] + (size_t)j * DFF * DM, DFF, DM, (bf16*)(ws + WS_W2) + (size_t)j * DM * DFF, scr, r, 64, F.lane); }
        }
    }
}
__device__ __forceinline__ void p0_prologue(const Frame& F0, KArgs a) {
    const Frame F = relaunder(F0);
    unsigned char* ws = a->ws;
    convert_weights<false>(F, a, blockIdx.x * NWAVES + F.wave, F.G * NWAVES);
    cvt_rows(F, a->in[I_XP], (bf16*)(ws + WS_XN), (size_t)NP * DM / 8);
    cvt_rows(F, a->in[I_XS], (bf16*)(ws + WS_XN) + (size_t)NP * DM, (size_t)NS * DM / 8);
#ifdef TEST_IN8
    if (blockIdx.x == 0 && F.tid == 0) { const float* p = a->in[I_SCS]; ((float*)(ws + WS_SIDE))[0] = p[0] + p[TEST_IN8]; }
#endif
}

struct FnAqkv {
    bf16* qkv; float* out; bf16* catk; bf16* catv; int j;
    __device__ __forceinline__ void operator()(int row, int col, f32x4 v0, f32x4 v1, const pg8::Unit& u) const {
        store8_bf16(qkv + (size_t)row * A_N + col, v0, v1);
        if (u.pn >= 8) {
            const bool isV = u.pn >= 16; const int c = col - (isV ? 4096 : 2048);
            if (u.pm >= 32) {
                const int r = row - NP;
                store8_f32(out + (isV ? O_AVS : O_AKS) + ((size_t)j * 512 + r) * 2048 + c, v0, v1);
                store8_bf16((isV ? catv : catk) + ((size_t)(r >> 5) * A_CATROWS + 512 + (r & 31)) * 2048 + c, v0, v1);
            } else if ((u.pm & 15) >= 14) {
                const int b = u.pm >> 4, tp = (row & 4095) - 3584;
                store8_f32(out + (isV ? O_AVP : O_AKP) + (((size_t)j * 2 + b) * 512 + tp) * 2048 + c, v0, v1);
            }
        }
    }
};
struct FnMix {
    float* mix; float* part;
    __device__ __forceinline__ void operator()(int row, int col, f32x4 v0, f32x4 v1, const pg8::Unit& u) const {
        if (u.pm >= 32) store8_bf16((bf16*)part + ((size_t)u.ks * NS + (row - NP)) * DM + col, v0, v1);
        else store8_bf16((bf16*)mix + (size_t)row * DM + col, v0, v1);
    }
};
struct FnRelu2 {
    bf16* h;
    __device__ __forceinline__ void operator()(int row, int col, f32x4 v0, f32x4 v1, const pg8::Unit&) const {
#pragma unroll
        for (int i = 0; i < 4; ++i) { const float a = fmaxf(v0[i], 0.f), b = fmaxf(v1[i], 0.f); v0[i] = a * a; v1[i] = b * b; }
        store8_bf16(h + (size_t)row * DFF + col, v0, v1);
    }
};
struct FnBproj {
    bf16* big; float* out; float* wi; bf16* catk; bf16* catv; bf16* cati;
    __device__ __forceinline__ void operator()(int row, int col, f32x4 v0, f32x4 v1, const pg8::Unit& u) const {
        store8_bf16(big + (size_t)row * B_NP + col, v0, v1);
        const bool smp = u.pm >= 32; const int r = row - NP;
        if (u.pn >= 8 && u.pn < 12) {
            const bool isV = u.pn >= 10; const int c = col - (isV ? 2560 : 2048);
            if (smp) { store8_f32(out + (isV ? O_BVS : O_BKS) + (size_t)r * 512 + c, v0 * PROBE_SCALE, v1 * PROBE_SCALE);
                       store8_bf16((isV ? catv : catk) + ((size_t)(r >> 5) * B_CATROWS + 1024 + (r & 31)) * 512 + c, v0, v1); }
            else store8_f32(out + (isV ? O_BVP : O_BKP) + (size_t)row * 512 + c, v0 * PROBE_SCALE, v1 * PROBE_SCALE);
        } else if (u.pn == 16) {
            const int c = col - 4096;
            if (c < 64) {
                if (smp) { store8_f32(out + O_BIS + (size_t)r * 64 + c, v0 * PROBE_SCALE, v1 * PROBE_SCALE);
                           store8_bf16(cati + ((size_t)(r >> 5) * B_CATROWS + 1024 + (r & 31)) * 64 + c, v0, v1); }
                else store8_f32(out + O_BIP + (size_t)row * 64 + c, v0 * PROBE_SCALE, v1 * PROBE_SCALE);
            } else if (c < 80) store8_f32(wi + (size_t)row * 16 + (c - 64), v0, v1);
        }
    }
};

struct FnCproj {
    bf16* big; float* out; float* side;
    __device__ __forceinline__ void operator()(int row, int col, f32x4 v0, f32x4 v1, const pg8::Unit& u) const {
        if (col < 12288) {
            store8_bf16(big + (size_t)row * C_NP + col, v0, v1);
            if (col < 8192) {
                if (u.pm >= 32) { const int r = row - NP, s = r & 31; if (s >= 29) store8_f32(out + O_CCS + ((size_t)(r >> 5) * 3 + (s - 29)) * 8192 + col, v0, v1); }
                else { const int t = row & 4095; if (t >= 4093) store8_f32(out + O_CCP + ((size_t)(row >> 12) * 3 + (t - 4093)) * 8192 + col, v0, v1); }
            }
        } else if (col < 12352) store8_f32(side + (size_t)row * 64 + (col - 12288), v0, v1);
    }
};

__device__ __forceinline__ void ln_phase(const Frame& F0, const float* __restrict__ xin_p, const float* __restrict__ xin_s, const bool x_f32, const float* __restrict__ mix, const float* __restrict__ part,
                                         const float* __restrict__ g, const float* __restrict__ bb, float* __restrict__ yout  , bf16* __restrict__ xn) {
    const Frame F = relaunder(F0);
    const int gw = blockIdx.x * NWAVES + F.wave, NGW = F.G * NWAVES;
    for (int row = gw; row < NTOK; row += NGW) {
        const float* xr = row < NP ? xin_p + (size_t)row * DM : xin_s + (size_t)(row - NP) * DM;
        f32x4 v[8]; float s = 0.f;
#pragma unroll
        for (int i = 0; i < 8; ++i) { const int c = (i * 64 + F.lane) * 4; f32x4 x, m;
            if (x_f32) x = *(const f32x4*)(xr + c);
            else { const v2u xb = *(const v2u*)(xn + (size_t)row * DM + c); x = (f32x4){__uint_as_float(xb.x << 16), __uint_as_float(xb.x & 0xffff0000u), __uint_as_float(xb.y << 16), __uint_as_float(xb.y & 0xffff0000u)}; }
            if (row < NP) { const v2u mb = *(const v2u*)((const bf16*)mix + (size_t)row * DM + c); m = (f32x4){__uint_as_float(mb.x << 16), __uint_as_float(mb.x & 0xffff0000u), __uint_as_float(mb.y << 16), __uint_as_float(mb.y & 0xffff0000u)}; }
            else { const bf16* pr = (const bf16*)part + (size_t)(row - NP) * DM + c; m = (f32x4){0.f, 0.f, 0.f, 0.f};
#pragma unroll
                for (int sl = 0; sl < 16; ++sl) { const v2u pb = *(const v2u*)(pr + (size_t)sl * NS * DM); m += (f32x4){__uint_as_float(pb.x << 16), __uint_as_float(pb.x & 0xffff0000u), __uint_as_float(pb.y << 16), __uint_as_float(pb.y & 0xffff0000u)}; } }
            v[i] = x * ALPHA + m; s += (v[i][0] + v[i][1]) + (v[i][2] + v[i][3]); }
        const float mean = wave_sum(s) * (1.f / DM); float q = 0.f;
#pragma unroll
        for (int i = 0; i < 8; ++i) { v[i] = v[i] - mean; q += (v[i][0] * v[i][0] + v[i][1] * v[i][1]) + (v[i][2] * v[i][2] + v[i][3] * v[i][3]); }
        const float rstd = 1.f / sqrtf(wave_sum(q) * (1.f / DM) + LN_EPS);
#pragma unroll
        for (int i = 0; i < 8; ++i) { const int c = (i * 64 + F.lane) * 4; const f32x4 gg = *(const f32x4*)(g + c), be = *(const f32x4*)(bb + c);
            const f32x4 y = v[i] * rstd * gg + be; if (yout) *(f32x4*)(yout + (size_t)row * DM + c) = y;
            v2u w; w.x = pk2(y[0], y[1]); w.y = pk2(y[2], y[3]); *(v2u*)(xn + (size_t)row * DM + c) = w; }
    }
}

__device__ __forceinline__ void attn_a_phase(const Frame& F0, unsigned char* ws, const float* __restrict__ rel_bias  ) {
    char* lds = (char*)F0.lds;
    float* bias_l = (float*)(lds + att::SHM_BIAS);
    const bf16* qkv = (const bf16*)(ws + WS_BIG); bf16* ao = (bf16*)(ws + WS_ATT);
    for (int u = blockIdx.x; u < 512; u += F0.G) {
        const Frame F = relaunder(F0);
        const int c4 = u & 15, h = (u >> 4) & 15, b = u >> 8, c0 = 4 * c4, kc0 = c0 >= 8 ? c0 - 8 : 0, NT = c0 + 4 - kc0;
        if (F.tid < 257) bias_l[F.tid] = rel_bias[h * 257 + F.tid] * (1.0f / att::SCALE);
        const size_t qrow = (size_t)b * SEQ + c0 * 64 + F.wave * 32;
        att::MaskAPrompt Mk{bias_l, c0 + (F.wave >> 1), kc0, (F.wave & 1) * 32};
        att::attn_body(qkv + qrow * A_N + h * 128, A_N, qkv + ((size_t)b * SEQ + kc0 * 64) * A_N + 2048 + h * 128, qkv + ((size_t)b * SEQ + kc0 * 64) * A_N + 4096 + h * 128, A_N,
                       ao + qrow * DM + h * 128, DM, true, NT, lds, Mk, F.tid);
    }
    for (int u = blockIdx.x; u < 256; u += F0.G) {
        const Frame F = relaunder(F0);
        const int h = u & 15, b = u >> 4;
        if (F.tid < 257) bias_l[F.tid] = rel_bias[h * 257 + F.tid] * (1.0f / att::SCALE);
        const size_t qrow = (size_t)NP + b * 32;
        att::MaskASample Mk{bias_l};
        att::attn_body(qkv + qrow * A_N + h * 128, A_N, (const bf16*)(ws + SA_CATK) + (size_t)b * A_CATROWS * 2048 + h * 128, (const bf16*)(ws + SA_CATV) + (size_t)b * A_CATROWS * 2048 + h * 128, 2048,
                       ao + qrow * DM + h * 128, DM, F.wave == 0, 10, lds, Mk, F.tid);
    }
}


typedef float f32x4m __attribute__((ext_vector_type(4)));
__device__ __forceinline__ unsigned fkey(float f) { const unsigned u = __float_as_uint(f); return (u & 0x80000000u) ? ~u : (u | 0x80000000u); }

__device__ __forceinline__ void idx_score_row(const bf16* __restrict__ qi  , const float* __restrict__ wi  , const bf16* __restrict__ kbase, int ldki, int ngrp,
                                              float* __restrict__ srow, int lane) {
    const int c = lane & 15, g = lane >> 4;
    const bf16x8 a0 = *(const bf16x8*)(qi + c * 64 + 8 * g), a1 = *(const bf16x8*)(qi + c * 64 + 32 + 8 * g);
    float w[4];
#pragma unroll
    for (int i = 0; i < 4; ++i) w[i] = wi[4 * g + i] * (0.25f * 0.125f);
    for (int gi = 0; gi < ngrp; ++gi) {
        float p[4];
#pragma unroll
        for (int t = 0; t < 4; ++t) {
            const bf16* kr = kbase + (size_t)(gi * 64 + t * 16 + c) * ldki + 8 * g;
            const bf16x8 b0 = *(const bf16x8*)kr, b1 = *(const bf16x8*)(kr + 32);
            f32x4m d = {0.f, 0.f, 0.f, 0.f};
            d = __builtin_amdgcn_mfma_f32_16x16x32_bf16(a0, b0, d, 0, 0, 0);
            d = __builtin_amdgcn_mfma_f32_16x16x32_bf16(a1, b1, d, 0, 0, 0);
            float s = w[0] * fmaxf(d[0], 0.f); s = fmaf(w[1], fmaxf(d[1], 0.f), s); s = fmaf(w[2], fmaxf(d[2], 0.f), s); s = fmaf(w[3], fmaxf(d[3], 0.f), s);
            s += __shfl_xor(s, 16); s += __shfl_xor(s, 32);
            p[t] = s;
        }
        const float mine = g == 0 ? p[0] : g == 1 ? p[1] : g == 2 ? p[2] : p[3];
        srow[gi * 64 + lane] = mine;
    }
}

__device__ __forceinline__ int wave_sum_i(int v) {
    { auto r = __builtin_amdgcn_permlane32_swap((unsigned)v, (unsigned)v, false, false); v = (int)r[0] + (int)r[1]; }
    { auto r = __builtin_amdgcn_permlane16_swap((unsigned)v, (unsigned)v, false, false); v = (int)r[0] + (int)r[1]; }
    v += __builtin_amdgcn_update_dpp(0, v, 0x128, 0xf, 0xf, false);
    v += __builtin_amdgcn_update_dpp(0, v, 0x124, 0xf, 0xf, false);
    v += __builtin_amdgcn_update_dpp(0, v, 0x122, 0xf, 0xf, false);
    v += __builtin_amdgcn_update_dpp(0, v, 0x121, 0xf, 0xf, false);
    return __builtin_amdgcn_readfirstlane(v);
}
__device__ __forceinline__ void idx_select_row(const float* __restrict__ srow, int L, unsigned* __restrict__ mrow, int nwords, int lane) {
    const int nj = (L + 63) >> 6;
    if (L <= 256) {
        for (int wd = lane; wd < nwords; wd += 64) { const int lo = wd * 32; mrow[wd] = (lo + 32 <= L) ? 0xffffffffu : (lo >= L ? 0u : ((1u << (L - lo)) - 1u)); }
        return;
    }
    unsigned key[64];
#pragma unroll
    for (int jb = 0; jb < 64; jb += 16) {
        if (jb < nj) {
            float sv[16];
#pragma unroll
            for (int j = 0; j < 16; ++j) { const int idx = (jb + j) * 64 + lane; sv[j] = __hip_atomic_load(srow + (idx < L ? idx : 0), __ATOMIC_RELAXED, __HIP_MEMORY_SCOPE_AGENT); }
#pragma unroll
            for (int j = 0; j < 16; ++j) { const int idx = (jb + j) * 64 + lane; key[jb + j] = idx < L ? fkey(sv[j]) : 0u; }
        } else {
#pragma unroll
            for (int j = 0; j < 16; ++j) key[jb + j] = 0u;
        }
    }
    unsigned T = 0u;
    for (int bit = 31; bit >= 0; --bit) {
        const unsigned cand = T | (1u << bit); int cn = 0;
#pragma unroll
        for (int jb = 0; jb < 64; jb += 16) if (jb < nj) {
#pragma unroll
            for (int j = 0; j < 16; ++j) cn += __popcll(__ballot(key[jb + j] >= cand)); }
        if (cn >= 256) T = cand;
        if (cn == 256) break;
    }
    int gv = 0;
#pragma unroll
    for (int j = 0; j < 64; ++j) gv += (key[j] > T) ? 1 : 0;
    int need = 256 - wave_sum_i(gv);
#pragma unroll
    for (int j = 0; j < 64; ++j) {
        unsigned long long sel = 0ull;
        if (j < nj) {
            sel = __ballot(key[j] > T);
            const unsigned long long tb = __ballot(key[j] == T && (j * 64 + lane) < L);
            if (need > 0 && tb != 0ull) { const int cc = __popcll(tb);
                if (cc <= need) { sel |= tb; need -= cc; }
                else { const unsigned long long below = tb & ((1ull << lane) - 1ull); sel |= __ballot(key[j] == T && (j * 64 + lane) < L && __popcll(below) < need); need = 0; } }
        }
        if (2 * j < nwords && lane == 0) { mrow[2 * j] = (unsigned)sel; mrow[2 * j + 1] = (unsigned)(sel >> 32); }
        __builtin_amdgcn_sched_barrier(0);
    }
}

constexpr int IDX_KROW = 144, IDX_KBUF = 64 * IDX_KROW;
__device__ __forceinline__ float xsum16_32(float s) {
    { auto r = __builtin_amdgcn_permlane16_swap(__float_as_uint(s), __float_as_uint(s), false, false); s = __uint_as_float(r[0]) + __uint_as_float(r[1]); }
    { auto r = __builtin_amdgcn_permlane32_swap(__float_as_uint(s), __float_as_uint(s), false, false); s = __uint_as_float(r[0]) + __uint_as_float(r[1]); }
    return s;
}
__device__ __forceinline__ void idx_phase(const Frame& F0, unsigned char* ws) {
    const bf16* big = (const bf16*)(ws + WS_BIG); const float* wi = (const float*)(ws + WS_SIDE);
    float* score = (float*)(ws + SB_SCORE); unsigned* mask = (unsigned*)(ws + SB_MASK);
    char* lds = (char*)F0.lds;
    for (int i = 0, u = blockIdx.x; u < 544; ++i, u += F0.G) {
        const Frame F = relaunder(F0);
        const int tid = F.tid, lane = F.lane;
        int uu = u; if (u < 512 && (i & 1)) uu = (u & ~255) + 255 - (u & 255);
        int rowb, L, ngrp, nwords, ldki; const bf16* kbase;
        if (uu < 512) { rowb = uu * 16; const int b = rowb >> 12, c = (rowb & 4095) >> 6; L = 64 * (c + 1); ngrp = c + 1; nwords = 128; kbase = big + (size_t)b * SEQ * B_NP + 4096; ldki = B_NP; }
        else { rowb = NP + (uu - 512) * 16; const int b = (rowb - NP) >> 5; L = 1056; ngrp = 17; nwords = 36; kbase = (const bf16*)(ws + SB_CATI) + (size_t)b * B_CATROWS * 64; ldki = 64; }
        const int row0 = rowb + 2 * F.wave;
        if (L > 256) {
            const int c = lane & 15, g = lane >> 4;
            bf16x8 a00, a01, a10, a11; float w0[4], w1[4];
            { const bf16* q0 = big + (size_t)row0 * B_NP + 3072 + c * 64 + 8 * g; const bf16* q1 = q0 + B_NP;
              a00 = *(const bf16x8*)q0; a01 = *(const bf16x8*)(q0 + 32); a10 = *(const bf16x8*)q1; a11 = *(const bf16x8*)(q1 + 32);
#pragma unroll
              for (int k = 0; k < 4; ++k) { w0[k] = wi[(size_t)row0 * 16 + 4 * g + k] * (0.25f * 0.125f); w1[k] = wi[(size_t)(row0 + 1) * 16 + 4 * g + k] * (0.25f * 0.125f); } }
            float* s0 = score + (size_t)row0 * 4096; float* s1 = s0 + 4096;
            const int skey = tid >> 3, sseg = tid & 7;
            const bf16* gsrc = kbase + (size_t)skey * ldki + sseg * 8;
            v4u stg = *(const v4u*)gsrc;
            *(v4u*)(lds + skey * IDX_KROW + sseg * 16) = stg;
            __syncthreads();
            for (int gi = 0; gi < ngrp; ++gi) {
                if (gi + 1 < ngrp) stg = *(const v4u*)(gsrc + (size_t)(gi + 1) * 64 * ldki);
                const char* kb = lds + (gi & 1) * IDX_KBUF + c * IDX_KROW + 16 * g;
                float p0[4], p1[4];
#pragma unroll
                for (int t = 0; t < 4; ++t) {
                    const bf16x8 b0 = *(const bf16x8*)(kb + t * 16 * IDX_KROW), b1 = *(const bf16x8*)(kb + t * 16 * IDX_KROW + 64);
                    f32x4m d0 = {0.f, 0.f, 0.f, 0.f}, d1 = {0.f, 0.f, 0.f, 0.f};
                    d0 = __builtin_amdgcn_mfma_f32_16x16x32_bf16(a00, b0, d0, 0, 0, 0); d0 = __builtin_amdgcn_mfma_f32_16x16x32_bf16(a01, b1, d0, 0, 0, 0);
                    d1 = __builtin_amdgcn_mfma_f32_16x16x32_bf16(a10, b0, d1, 0, 0, 0); d1 = __builtin_amdgcn_mfma_f32_16x16x32_bf16(a11, b1, d1, 0, 0, 0);
                    float x0 = w0[0] * fmaxf(d0[0], 0.f); x0 = fmaf(w0[1], fmaxf(d0[1], 0.f), x0); x0 = fmaf(w0[2], fmaxf(d0[2], 0.f), x0); x0 = fmaf(w0[3], fmaxf(d0[3], 0.f), x0);
                    float x1 = w1[0] * fmaxf(d1[0], 0.f); x1 = fmaf(w1[1], fmaxf(d1[1], 0.f), x1); x1 = fmaf(w1[2], fmaxf(d1[2], 0.f), x1); x1 = fmaf(w1[3], fmaxf(d1[3], 0.f), x1);
                    p0[t] = xsum16_32(x0); p1[t] = xsum16_32(x1);
                }
                s0[gi * 64 + lane] = g == 0 ? p0[0] : g == 1 ? p0[1] : g == 2 ? p0[2] : p0[3];
                s1[gi * 64 + lane] = g == 0 ? p1[0] : g == 1 ? p1[1] : g == 2 ? p1[2] : p1[3];
                if (gi + 1 < ngrp) *(v4u*)(lds + ((gi + 1) & 1) * IDX_KBUF + skey * IDX_KROW + sseg * 16) = stg;
                __syncthreads();
            }
            VM_WAIT();
        }
        for (int rr = 0; rr < 2; ++rr) idx_select_row(score + (size_t)(row0 + rr) * 4096, L, mask + (size_t)(row0 + rr) * 128, nwords, lane);
    }
}

__device__ __forceinline__ void attn_b_phase(const Frame& F0, unsigned char* ws) {
    char* lds = (char*)F0.lds;
    const bf16* big = (const bf16*)(ws + WS_BIG); bf16* ao = (bf16*)(ws + WS_ATT); const unsigned* mask = (const unsigned*)(ws + SB_MASK);
    for (int u = blockIdx.x; u < 512; u += F0.G) {
        const Frame F = relaunder(F0);
        const int bg = (u & 255) >> 5, c = (u < 256) ? (u & 31) : 63 - (u & 31), b = bg >> 2, g = bg & 3;
        const int NT = (c + 2) & ~1, head = 4 * g + (F.wave >> 1);
        const size_t qrow = (size_t)b * SEQ + c * 64 + (F.wave & 1) * 32;
        att::MaskBits Mk{mask + (qrow + (F.lane & 31)) * 128};
        att::attn_body(big + qrow * B_NP + head * 128, B_NP, big + (size_t)b * SEQ * B_NP + 2048 + g * 128, big + (size_t)b * SEQ * B_NP + 2560 + g * 128, B_NP,
                       ao + qrow * DM + head * 128, DM, true, NT, lds, Mk, F.tid);
    }
    for (int u = blockIdx.x; u < 64; u += F0.G) {
        const Frame F = relaunder(F0);
        const int b = u >> 2, g = u & 3, head = 4 * g + (F.wave & 3);
        const size_t qrow = (size_t)NP + b * 32;
        att::MaskBits Mk{mask + (qrow + (F.lane & 31)) * 128};
        att::attn_body(big + qrow * B_NP + head * 128, B_NP, (const bf16*)(ws + SB_CATK) + (size_t)b * B_CATROWS * 512 + g * 128, (const bf16*)(ws + SB_CATV) + (size_t)b * B_CATROWS * 512 + g * 128, 512,
                       ao + qrow * DM + head * 128, DM, F.wave < 4, 18, lds, Mk, F.tid);
    }
}

constexpr int C_UNITS = 4096 + 512;
constexpr size_t CU_W = 0, CU_U0T = 16384, CU_QG = 32768, CU_KT = 49152, CU_AQK = 65536, CU_BYTES = 73728;
constexpr size_t SC_UNITS = WS_SCR, SC_DECAY = SC_UNITS + (size_t)C_UNITS * CU_BYTES, SC_END = SC_DECAY + C_UNITS * 4;
static_assert(SC_END <= WS_S0COPY, "C scratch");
typedef float f32x16c __attribute__((ext_vector_type(16)));
__device__ __forceinline__ int crow16(int r, int h) { return (r & 3) + 8 * (r >> 2) + 4 * h; }
__device__ __forceinline__ float sigmoidf_(float x) { return __builtin_amdgcn_rcpf(1.f + __expf(-x)); }
__device__ __forceinline__ float siluf_(float x) { return x * __builtin_amdgcn_rcpf(1.f + __expf(-x)); }

constexpr int PL_QN = 0;
constexpr int PL_KN = PL_QN + 64 * 272;
constexpr int PL_KB = PL_KN + 64 * 272;
constexpr int PL_M = PL_KB + 64 * 272;
constexpr int PL_RHS = PL_M + 64 * 256;
constexpr int PL_VEC = PL_RHS + 64 * 1040;
constexpr int PL_END = PL_VEC + 5 * 256;
static_assert(PL_END <= 147456, "prep LDS");

constexpr int C_TLATE = 56, C_NEARLY = 2 * C_TLATE * 32 + 512, C_NLATE = 2 * (64 - C_TLATE) * 32;
template <int MODE> __device__ __forceinline__ void c_prep_phase(const Frame& F0, KArgs a, const int first, const int stride, const int count) {
    unsigned char* ws = a->ws;
    const bf16* big = (const bf16*)(ws + WS_BIG); const float* side = (const float*)(ws + WS_SIDE);
    const float* convw = a->in[I_CCONVW]; const float* cbuf = a->in[I_SCC];
    char* lds = (char*)F0.lds;
    for (int it = first; it < count; it += stride) {
        const Frame F = relaunder(F0);
        const int tid = F.tid, lane = F.lane, wave = F.wave;
        int uid = it;
        if constexpr (MODE == 0) { const int pe = 2 * C_TLATE * 32, per = C_TLATE * 32; const int sq = it >= per ? 1 : 0, rem = it - sq * per; uid = it < pe ? (sq * 64 + (rem >> 5)) * 32 + (it & 31) : 4096 + (it - pe); }
        if constexpr (MODE == 1) { const int per = (64 - C_TLATE) * 32; const int sq = it >= per ? 1 : 0, rem = it - sq * per; uid = (sq * 64 + C_TLATE + (rem >> 5)) * 32 + (it & 31); }
        const bool smp = uid >= 4096;
        const int hv = uid & 31, hq = hv >> 1;
        const int seq = smp ? (uid - 4096) >> 5 : uid >> 11, chunk = smp ? 0 : (uid >> 5) & 63;
        const int row0 = smp ? NP + seq * 32 : seq * SEQ + chunk * 64, nvalid = smp ? 32 : 64;
        bf16* qn = (bf16*)(lds + PL_QN); bf16* kn = (bf16*)(lds + PL_KN); bf16* kb = (bf16*)(lds + PL_KB);
        float* mL = (float*)(lds + PL_M); float* rhs = (float*)(lds + PL_RHS);
        float* Gv = (float*)(lds + PL_VEC); float* betav = Gv + 64; float* eGv = Gv + 128; float* rqv = Gv + 192; float* rkv = Gv + 256;
        unsigned char* ub = ws + SC_UNITS + (size_t)uid * CU_BYTES;
        if (wave == 7) {
            float beta = 0.f, g = 0.f;
            if (lane < nvalid) { const float* sr = side + (size_t)(row0 + lane) * 64;
                beta = sigmoidf_(sr[hv]); const float x = sr[32 + hv] + a->in[I_CDT][hv]; const float sp = x > 20.f ? x : __logf(1.f + __expf(x)); g = -__expf(a->in[I_CALOG][hv]) * sp; }
            float G = g;
#pragma unroll
            for (int o = 1; o < 64; o <<= 1) { const float t = __shfl_up(G, o); if (lane >= o) G += t; }
            Gv[lane] = G; betav[lane] = beta; eGv[lane] = __expf(G);
        }
        if (tid < 384) {
            const int grp = tid % 48, tb = tid / 48, part = grp >> 4, c8 = (grp & 15) * 8;
            const int ch = part == 0 ? hq * 128 + c8 : part == 1 ? 2048 + hq * 128 + c8 : 4096 + hv * 128 + c8;
            float* dst = part == 2 ? (float*)(lds + PL_QN) + c8 : rhs + (part == 1 ? 128 : 0) + c8; const int dstride = part == 2 ? 132 : 260;
            if (8 * tb < nvalid) {
                float w[4][8], xr[11][8];
#pragma unroll
                for (int j = 0; j < 4; ++j) { const f32x4 a0 = *(const f32x4*)(convw + (size_t)j * 8192 + ch), a1 = *(const f32x4*)(convw + (size_t)j * 8192 + ch + 4);
                    w[j][0] = a0[0]; w[j][1] = a0[1]; w[j][2] = a0[2]; w[j][3] = a0[3]; w[j][4] = a1[0]; w[j][5] = a1[1]; w[j][6] = a1[2]; w[j][7] = a1[3]; }
                bf16x8 xv[11];
#pragma unroll
                for (int i = 0; i < 11; ++i) { const int tt = 8 * tb - 3 + i; const bool ok = tt >= 0 || (!smp && chunk > 0);
                    xv[i] = *(const bf16x8*)(big + (size_t)(row0 + (ok ? tt : 0)) * C_NP + ch); }
#pragma unroll
                for (int i = 0; i < 11; ++i) { const int tt = 8 * tb - 3 + i; const bool ok = tt >= 0 || (!smp && chunk > 0);
#pragma unroll
                    for (int e = 0; e < 8; ++e) xr[i][e] = ok ? bf2f((bf16)xv[i][e]) : 0.f; }
                if (smp) {
#pragma unroll
                    for (int i = 0; i < 3; ++i) { const int tt = 8 * tb - 3 + i; const int r = tt < 0 ? 3 + tt : 0;
                        const float* cb = cbuf + ((size_t)seq * 3 + r) * 8192 + ch; const f32x4 a0 = *(const f32x4*)cb, a1 = *(const f32x4*)(cb + 4);
                        if (tt < 0) { xr[i][0] = a0[0]; xr[i][1] = a0[1]; xr[i][2] = a0[2]; xr[i][3] = a0[3]; xr[i][4] = a1[0]; xr[i][5] = a1[1]; xr[i][6] = a1[2]; xr[i][7] = a1[3]; } }
                }
#pragma unroll
                for (int t8 = 0; t8 < 8; ++t8) { f32x4 y0, y1;
#pragma unroll
                    for (int e = 0; e < 8; ++e) { float y = xr[t8][e] * w[0][e]; y = fmaf(xr[t8 + 1][e], w[1][e], y); y = fmaf(xr[t8 + 2][e], w[2][e], y); y = fmaf(xr[t8 + 3][e], w[3][e], y); y = siluf_(y);
                        if (e < 4) y0[e] = y; else y1[e - 4] = y; }
                    float* d = dst + (8 * tb + t8) * dstride; *(f32x4*)d = y0; *(f32x4*)(d + 4) = y1; }
            } else {
#pragma unroll
                for (int t8 = 0; t8 < 8; ++t8) { float* d = dst + (8 * tb + t8) * dstride; *(f32x4*)d = (f32x4){0.f, 0.f, 0.f, 0.f}; *(f32x4*)(d + 4) = (f32x4){0.f, 0.f, 0.f, 0.f}; }
            }
        }
        __syncthreads();
        { const int t = tid >> 3, sub = tid & 7; float sq = 0.f, sk = 0.f;
#pragma unroll
          for (int e = 0; e < 16; ++e) { const float q = rhs[t * 260 + sub * 16 + e], k = rhs[t * 260 + 128 + sub * 16 + e]; sq = fmaf(q, q, sq); sk = fmaf(k, k, sk); }
          sq += __shfl_xor(sq, 1); sq += __shfl_xor(sq, 2); sq += __shfl_xor(sq, 4); sk += __shfl_xor(sk, 1); sk += __shfl_xor(sk, 2); sk += __shfl_xor(sk, 4);
          if (sub == 0) { rqv[t] = rsqrtf(sq + RMS_EPS) * 0.08838834764831845f; rkv[t] = rsqrtf(sk + RMS_EPS); } }
        __syncthreads();
        { const int t = tid >> 3, sub = tid & 7; float q[16], k[16], vb[16];
          const float* vpark = (const float*)(lds + PL_QN) + t * 132 + sub * 16;
#pragma unroll
          for (int e = 0; e < 16; ++e) { q[e] = rhs[t * 260 + sub * 16 + e] * rqv[t]; k[e] = rhs[t * 260 + 128 + sub * 16 + e] * rkv[t]; vb[e] = vpark[e] * betav[t]; }
          __syncthreads();
          const float be = betav[t], eg = eGv[t];
#pragma unroll
          for (int e = 0; e < 16; e += 2) {
              *(unsigned*)(qn + t * 136 + sub * 16 + e) = pk2(q[e], q[e + 1]); *(unsigned*)(kn + t * 136 + sub * 16 + e) = pk2(k[e], k[e + 1]);
              *(unsigned*)(kb + t * 136 + sub * 16 + e) = pk2(k[e] * be, k[e + 1] * be); }
#pragma unroll
          for (int e = 0; e < 16; ++e) { rhs[t * 260 + sub * 16 + e] = vb[e]; rhs[t * 260 + 128 + sub * 16 + e] = k[e] * be * eg; }
        }
        __syncthreads();
        { const int r32 = lane & 31, h = lane >> 5, tile = wave & 3, mt = tile >> 1, nt = tile & 1;
          const bf16* Ab = (wave < 4 ? kb : qn) + (mt * 32 + r32) * 136 + 8 * h; const bf16* Bb = kn + (nt * 32 + r32) * 136 + 8 * h;
          f32x16c d = {};
#pragma unroll
          for (int s = 0; s < 8; ++s) d = __builtin_amdgcn_mfma_f32_32x32x16_bf16(*(const bf16x8*)(Ab + 16 * s), *(const bf16x8*)(Bb + 16 * s), d, 0, 0, 0);
          const int j = nt * 32 + r32; const float Gj = Gv[j];
          bf16* aqk = (bf16*)(ub + CU_AQK);
#pragma unroll
          for (int r = 0; r < 16; ++r) { const int i = mt * 32 + crow16(r, h); const float dec = __expf(fminf(Gv[i] - Gj, 0.f));
              if (wave < 4) mL[i * 64 + j] = (j < i) ? d[r] * dec : 0.f;
              else aqk[i * 64 + j] = (bf16)(pk2((j <= i) ? d[r] * dec : 0.f, 0.f) & 0xffffu); }
        }
        __syncthreads();
        if (wave < 4) {
            const int c = tid; float x[64];
            const LAS float* mLv = (const LAS float*)mL; asm volatile("" : "+v"(mLv));
#ifdef EXP_SOLVE2
            for (int rep_ = 0; rep_ < 2; ++rep_) { asm volatile("" ::: "memory");
#endif
#pragma unroll
            for (int ib = 0; ib < 16; ++ib) {
                float a0 = rhs[(4 * ib + 0) * 260 + c], a1 = rhs[(4 * ib + 1) * 260 + c], a2 = rhs[(4 * ib + 2) * 260 + c], a3 = rhs[(4 * ib + 3) * 260 + c];
#pragma unroll
                for (int jb = 0; jb < ib; ++jb) {
                    const f32x4 m0 = *(const LAS f32x4*)(mLv + (4 * ib + 0) * 64 + 4 * jb), m1 = *(const LAS f32x4*)(mLv + (4 * ib + 1) * 64 + 4 * jb),
                                m2 = *(const LAS f32x4*)(mLv + (4 * ib + 2) * 64 + 4 * jb), m3 = *(const LAS f32x4*)(mLv + (4 * ib + 3) * 64 + 4 * jb);
#pragma unroll
                    for (int e = 0; e < 4; ++e) { const float xv = x[4 * jb + e]; a0 = fmaf(-m0[e], xv, a0); a1 = fmaf(-m1[e], xv, a1); a2 = fmaf(-m2[e], xv, a2); a3 = fmaf(-m3[e], xv, a3); }
                }
                const f32x4 d1 = *(const LAS f32x4*)(mLv + (4 * ib + 1) * 64 + 4 * ib), d2 = *(const LAS f32x4*)(mLv + (4 * ib + 2) * 64 + 4 * ib), d3 = *(const LAS f32x4*)(mLv + (4 * ib + 3) * 64 + 4 * ib);
                x[4 * ib] = a0;
                a1 = fmaf(-d1[0], a0, a1); x[4 * ib + 1] = a1;
                a2 = fmaf(-d2[0], a0, a2); a2 = fmaf(-d2[1], a1, a2); x[4 * ib + 2] = a2;
                a3 = fmaf(-d3[0], a0, a3); a3 = fmaf(-d3[1], a1, a3); a3 = fmaf(-d3[2], a2, a3); x[4 * ib + 3] = a3;
            }
#ifdef EXP_SOLVE2
            }
#endif
#pragma unroll
            for (int i = 0; i < 64; ++i) rhs[i * 260 + c] = x[i];
        } else {
            const int t2 = tid - 256;
            bf16* qg = (bf16*)(ub + CU_QG); bf16* kt = (bf16*)(ub + CU_KT);
            const float Glast = Gv[63];
            for (int it = t2; it < 64 * 16; it += 256) { const int t = it >> 4, c8 = (it & 15) * 8; const float eg = eGv[t];
                const bf16x8 v = *(const bf16x8*)(qn + t * 136 + c8); v4u o;
                o.x = pk2(bf2f((bf16)v[0]) * eg, bf2f((bf16)v[1]) * eg); o.y = pk2(bf2f((bf16)v[2]) * eg, bf2f((bf16)v[3]) * eg); o.z = pk2(bf2f((bf16)v[4]) * eg, bf2f((bf16)v[5]) * eg); o.w = pk2(bf2f((bf16)v[6]) * eg, bf2f((bf16)v[7]) * eg);
                *(v4u*)(qg + t * 128 + c8) = o; }
            for (int it = t2; it < 128 * 8; it += 256) { const int dk = it & 127, t8 = (it >> 7) * 8; float f[8];
#pragma unroll
                for (int e = 0; e < 8; ++e) f[e] = bf2f(kn[(t8 + e) * 136 + dk]) * __expf(Glast - Gv[t8 + e]);
                v4u o; o.x = pk2(f[0], f[1]); o.y = pk2(f[2], f[3]); o.z = pk2(f[4], f[5]); o.w = pk2(f[6], f[7]);
                *(v4u*)(kt + dk * 64 + t8) = o; }
            if (t2 == 0) ((float*)(ws + SC_DECAY))[uid] = __expf(Glast);
        }
        __syncthreads();
        { bf16* Wg = (bf16*)(ub + CU_W); bf16* U0t = (bf16*)(ub + CU_U0T);
          for (int it = tid; it < 64 * 16; it += NTHR) { const int t = it >> 4, c8 = (it & 15) * 8; const float* s = rhs + t * 260 + 128 + c8;
              v4u o; o.x = pk2(s[0], s[1]); o.y = pk2(s[2], s[3]); o.z = pk2(s[4], s[5]); o.w = pk2(s[6], s[7]); *(v4u*)(Wg + t * 128 + c8) = o; }
          for (int it = tid; it < 128 * 8; it += NTHR) { const int dv = it & 127, t8 = (it >> 7) * 8; const float* s = rhs + t8 * 260 + dv;
              v4u o; o.x = pk2(s[0], s[260]); o.y = pk2(s[520], s[780]); o.z = pk2(s[1040], s[1300]); o.w = pk2(s[1560], s[1820]); *(v4u*)(U0t + dv * 64 + t8) = o; } }
        __syncthreads();
    }
}

constexpr int SL_W = 0, SL_QG = SL_W + 64 * 272, SL_KT = SL_QG + 64 * 272, SL_AQK = SL_KT + 128 * 144, SL_ST = SL_AQK + 64 * 144, SL_UT = SL_ST + 128 * 272, SL_END = SL_UT + 128 * 144;
constexpr int SL_O = 0;
static_assert(64 * 132 * 4 <= SL_KT && SL_END <= 147456, "scan LDS");

struct ScanPf { v4u w0, w1, q0, q1, k0, k1, aq; v2u u0, u1, u2, u3; v4u z0, z1; float decay; };
__device__ __forceinline__ void c_scan_phase(const Frame& F0, KArgs a) {
    unsigned char* ws = a->ws; char* lds = (char*)F0.lds;
    const bf16* big = (const bf16*)(ws + WS_BIG); bf16* og = (bf16*)(ws + WS_ATT); const float* normw = a->in[I_CNORM];
    const int G = F0.G; const bool few = G <= 64;
    gu32* lpw = (gu32*)((unsigned*)(ws + WS_CTL) + CW_QB);
    if (!few && blockIdx.x >= 64) {
        c_prep_phase<1>(F0, a, (int)blockIdx.x - 64, G - 64, C_NLATE);
        asm volatile("s_waitcnt vmcnt(0)" ::: "memory");
        __syncthreads();
        if (relaunder(F0).tid == 0) { __builtin_amdgcn_fence(__ATOMIC_RELEASE, "agent"); asm volatile("s_waitcnt vmcnt(0)" ::: "memory"); (void)__hip_atomic_fetch_add(lpw, 1u, __ATOMIC_RELAXED, __HIP_MEMORY_SCOPE_AGENT); }
    }
    for (int pass = 0; pass < 2; ++pass) {
        int first, stride, count;
        if (pass == 0) { first = blockIdx.x; stride = G; count = 64; if (!few && blockIdx.x >= 64) count = 0; }
        else { if (few) { first = blockIdx.x; stride = G; } else { first = (int)blockIdx.x - 64; stride = G - 64; } count = 512; if (first < 0) { first = 0; count = 0; } }
        for (int ch = first; ch < count; ch += stride) {
            const Frame F = relaunder(F0);
            const int tid = F.tid, lane = F.lane, wave = F.wave, r32 = lane & 31, h = lane >> 5;
            const bool smp = pass == 1;
            const int seq = ch >> 5, hv = ch & 31, nsteps = smp ? 1 : 64, nvalid = smp ? 32 : 64;
            const int mt = wave & 1, nt = wave >> 1;
            const int dvc = nt * 32 + r32;
            const int tn = tid >> 3, sub = tid & 7;
            f32x16c S0 = {}, S1 = {};
            if (smp) { const float* s0 = a->in[I_SCS] + ((size_t)(seq * 32 + hv) * 128) * 128;
#pragma unroll
                for (int r = 0; r < 16; ++r) { S0[r] = s0[(size_t)((2 * mt) * 32 + crow16(r, h)) * 128 + dvc]; S1[r] = s0[(size_t)((2 * mt + 1) * 32 + crow16(r, h)) * 128 + dvc]; } }
            bf16* Wl = (bf16*)(lds + SL_W); bf16* Ql = (bf16*)(lds + SL_QG); bf16* Kl = (bf16*)(lds + SL_KT); bf16* Al = (bf16*)(lds + SL_AQK);
            bf16* St = (bf16*)(lds + SL_ST); bf16* ut = (bf16*)(lds + SL_UT); float* ol = (float*)(lds + SL_O);
#define SCAN_FETCH(P, st) do { const int uid_ = smp ? 4096 + ch : (seq * 64 + (st)) * 32 + hv; const int row0_ = smp ? NP + seq * 32 : seq * SEQ + (st) * 64;                 \
                const unsigned char* ub_ = ws + SC_UNITS + (size_t)uid_ * CU_BYTES;                                                                                                  \
                { const int t_ = tid >> 4, c8_ = (tid & 15) * 8; P.w0 = *(const v4u*)((const bf16*)(ub_ + CU_W) + t_ * 128 + c8_); P.w1 = *(const v4u*)((const bf16*)(ub_ + CU_W) + (t_ + 32) * 128 + c8_);        \
                  P.q0 = *(const v4u*)((const bf16*)(ub_ + CU_QG) + t_ * 128 + c8_); P.q1 = *(const v4u*)((const bf16*)(ub_ + CU_QG) + (t_ + 32) * 128 + c8_); }                                                 \
                { const int dk_ = tid >> 3, c8_ = (tid & 7) * 8; P.k0 = *(const v4u*)((const bf16*)(ub_ + CU_KT) + dk_ * 64 + c8_); P.k1 = *(const v4u*)((const bf16*)(ub_ + CU_KT) + (dk_ + 64) * 64 + c8_);       \
                  P.aq = *(const v4u*)((const bf16*)(ub_ + CU_AQK) + dk_ * 64 + c8_); }                                                                                              \
                { const bf16* U0t_ = (const bf16*)(ub_ + CU_U0T) + dvc * 64 + mt * 32 + 4 * h; P.u0 = *(const v2u*)(U0t_); P.u1 = *(const v2u*)(U0t_ + 8); P.u2 = *(const v2u*)(U0t_ + 16); P.u3 = *(const v2u*)(U0t_ + 24); } \
                { const int tz_ = tn < nvalid ? tn : 0; const bf16* zr_ = big + (size_t)(row0_ + tz_) * C_NP + 8192 + hv * 128 + sub * 16; P.z0 = *(const v4u*)zr_; P.z1 = *(const v4u*)(zr_ + 8); }          \
                P.decay = ((const float*)(ws + SC_DECAY))[uid_]; } while (0)
#define SCAN_STAGE(P) do { { const int t_ = tid >> 4, c8_ = (tid & 15) * 8; *(v4u*)(Wl + t_ * 136 + c8_) = P.w0; *(v4u*)(Wl + (t_ + 32) * 136 + c8_) = P.w1; *(v4u*)(Ql + t_ * 136 + c8_) = P.q0; *(v4u*)(Ql + (t_ + 32) * 136 + c8_) = P.q1; } \
                { const int dk_ = tid >> 3, c8_ = (tid & 7) * 8; *(v4u*)(Kl + dk_ * 72 + c8_) = P.k0; *(v4u*)(Kl + (dk_ + 64) * 72 + c8_) = P.k1; *(v4u*)(Al + dk_ * 72 + c8_) = P.aq; } } while (0)
            ScanPf cur, nxt;
            SCAN_FETCH(cur, 0);
            SCAN_STAGE(cur);
            nxt = cur;
            for (int step = 0; step < nsteps; ++step) {
                const int row0 = smp ? NP + seq * 32 : seq * SEQ + step * 64;
                if (!smp && !few && step + 1 == C_TLATE) {
                    if (tid == 0) { unsigned sp = 0u; while (__hip_atomic_load(lpw, __ATOMIC_RELAXED, __HIP_MEMORY_SCOPE_AGENT) < (unsigned)(G - 64) && ++sp < (1u << 20)) __builtin_amdgcn_s_sleep(2);
                        __builtin_amdgcn_fence(__ATOMIC_ACQUIRE, "agent"); asm volatile("s_waitcnt vmcnt(0)" ::: "memory"); }
                    __syncthreads();
                }
                if (step + 1 < nsteps) SCAN_FETCH(nxt, step + 1);
#pragma unroll
                for (int q = 0; q < 4; ++q) {
                    v2u w0, w1; w0.x = pk2(S0[4 * q], S0[4 * q + 1]); w0.y = pk2(S0[4 * q + 2], S0[4 * q + 3]); w1.x = pk2(S1[4 * q], S1[4 * q + 1]); w1.y = pk2(S1[4 * q + 2], S1[4 * q + 3]);
                    *(v2u*)(St + dvc * 136 + (2 * mt) * 32 + 8 * q + 4 * h) = w0; *(v2u*)(St + dvc * 136 + (2 * mt + 1) * 32 + 8 * q + 4 * h) = w1; }
                f32x16c u;
#define SCAN_U0(q, W) do { u[4 * q] = __uint_as_float(W.x << 16); u[4 * q + 1] = __uint_as_float(W.x & 0xffff0000u); u[4 * q + 2] = __uint_as_float(W.y << 16); u[4 * q + 3] = __uint_as_float(W.y & 0xffff0000u); } while (0)
                SCAN_U0(0, cur.u0); SCAN_U0(1, cur.u1); SCAN_U0(2, cur.u2); SCAN_U0(3, cur.u3);
                __syncthreads();
                f32x16c ws_acc = {}, o = {};
#pragma unroll
                for (int s = 0; s < 8; ++s) { const bf16x8 bS = *(const bf16x8*)(St + dvc * 136 + 16 * s + 8 * h);
                    ws_acc = __builtin_amdgcn_mfma_f32_32x32x16_bf16(*(const bf16x8*)(Wl + (mt * 32 + r32) * 136 + 16 * s + 8 * h), bS, ws_acc, 0, 0, 0);
                    o = __builtin_amdgcn_mfma_f32_32x32x16_bf16(*(const bf16x8*)(Ql + (mt * 32 + r32) * 136 + 16 * s + 8 * h), bS, o, 0, 0, 0); }
#pragma unroll
                for (int r = 0; r < 16; ++r) u[r] -= ws_acc[r];
#pragma unroll
                for (int q = 0; q < 4; ++q) { v2u w; w.x = pk2(u[4 * q], u[4 * q + 1]); w.y = pk2(u[4 * q + 2], u[4 * q + 3]); *(v2u*)(ut + dvc * 72 + mt * 32 + 8 * q + 4 * h) = w; }
                __syncthreads();
                const float decay = cur.decay;
#pragma unroll
                for (int r = 0; r < 16; ++r) { S0[r] *= decay; S1[r] *= decay; }
#pragma unroll
                for (int s = 0; s < 4; ++s) { const bf16x8 bU = *(const bf16x8*)(ut + dvc * 72 + 16 * s + 8 * h);
                    o = __builtin_amdgcn_mfma_f32_32x32x16_bf16(*(const bf16x8*)(Al + (mt * 32 + r32) * 72 + 16 * s + 8 * h), bU, o, 0, 0, 0);
                    S0 = __builtin_amdgcn_mfma_f32_32x32x16_bf16(*(const bf16x8*)(Kl + ((2 * mt) * 32 + r32) * 72 + 16 * s + 8 * h), bU, S0, 0, 0, 0);
                    S1 = __builtin_amdgcn_mfma_f32_32x32x16_bf16(*(const bf16x8*)(Kl + ((2 * mt + 1) * 32 + r32) * 72 + 16 * s + 8 * h), bU, S1, 0, 0, 0); }
#pragma unroll
                for (int r = 0; r < 16; ++r) ol[(mt * 32 + crow16(r, h)) * 132 + dvc] = o[r];
                __syncthreads();
                { float v[16]; float ss = 0.f;
#pragma unroll
                  for (int e = 0; e < 16; ++e) { v[e] = ol[tn * 132 + sub * 16 + e]; ss = fmaf(v[e], v[e], ss); }
                  ss += __shfl_xor(ss, 1); ss += __shfl_xor(ss, 2); ss += __shfl_xor(ss, 4);
                  const float rs = rsqrtf(ss * (1.f / 128.f) + RMS_EPS);
                  if (tn < nvalid) {
                      const unsigned zw[8] = {cur.z0.x, cur.z0.y, cur.z0.z, cur.z0.w, cur.z1.x, cur.z1.y, cur.z1.z, cur.z1.w};
                      float y[16];
#pragma unroll
                      for (int e = 0; e < 16; ++e) { const float z = (e & 1) ? __uint_as_float(zw[e >> 1] & 0xffff0000u) : __uint_as_float(zw[e >> 1] << 16); y[e] = v[e] * rs * normw[sub * 16 + e] * siluf_(z); }
                      v4u o0, o1; o0.x = pk2(y[0], y[1]); o0.y = pk2(y[2], y[3]); o0.z = pk2(y[4], y[5]); o0.w = pk2(y[6], y[7]); o1.x = pk2(y[8], y[9]); o1.y = pk2(y[10], y[11]); o1.z = pk2(y[12], y[13]); o1.w = pk2(y[14], y[15]);
                      bf16* dst = og + (size_t)(row0 + tn) * C_VD + hv * 128 + sub * 16; *(v4u*)dst = o0; *(v4u*)(dst + 8) = o1; } }
                __syncthreads();
                if (step + 1 < nsteps) { SCAN_STAGE(nxt); cur = nxt; }
            }
            { float* so = a->out + (smp ? O_CSS : O_CSP) + ((size_t)(seq * 32 + hv) * 128) * 128;
#pragma unroll
              for (int r = 0; r < 16; ++r) { so[(size_t)((2 * mt) * 32 + crow16(r, h)) * 128 + dvc] = S0[r]; so[(size_t)((2 * mt + 1) * 32 + crow16(r, h)) * 128 + dvc] = S1[r]; } }
#undef SCAN_FETCH
#undef SCAN_STAGE
#undef SCAN_U0
        }
    }
    { const Frame F = relaunder(F0); __syncthreads();
      if (few) convert_weights<true>(F, a, blockIdx.x * NWAVES + F.wave, G * NWAVES);
      else if (blockIdx.x >= 64) convert_weights<true>(F, a, ((int)blockIdx.x - 64) * NWAVES + F.wave, (G - 64) * NWAVES); }
}

template <int PH> __device__ __forceinline__ void run_phase(const Frame& F, const int layer) {
    const KArgs KA = kargs();
    unsigned char* ws = KA->ws;
    const int kind = layer % 3, j = layer / 3;
    if constexpr (PH == 0) { p0_prologue(F, KA); }
    if constexpr (PH == 1) {
        pg8::Gemm g{(const bf16*)(ws + WS_XN), (const bf16*)(ws + WS_WA_IN) + (size_t)j * A_N * DM, NTOK, A_N, DM};
        pg8::StaticOrder S; S.init(NTOK, A_N, F.G, launder_s((int)blockIdx.x), DM);
        pg8::EpiF<FnAqkv> E{{(bf16*)(ws + WS_BIG), KA->out, (bf16*)(ws + SA_CATK), (bf16*)(ws + SA_CATV), j}};
        pg8::gemm_phase<pg8::EpiF<FnAqkv>, pg8::StaticOrder, true, true>(F.lds, g, S, E, relaunder(F).tid);
        cat_rows(F, KA->in[I_CAK] + (size_t)j * 16 * 512 * 2048, (bf16*)(ws + SA_CATK), 16, 512, 2048, A_CATROWS, 544);
        cat_rows(F, KA->in[I_CAV] + (size_t)j * 16 * 512 * 2048, (bf16*)(ws + SA_CATV), 16, 512, 2048, A_CATROWS, 544);
    }
    if constexpr (PH == 2) attn_a_phase(F, ws, KA->in[I_ABIAS] + (size_t)j * 16 * 257);
    if constexpr (PH == 3) {
        pg8::Gemm g{(const bf16*)(ws + WS_XN), (const bf16*)(ws + WS_WB_IN), NTOK, B_NP, DM};
        pg8::StaticOrder S; S.init(NTOK, B_NP, F.G, launder_s((int)blockIdx.x), DM);
        pg8::EpiF<FnBproj> E{{(bf16*)(ws + WS_BIG), KA->out, (float*)(ws + WS_SIDE), (bf16*)(ws + SB_CATK), (bf16*)(ws + SB_CATV), (bf16*)(ws + SB_CATI)}};
        pg8::gemm_phase<pg8::EpiF<FnBproj>, pg8::StaticOrder, true, true>(F.lds, g, S, E, relaunder(F).tid);
        cat_rows(F, KA->in[I_CBK], (bf16*)(ws + SB_CATK), 16, 1024, 512, B_CATROWS, 1056);
        cat_rows(F, KA->in[I_CBV], (bf16*)(ws + SB_CATV), 16, 1024, 512, B_CATROWS, 1056);
        cat_rows(F, KA->in[I_CBI], (bf16*)(ws + SB_CATI), 16, 1024, 64, B_CATROWS, 1056);
    }
    if constexpr (PH == 4) idx_phase(F, ws);
    if constexpr (PH == 5) attn_b_phase(F, ws);
    if constexpr (PH == 6) {
        pg8::Gemm g{(const bf16*)(ws + WS_XN), (const bf16*)(ws + WS_WC_IN), NTOK, C_NP, DM};
        pg8::StaticOrder S; S.init(NTOK, C_NP, F.G, launder_s((int)blockIdx.x), DM);
        pg8::EpiF<FnCproj> E{{(bf16*)(ws + WS_BIG), KA->out, (float*)(ws + WS_SIDE)}};
        pg8::gemm_phase<pg8::EpiF<FnCproj>, pg8::StaticOrder, true, true>(F.lds, g, S, E, relaunder(F).tid);
    }
    if constexpr (PH == 7) { if (F.G > 64) c_prep_phase<0>(F, KA, (int)blockIdx.x, F.G, C_NEARLY); else c_prep_phase<2>(F, KA, (int)blockIdx.x, F.G, C_UNITS); }
    if constexpr (PH == 8) c_scan_phase(F, KA);
    if constexpr (PH == 9) {
        const bf16* wout = kind == 0 ? (const bf16*)(ws + WS_WA_OUT) + (size_t)j * DM * DM : kind == 1 ? (const bf16*)(ws + WS_WB_OUT) : (const bf16*)(ws + WS_WC_OUT);
        pg8::Gemm g{(const bf16*)(ws + WS_ATT), wout, NTOK, DM, kind == 2 ? C_VD : DM};
        pg8::SplitOrder S; S.init(launder_s((int)blockIdx.x), g.K);
        pg8::EpiF<FnMix> E{{(float*)(ws + WS_MIX), (float*)(ws + WS_PART)}};
        pg8::gemm_phase<pg8::EpiF<FnMix>, pg8::SplitOrder, true, true>(F.lds, g, S, E, relaunder(F).tid);
    }
    if constexpr (PH == 10) {
        ln_phase(F, KA->in[I_XP], KA->in[I_XS], layer == 0, (const float*)(ws + WS_MIX), (const float*)(ws + WS_PART), KA->in[I_LN1G] + layer * DM, KA->in[I_LN1B] + layer * DM, nullptr, (bf16*)(ws + WS_XN));
    }
    if constexpr (PH == 11) {
        pg8::Gemm g{(const bf16*)(ws + WS_XN), (const bf16*)(ws + WS_W1) + (size_t)layer * DFF * DM, NTOK, DFF, DM};
        pg8::StaticOrder S; S.init(NTOK, DFF, F.G, launder_s((int)blockIdx.x), DM);
        pg8::EpiF<FnRelu2> E{{(bf16*)(ws + WS_BIG)}};
        pg8::gemm_phase<pg8::EpiF<FnRelu2>, pg8::StaticOrder, true, true>(F.lds, g, S, E, relaunder(F).tid);
    }
    if constexpr (PH == 12) {
        pg8::Gemm g{(const bf16*)(ws + WS_BIG), (const bf16*)(ws + WS_W2) + (size_t)layer * DM * DFF, NTOK, DM, DFF};
        pg8::SplitOrder S; S.init(launder_s((int)blockIdx.x), DFF);
        pg8::EpiF<FnMix> E{{(float*)(ws + WS_MIX), (float*)(ws + WS_PART)}};
        pg8::gemm_phase<pg8::EpiF<FnMix>, pg8::SplitOrder, true, true>(F.lds, g, S, E, relaunder(F).tid);
    }
    if constexpr (PH == 13) ln_phase(F, KA->in[I_XP], KA->in[I_XS], false, (const float*)(ws + WS_MIX), (const float*)(ws + WS_PART), KA->in[I_LN2G] + layer * DM, KA->in[I_LN2B] + layer * DM, layer == DEPTH - 1 ? KA->out + O_YP : nullptr, (bf16*)(ws + WS_XN));
}

constexpr int LDS_BYTES = 147456, MISC_OFF = LDS_BYTES - 64;
#ifndef MK_SINGLE
#define MK_SINGLE 1
#endif
#ifndef MULTIK
__global__ void __launch_bounds__(NTHR, 2) mk_fwd(Args args) {
    extern __shared__ __attribute__((aligned(16))) unsigned char lds_raw[];
    Frame F; F.lds = (LAS unsigned char*)lds_raw;
    F.tid = threadIdx.x; F.lane = F.tid & 63; F.wave = __builtin_amdgcn_readfirstlane(F.tid >> 6);
    F.G = gridDim.x; { const int bx = blockIdx.x; F.vcu = (F.G % 8 == 0) ? (bx % 8) * (F.G / 8) + bx / 8 : bx; }
    const int lo = args.ph_lo, hi = args.ph_hi;
    volatile LAS unsigned* misc = (volatile LAS unsigned*)(F.lds + MISC_OFF);
    if (F.tid < 16) misc[F.tid] = 0u;
    __syncthreads();
    XcdBarrier bar; bar.bar = (unsigned*)(args.ws + WS_CTL) + CW_BAR; bar.x = 0; bar.st = misc;
    if (MK_SINGLE) bar = xcd_barrier_post((unsigned*)(args.ws + WS_CTL) + CW_BAR, misc);
#define IN(k) (lo <= (k) && (k) < hi)
#define SEAM(k) do { if (MK_SINGLE && hi > (k) + 1) xcd_barrier(bar); } while (0)
    if (IN(0)) { run_phase<0>(F, 0); SEAM(0); }
    for (int layer = 0; layer < DEPTH; ++layer) {
        const int kind = layer % 3, base = 1 + 8 * layer;
        if (kind == 0) {
            if (IN(base + 0)) { run_phase<1>(F, layer); SEAM(base + 0); }
            if (IN(base + 1)) { run_phase<2>(F, layer); SEAM(base + 1); }
        } else if (kind == 1) {
            if (IN(base + 0)) { run_phase<3>(F, layer); SEAM(base + 0); }
            if (IN(base + 1)) { run_phase<4>(F, layer); SEAM(base + 1); }
            if (IN(base + 2)) { run_phase<5>(F, layer); SEAM(base + 2); }
        } else {
            if (IN(base + 0)) { run_phase<6>(F, layer); SEAM(base + 0); }
            if (IN(base + 1)) { run_phase<7>(F, layer); SEAM(base + 1); }
            if (IN(base + 2)) { run_phase<8>(F, layer); SEAM(base + 2); }
        }
        if (IN(base + 3)) { run_phase<9>(F, layer); SEAM(base + 3); }
        if (IN(base + 4)) { run_phase<10>(F, layer); SEAM(base + 4); }
        if (IN(base + 5)) { run_phase<11>(F, layer); SEAM(base + 5); }
        if (IN(base + 6)) { run_phase<12>(F, layer); SEAM(base + 6); }
        if (IN(base + 7)) { run_phase<13>(F, layer); SEAM(base + 7); }
    }
#undef IN
#undef SEAM
}
#endif

#ifdef MULTIK
template <int PH> __global__ void __launch_bounds__(NTHR, 2) k_phase(Args args, int layer) {
    extern __shared__ __attribute__((aligned(16))) unsigned char lds_raw[];
    Frame F; F.lds = (LAS unsigned char*)lds_raw;
    F.tid = threadIdx.x; F.lane = F.tid & 63; F.wave = __builtin_amdgcn_readfirstlane(F.tid >> 6);
    F.G = gridDim.x; F.vcu = blockIdx.x;
    run_phase<PH>(F, layer);
}
template <int PH> static void launch_phase(const Args& a, int layer, int grid, hipStream_t stream) {
    static bool attr = false;
    if (!attr) { (void)hipFuncSetAttribute((const void*)k_phase<PH>, hipFuncAttributeMaxDynamicSharedMemorySize, LDS_BYTES); attr = true; }
    hipLaunchKernelGGL(k_phase<PH>, dim3(grid), dim3(NTHR), LDS_BYTES, stream, a, layer);
#ifdef DBL_K
    if (PH == DBL_K) hipLaunchKernelGGL(k_phase<PH>, dim3(grid), dim3(NTHR), LDS_BYTES, stream, a, layer);
#endif
}
#endif
extern "C" void kernel_launch(void* const* d_in, const int* in_sizes, int n_in, void* d_out, int out_size, void* d_ws, size_t ws_size, hipStream_t stream) {
    static int grid = 0;
    if (grid == 0) {
        if (n_in != N_IN || (size_t)out_size != O_END || ws_size < WS_END) { fprintf(stderr, "kernel_launch: shape mismatch n_in %d out %d ws %zu (need %zu)\n", n_in, out_size, ws_size, (size_t)WS_END); grid = -1; return; }
        { const long exp_sz[N_IN] = {(long)NP * DM, (long)NS * DM, 2L * 16 * 512 * 2048, 2L * 16 * 512 * 2048, 16L * 1024 * 512, 16L * 1024 * 512, 16L * 1024 * 64, 16L * 3 * 8192, 16L * 32 * 128 * 128,
                                       2L * DM * A_N, 2L * 16 * 257, 2L * DM * DM, (long)DM * B_N, (long)DM * DM, (long)DM * C_N, 4L * 8192, 32, 32, 128, (long)C_VD * DM,
                                       4L * DM, 4L * DM, 4L * DM * DFF, 4L * DFF * DM, 4L * DM, 4L * DM};
          for (int i = 0; i < N_IN; ++i) if ((long)in_sizes[i] != exp_sz[i]) { fprintf(stderr, "kernel_launch: input %d has %d elements, expected %ld\n", i, in_sizes[i], exp_sz[i]); grid = -1; return; } }
        int dev = 0, cus = 0, per_cu = 0;
        if (hipGetDevice(&dev) != hipSuccess || hipDeviceGetAttribute(&cus, hipDeviceAttributeMultiprocessorCount, dev) != hipSuccess) { grid = -1; return; }
#ifndef MULTIK
        if (hipFuncSetAttribute((const void*)mk_fwd, hipFuncAttributeMaxDynamicSharedMemorySize, LDS_BYTES) != hipSuccess) { grid = -1; return; }
        if (hipOccupancyMaxActiveBlocksPerMultiprocessor(&per_cu, (const void*)mk_fwd, NTHR, LDS_BYTES) != hipSuccess || per_cu < 1) fprintf(stderr, "kernel_launch: occupancy query says %d workgroups per CU\n", per_cu);
#endif
        (void)hipGetLastError();
        grid = cus;
        if (grid != 256) { fprintf(stderr, "kernel_launch: built for a 256-CU device (split-K deal), found %d CUs; nothing launched\n", grid); grid = -1; return; }
    }
    if (grid < 0) return;
    (void)hipMemsetAsync((char*)d_ws + WS_CTL, 0, CTL_ZERO_BYTES, stream);
    Args a{};
    for (int i = 0; i < N_IN; ++i) a.in[i] = (const float*)d_in[i];
    a.out = (float*)d_out; a.ws = (unsigned char*)d_ws;
#ifdef MULTIK
    launch_phase<0>(a, 0, grid, stream);
    for (int layer = 0; layer < DEPTH; ++layer) {
        const int kind = layer % 3;
        if (kind == 0) { launch_phase<1>(a, layer, grid, stream); launch_phase<2>(a, layer, grid, stream); }
        else if (kind == 1) { launch_phase<3>(a, layer, grid, stream); launch_phase<4>(a, layer, grid, stream); launch_phase<5>(a, layer, grid, stream); }
        else { launch_phase<6>(a, layer, grid, stream); launch_phase<7>(a, layer, grid, stream); launch_phase<8>(a, layer, grid, stream); }
        launch_phase<9>(a, layer, grid, stream); launch_phase<10>(a, layer, grid, stream); launch_phase<11>(a, layer, grid, stream); launch_phase<12>(a, layer, grid, stream); launch_phase<13>(a, layer, grid, stream);
    }
    return;
#else
    if (MK_SINGLE) { a.ph_lo = 0; a.ph_hi = 1 + 8 * DEPTH; hipLaunchKernelGGL(mk_fwd, dim3(grid), dim3(NTHR), LDS_BYTES, stream, a); }
    else for (int ph = 0; ph < 1 + 8 * DEPTH; ++ph) { if (ph == 3 || ph == 27) continue; a.ph_lo = ph; a.ph_hi = ph + 1; hipLaunchKernelGGL(mk_fwd, dim3(grid), dim3(NTHR), LDS_BYTES, stream, a); }
#endif
}
```

```cpp
#include <hip/hip_runtime.h>
#include <cstdio>
#include <cstdint>
namespace pg8 {
#define PG8_LAS __attribute__((address_space(3)))
typedef unsigned short bf16_t;
typedef short bf16x8 __attribute__((ext_vector_type(8)));
typedef float f32x4 __attribute__((ext_vector_type(4)));
typedef unsigned u32x4 __attribute__((ext_vector_type(4)));
constexpr int BM = 256, BK = 64, HALF = 128, HTB = HALF * BK * 2  , STAGE_BYTES = 8 * HTB, NXCD = 8, WGM = 8;

__host__ __device__ __forceinline__ int lds_byte(int r, int c) { const int st = (r >> 4) * 2 + (c >> 5), rr = r & 15, cc = c & 31, ob = rr * 64 + cc * 2; return st * 1024 + (ob ^ (((ob >> 9) & 1) << 5)); }
__host__ __device__ __forceinline__ void stage_rc(int b, int& R, int& C) { const int st = b / 1024, sb = b % 1024, swz = sb ^ (((sb >> 9) & 1) << 5); R = (st >> 1) * 16 + swz / 64; C = (st & 1) * 32 + (swz % 64) / 2; }
__host__ __device__ __forceinline__ int perm32(int rho) { const int n = rho >> 4, i = rho & 15; return 8 * (i >> 2) + 4 * n + (i & 3); }

struct Unit { int pm, pn, k0, nt, ks; };
struct Gemm { const bf16_t* A; const bf16_t* Bt; int M, N, K; };

struct StaticOrder {
    int nM, nN, nwg, G, c, Kt;
    __host__ __device__ void init(int M, int N, int G_, int c_, int K_) { nM = M / BM; nN = N / BM; nwg = nM * nN; G = G_; c = c_; Kt = K_ / BK; }
    __host__ __device__ bool next(int i, Unit& u) const {
        const long L = (long)i * G + c; if (L >= nwg) return false;
        int wgid = (int)L; { const int q = nwg / NXCD, r = nwg % NXCD, xcd = wgid % NXCD, off = wgid / NXCD; wgid = (xcd < r ? xcd * (q + 1) : r * (q + 1) + (xcd - r) * q) + off; }
        const int nig = WGM * nN, gid = wgid / nig, fm = gid * WGM, gsz = (nM - fm) < WGM ? (nM - fm) : WGM;
        u.pm = fm + ((wgid % nig) % gsz); u.pn = (wgid % nig) / gsz; u.k0 = 0; u.nt = Kt; u.ks = 0; return true;
    }
    __device__ __forceinline__ void a_ready(const Unit&) const {}
    __device__ __forceinline__ void done(const Unit&) const {}
};


struct SplitOrder {
    int c, Kt;
    __host__ __device__ void init(int c_, int K_) { c = c_; Kt = K_ / BK; }
    __host__ __device__ bool next(int i, Unit& u) const {
        if (i == 0) { const int xcd = c & 7, off = c >> 3;
            const int w = xcd * 32 + off; u.pm = (w >> 5) * 4 + (w & 3); u.pn = (w >> 2) & 7; u.k0 = 0; u.nt = Kt; u.ks = 0; return true; }
        if (i == 1) { u.pm = 32 + (c >> 7); u.pn = (c >> 4) & 7; u.ks = c & 15; u.nt = Kt / 16; u.k0 = u.ks * u.nt * BK; return true; }
        return false;
    }
    __device__ __forceinline__ void a_ready(const Unit&) const {}
    __device__ __forceinline__ void done(const Unit&) const {}
};
__device__ __forceinline__ unsigned cvt_pk_bf16(float lo, float hi) { unsigned r; asm volatile("v_cvt_pk_bf16_f32 %0, %1, %2" : "=v"(r) : "v"(lo), "v"(hi)); return r; }
template <class F> struct EpiF {
    static constexpr bool PERM = true, AFTER_DRAIN = false;
    F f;
    __device__ __forceinline__ void operator()(const f32x4 (&acc)[2][2][4][2], const Unit& u, int wr, int wc, int fr, int fq) const {
        const int row0 = u.pm * BM + wr * 64 + fr, col0 = u.pn * BM + wc * 32 + 8 * fq;
#pragma unroll
        for (int ai = 0; ai < 2; ++ai)
#pragma unroll
            for (int m = 0; m < 4; ++m)
#pragma unroll
                for (int bj = 0; bj < 2; ++bj) f(row0 + ai * HALF + m * 16, col0 + bj * HALF, acc[ai][bj][m][0], acc[ai][bj][m][1], u);
    }
};
template <class Epi, class Sched, bool ALIGN_EPI = false, bool SP2 = false>
__device__ __forceinline__ void gemm_phase(PG8_LAS unsigned char* lds, const Gemm g, const Sched& S, const Epi& E, const int tid  ) {
    const int wid = __builtin_amdgcn_readfirstlane(tid >> 6), lane = tid & 63, wr = wid >> 2, wc = wid & 3, fr = lane & 15, fq = lane >> 4;
    const int K = g.K;
    unsigned voffA[2], voffB[2];
#pragma unroll
    for (int i = 0; i < 2; ++i) { int R, C; stage_rc(tid * 16 + i * 8192, R, C); const int Rb = Epi::PERM ? ((R & ~31) + perm32(R & 31)) : R;
        voffA[i] = (unsigned)(R * K + C) * 2u; voffB[i] = (unsigned)(Rb * K + C) * 2u; }
    const size_t kstep = (size_t)(BK * 2);
    const size_t hstep = (size_t)HALF * K * 2;
    const size_t tstep = 2 * hstep;
    const unsigned ldsw = (unsigned)wid * 1024u;
    const int aoff = lds_byte(wr * 64 + fr, fq * 8), boff = lds_byte(wc * 32 + fr, fq * 8);
#define PG8_SA(b, h) (((b) * 2 + (h)) * HTB)
#define PG8_SB(b, h) ((4 + (b) * 2 + (h)) * HTB)
#define PG8_STAGE(bufoff, gbase, voff) do { _Pragma("unroll") for (int _i = 0; _i < 2; ++_i) \
        __builtin_amdgcn_global_load_lds((const unsigned*)((const char*)(gbase) + (voff)[_i]), (PG8_LAS unsigned*)(lds + (bufoff) + ldsw + _i * 8192), 16, 0, 0); } while (0)
#define PG8_LDA(dst, b, h) do { _Pragma("unroll") for (int m = 0; m < 4; ++m) _Pragma("unroll") for (int k = 0; k < 2; ++k) dst[m][k] = *(const PG8_LAS bf16x8*)(lds + PG8_SA(b, h) + aoff + m * 2048 + k * 1024); } while (0)
#define PG8_LDB(dst, b, h) do { _Pragma("unroll") for (int n = 0; n < 2; ++n) _Pragma("unroll") for (int k = 0; k < 2; ++k) dst[n][k] = *(const PG8_LAS bf16x8*)(lds + PG8_SB(b, h) + boff + n * 2048 + k * 1024); } while (0)
#define PG8_MMA(ai, bj, At, Bt) do { __builtin_amdgcn_s_setprio(1); _Pragma("unroll") for (int m = 0; m < 4; ++m) _Pragma("unroll") for (int n = 0; n < 2; ++n) _Pragma("unroll") for (int k = 0; k < 2; ++k) \
        acc[ai][bj][m][n] = __builtin_amdgcn_mfma_f32_16x16x32_bf16(Bt[n][k], At[m][k], acc[ai][bj][m][n], 0, 0, 0); __builtin_amdgcn_s_setprio(0); } while (0)
#define PG8_WAIT_V(n) asm volatile("s_waitcnt vmcnt(" #n ")" ::: "memory")
#define PG8_WAIT_L(n) asm volatile("s_waitcnt lgkmcnt(" #n ")" ::: "memory")
#define PG8_BAR __builtin_amdgcn_s_barrier()
#define PG8_SCHED __builtin_amdgcn_sched_barrier(0)
    Unit cur, nxt; int ui = 0;
    if (!S.next(0, cur)) return;
    f32x4 acc[2][2][4][2];
#pragma unroll
    for (int a = 0; a < 2; ++a)
#pragma unroll
        for (int b = 0; b < 2; ++b)
#pragma unroll
            for (int m = 0; m < 4; ++m)
#pragma unroll
                for (int n = 0; n < 2; ++n) acc[a][b][m][n] = (f32x4){0.f, 0.f, 0.f, 0.f};
    bf16x8 At[4][2], B0[2][2], B1[2][2];
    const char* cA = (const char*)g.A + (size_t)cur.pm * tstep + (size_t)cur.k0 * 2; const char* cB = (const char*)g.Bt + (size_t)cur.pn * tstep + (size_t)cur.k0 * 2;
    S.a_ready(cur);
    if constexpr (SP2) {
        PG8_STAGE(PG8_SB(0, 0), cB, voffB); PG8_STAGE(PG8_SB(0, 1), cB + hstep, voffB); PG8_STAGE(PG8_SA(0, 0), cA, voffA); PG8_STAGE(PG8_SA(0, 1), cA + hstep, voffA);
        if (wr == 1) PG8_BAR;
        PG8_WAIT_V(2); PG8_BAR;
        PG8_STAGE(PG8_SB(1, 0), cB + kstep, voffB); PG8_STAGE(PG8_SA(1, 0), cA + kstep, voffA); PG8_STAGE(PG8_SB(1, 1), cB + hstep + kstep, voffB);
        PG8_WAIT_V(6); PG8_BAR;
    } else {
        PG8_STAGE(PG8_SB(0, 0), cB, voffB); PG8_STAGE(PG8_SA(0, 0), cA, voffA); PG8_STAGE(PG8_SB(0, 1), cB + hstep, voffB); PG8_STAGE(PG8_SA(0, 1), cA + hstep, voffA);
        if (wr == 1) PG8_BAR;
        PG8_WAIT_V(4); PG8_BAR;
        PG8_STAGE(PG8_SB(1, 0), cB + kstep, voffB); PG8_STAGE(PG8_SA(1, 0), cA + kstep, voffA); PG8_STAGE(PG8_SB(1, 1), cB + hstep + kstep, voffB);
        PG8_WAIT_V(6); PG8_BAR;
    }
    for (;;) {
        const bool has_next = S.next(ui + 1, nxt);
        const char* nA = has_next ? (const char*)g.A + (size_t)nxt.pm * tstep + (size_t)nxt.k0 * 2 : cA; const char* nB = has_next ? (const char*)g.Bt + (size_t)nxt.pn * tstep + (size_t)nxt.k0 * 2 : cB;
        const int nt = cur.nt;
        for (int t = 0; t < nt; t += 2) {
            const bool last = (t == nt - 2);
            const char* a1 = cA + (size_t)(t + 1) * kstep;
            const char* a2 = last ? nA : cA + (size_t)(t + 2) * kstep; const char* b2 = last ? nB : cB + (size_t)(t + 2) * kstep;
            const char* a3 = a2 + kstep; const char* b3 = b2 + kstep;
            if (last && has_next) S.a_ready(nxt);
            if constexpr (SP2) {
            PG8_LDB(B0, 0, 0); PG8_LDB(B1, 0, 1); PG8_SCHED; PG8_LDA(At, 0, 0); PG8_STAGE(PG8_SA(1, 1), a1 + hstep, voffA);
            PG8_WAIT_V(8); PG8_WAIT_L(0); PG8_BAR; PG8_MMA(0, 0, At, B0); PG8_MMA(0, 1, At, B1); PG8_BAR; PG8_SCHED;
            PG8_LDA(At, 0, 1); PG8_STAGE(PG8_SB(0, 0), b2, voffB); PG8_STAGE(PG8_SB(0, 1), b2 + hstep, voffB); PG8_STAGE(PG8_SA(0, 0), a2, voffA);
            PG8_WAIT_V(8); PG8_WAIT_L(0); PG8_BAR; PG8_MMA(1, 0, At, B0); PG8_MMA(1, 1, At, B1); PG8_BAR; PG8_SCHED;
            PG8_LDB(B0, 1, 0); PG8_LDB(B1, 1, 1); PG8_SCHED; PG8_LDA(At, 1, 0); PG8_STAGE(PG8_SA(0, 1), a2 + hstep, voffA);
            PG8_WAIT_V(8); PG8_WAIT_L(0); PG8_BAR; PG8_MMA(0, 0, At, B0); PG8_MMA(0, 1, At, B1); PG8_BAR; PG8_SCHED;
            PG8_LDA(At, 1, 1); PG8_STAGE(PG8_SB(1, 0), b3, voffB); PG8_STAGE(PG8_SB(1, 1), b3 + hstep, voffB); PG8_STAGE(PG8_SA(1, 0), a3, voffA);
            PG8_WAIT_V(8); PG8_WAIT_L(0); PG8_BAR; PG8_MMA(1, 0, At, B0); PG8_MMA(1, 1, At, B1); PG8_BAR; PG8_SCHED;
            } else {
            PG8_LDB(B0, 0, 0); PG8_SCHED; PG8_LDA(At, 0, 0); PG8_STAGE(PG8_SA(1, 1), a1 + hstep, voffA);
            PG8_WAIT_L(8); PG8_BAR; PG8_WAIT_L(0); PG8_MMA(0, 0, At, B0); PG8_BAR; PG8_SCHED;
            PG8_LDB(B1, 0, 1); PG8_STAGE(PG8_SB(0, 0), b2, voffB);
            PG8_BAR; PG8_WAIT_L(0); PG8_MMA(0, 1, At, B1); PG8_BAR;
            PG8_LDA(At, 0, 1); PG8_STAGE(PG8_SA(0, 0), a2, voffA);
            PG8_BAR; PG8_WAIT_L(0); PG8_MMA(1, 0, At, B0); PG8_BAR; PG8_SCHED;
            PG8_STAGE(PG8_SB(0, 1), b2 + hstep, voffB);
            PG8_WAIT_V(6); PG8_BAR; PG8_MMA(1, 1, At, B1); PG8_BAR;
            PG8_LDB(B0, 1, 0); PG8_SCHED; PG8_LDA(At, 1, 0); PG8_STAGE(PG8_SA(0, 1), a2 + hstep, voffA);
            PG8_WAIT_L(8); PG8_BAR; PG8_WAIT_L(0); PG8_MMA(0, 0, At, B0); PG8_BAR; PG8_SCHED;
            PG8_LDB(B1, 1, 1); PG8_STAGE(PG8_SB(1, 0), b3, voffB);
            PG8_BAR; PG8_WAIT_L(0); PG8_MMA(0, 1, At, B1); PG8_BAR;
            PG8_LDA(At, 1, 1); PG8_STAGE(PG8_SA(1, 0), a3, voffA);
            PG8_BAR; PG8_WAIT_L(0); PG8_MMA(1, 0, At, B0); PG8_BAR; PG8_SCHED;
            PG8_STAGE(PG8_SB(1, 1), b3 + hstep, voffB);
            PG8_WAIT_V(6); PG8_BAR; PG8_MMA(1, 1, At, B1); PG8_BAR;
            }
        }
        if constexpr (ALIGN_EPI) { if (wr == 0) PG8_BAR; }
        if constexpr (!Epi::AFTER_DRAIN) { E(acc, cur, wr, wc, fr, fq); S.done(cur); }
        if (!has_next) break;
#pragma unroll
        for (int a = 0; a < 2; ++a)
#pragma unroll
            for (int b = 0; b < 2; ++b)
#pragma unroll
                for (int m = 0; m < 4; ++m)
#pragma unroll
                    for (int n = 0; n < 2; ++n) acc[a][b][m][n] = (f32x4){0.f, 0.f, 0.f, 0.f};
        cur = nxt; cA = nA; cB = nB; ++ui;
        if constexpr (ALIGN_EPI) { if (wr == 1) PG8_BAR; }
    }
    PG8_WAIT_V(0);
    if constexpr (!ALIGN_EPI) { if (wr == 0) PG8_BAR; }
    PG8_BAR;
    if constexpr (Epi::AFTER_DRAIN) { E.fused(acc, cur, wr, wc, fr, fq, lds, wid, lane); S.done(cur); }
#undef PG8_SA
#undef PG8_SB
#undef PG8_STAGE
#undef PG8_LDA
#undef PG8_LDB
#undef PG8_MMA
#undef PG8_WAIT_V
#undef PG8_WAIT_L
#undef PG8_BAR
#undef PG8_SCHED
}
}

constexpr int NP = 8192, NS = 512, NTOK = NP + NS, DM = 2048, DFF = 8192, SEQ = 4096, DEPTH = 4;
constexpr int A_N = 6144, B_N = 4176, B_NP = 4352, C_N = 12352, C_NP = 12544, C_VD = 4096;
constexpr int A_LD = A_N + 128, B_LD = B_NP + 128;
constexpr float ALPHA = 1.681792830507429f;
constexpr float LN_EPS = 1e-5f, RMS_EPS = 1e-6f;
constexpr size_t O_YP = 0, O_YS = O_YP + (size_t)NP * DM, O_AKP = O_YS + (size_t)NS * DM, O_AVP = O_AKP + 2ull * 2 * 512 * 2048, O_AKS = O_AVP + 2ull * 2 * 512 * 2048,
    O_AVS = O_AKS + 2ull * 16 * 32 * 2048, O_BKP = O_AVS + 2ull * 16 * 32 * 2048, O_BVP = O_BKP + (size_t)NP * 512, O_BIP = O_BVP + (size_t)NP * 512, O_BKS = O_BIP + (size_t)NP * 64,
    O_BVS = O_BKS + (size_t)NS * 512, O_BIS = O_BVS + (size_t)NS * 512, O_CCP = O_BIS + (size_t)NS * 64, O_CSP = O_CCP + 2ull * 3 * 8192, O_CCS = O_CSP + 2ull * 32 * 128 * 128,
    O_CSS = O_CCS + 16ull * 3 * 8192, O_END = O_CSS + 16ull * 32 * 128 * 128;
enum { I_XP = 0, I_XS, I_CAK, I_CAV, I_CBK, I_CBV, I_CBI, I_SCC, I_SCS, I_AWIN, I_ABIAS, I_AWOUT, I_BWIN, I_BWOUT, I_CWIN, I_CCONVW, I_CALOG, I_CDT, I_CNORM, I_CWOUT,
       I_LN1G, I_LN1B, I_W1, I_W2, I_LN2G, I_LN2B, N_IN };

constexpr size_t MiB = 1u << 20;
constexpr size_t WS_CTL = 0, CTL_ZERO_BYTES = 1 * MiB;
constexpr size_t WS_WA_IN = 1 * MiB;
constexpr size_t WS_WA_OUT = WS_WA_IN + 48 * MiB;
constexpr size_t WS_WB_IN = WS_WA_OUT + 16 * MiB;
constexpr size_t WS_WB_OUT = WS_WB_IN + 17 * MiB;
constexpr size_t WS_WC_IN = WS_WB_OUT + 8 * MiB;
constexpr size_t WS_WC_OUT = WS_WC_IN + 49 * MiB;
constexpr size_t WS_W1 = WS_WC_OUT + 16 * MiB;
constexpr size_t WS_W2 = WS_W1 + 128 * MiB;
constexpr size_t WS_XN = WS_W2 + 128 * MiB;
constexpr size_t WS_BIG = WS_XN + 34 * MiB;
constexpr size_t WS_ATT = WS_BIG + 209 * MiB;
constexpr size_t WS_MIX = WS_ATT + 68 * MiB;
constexpr size_t WS_SIDE = WS_MIX + 68 * MiB;
constexpr size_t WS_SCR = WS_SIDE + 4 * MiB;
constexpr size_t WS_S0COPY = WS_SCR + 330 * MiB;
constexpr size_t WS_PART = WS_S0COPY + 32 * MiB;
constexpr size_t WS_END = WS_PART + 64 * MiB;
constexpr int A_CATROWS = 640;
constexpr size_t SA_CATK = WS_SCR, SA_CATV = SA_CATK + 16ull * A_CATROWS * 2048 * 2;
constexpr int B_CATROWS = 1152;
constexpr size_t SB_CATK = WS_SCR, SB_CATV = SB_CATK + 16ull * B_CATROWS * 512 * 2, SB_CATI = SB_CATV + 16ull * B_CATROWS * 512 * 2,
    SB_SCORE = SB_CATI + 16ull * B_CATROWS * 64 * 2 + MiB / 2, SB_MASK = SB_SCORE + (size_t)NTOK * 4096 * 4, SB_END = SB_MASK + (size_t)NTOK * 512;
static_assert(SB_END <= WS_S0COPY && SA_CATV + 16ull * A_CATROWS * 2048 * 2 <= WS_S0COPY, "scratch map");
constexpr int CW_BAR = 4096, CW_QB = 8192, CW_TF = 16384;

#define GAS __attribute__((address_space(1)))
#define LAS __attribute__((address_space(3)))
typedef unsigned short bf16;
typedef unsigned v4u __attribute__((ext_vector_type(4)));
typedef unsigned v2u __attribute__((ext_vector_type(2)));
typedef float f32x4 __attribute__((ext_vector_type(4)));
typedef float f32x2 __attribute__((ext_vector_type(2)));
typedef short bf16x8 __attribute__((ext_vector_type(8)));
typedef GAS unsigned gu32;
#define LDS_WAIT() asm volatile("s_waitcnt lgkmcnt(0)" ::: "memory")
#define VM_WAIT() asm volatile("s_waitcnt vmcnt(0)" ::: "memory")
constexpr int NWAVES = 8, NTHR = 512;
__device__ __forceinline__ unsigned pk2(float lo, float hi) { return pg8::cvt_pk_bf16(lo, hi); }
__device__ __forceinline__ float bf2f(bf16 b) { return __uint_as_float((unsigned)b << 16); }
__device__ __forceinline__ float wave_sum(float v) {
#pragma unroll
    for (int o = 1; o < 64; o <<= 1) v += __shfl_xor(v, o);
    return v;
}
__device__ __forceinline__ void store8_bf16(bf16* p, f32x4 v0, f32x4 v1) { v4u w; w.x = pk2(v0[0], v0[1]); w.y = pk2(v0[2], v0[3]); w.z = pk2(v1[0], v1[1]); w.w = pk2(v1[2], v1[3]); *(v4u*)p = w; }
__device__ __forceinline__ void store8_f32(float* p, f32x4 v0, f32x4 v1) { *(f32x4*)p = v0; *(f32x4*)(p + 4) = v1; }

#define XB_TMO      128
#define XB_XCNT(j)  (256  + 64 * (j))
#define XB_XSUB(j)  (1280 + 64 * (j))
#define XB_XGEN(j)  (2304 + 64 * (j))
#define XB_TOP      3328
#define XB_TOPGEN   3392
#define XCD_BAR_WORDS 3456
#define XB_SPIN_CAP (1u << 18)

__device__ __forceinline__ unsigned xb_ld(unsigned* p)              { return __hip_atomic_load(p, __ATOMIC_RELAXED, __HIP_MEMORY_SCOPE_AGENT); }
__device__ __forceinline__ unsigned xb_add(unsigned* p, unsigned v) { return __hip_atomic_fetch_add(p, v, __ATOMIC_RELAXED, __HIP_MEMORY_SCOPE_AGENT); }
__device__ __forceinline__ unsigned xb_xcc_id() { return (unsigned)__builtin_amdgcn_s_getreg((3 << 11) | 20) & 0xFu; }
#define XB_SPIN(cond, bar) do { unsigned _sp = 0; while (cond) { __builtin_amdgcn_s_sleep(1); \
    if ((++_sp & 255u) == 0u) { if (xb_ld(&(bar)[XB_TMO])) break; if (_sp > XB_SPIN_CAP) { atomicAdd(&(bar)[XB_TMO], 1u); break; } } } } while (0)

struct XcdBarrier {
    unsigned* bar; unsigned x;
    volatile LAS unsigned* st;
};

__device__ __forceinline__ XcdBarrier xcd_barrier_post(unsigned* bar, volatile LAS unsigned* st) {
    XcdBarrier b; b.bar = bar; b.x = xb_xcc_id(); b.st = st;
    if (threadIdx.x == 0) (void)xb_add(&bar[XB_XCNT(b.x)], 1u);
    return b;
}
__device__ __forceinline__ void xcd_barrier_complete(unsigned* bar, unsigned x, unsigned& nloc, unsigned& nx) {
    const unsigned G = gridDim.x * gridDim.y * gridDim.z;
    unsigned sum, cnt, mine, sp = 0u;
    for (;;) {
        sum = 0u; cnt = 0u; mine = 0u;
#pragma unroll
        for (unsigned j = 0; j < 16; ++j) { const unsigned c = xb_ld(&bar[XB_XCNT(j)]); sum += c; cnt += (c > 0u) ? 1u : 0u; mine = (j == x) ? c : mine; }
        if (sum == G) break;
        __builtin_amdgcn_s_sleep(1);
        if ((++sp & 255u) == 0u) { if (xb_ld(&bar[XB_TMO])) break; if (sp > XB_SPIN_CAP) { atomicAdd(&bar[XB_TMO], 1u); break; } }
    }
    nloc = mine > 0u ? mine : 1u; nx = cnt > 0u ? cnt : 1u;
}

__device__ __forceinline__ void xcd_barrier(const XcdBarrier& b) {
    asm volatile("s_waitcnt vmcnt(0)" ::: "memory");
    __syncthreads();
    if (threadIdx.x == 0) {
        unsigned* bar = b.bar;
        __builtin_amdgcn_s_waitcnt(0);
        unsigned nloc = b.st[0], nx = b.st[1];
        if (nloc == 0u) { xcd_barrier_complete(bar, b.x, nloc, nx); b.st[0] = nloc; b.st[1] = nx; }
        const unsigned old = xb_add(&bar[XB_XSUB(b.x)], 1u);
        const unsigned gen = old / nloc;
        if (old + 1u == (gen + 1u) * nloc) {
            __builtin_amdgcn_fence(__ATOMIC_RELEASE, "agent");
            asm volatile("s_waitcnt vmcnt(0)" ::: "memory");
            const unsigned og = xb_add(&bar[XB_TOP], 1u);
            const unsigned tg = og / nx;
            if (og + 1u == (tg + 1u) * nx) xb_add(&bar[XB_TOPGEN], 1u);
            else XB_SPIN(xb_ld(&bar[XB_TOPGEN]) == tg, bar);
            __builtin_amdgcn_fence(__ATOMIC_ACQUIRE, "agent");
            xb_add(&bar[XB_XGEN(b.x)], 1u);
            asm volatile("s_waitcnt vmcnt(0)" ::: "memory");
        } else {
            XB_SPIN(xb_ld(&bar[XB_XGEN(b.x)]) == gen, bar);
            __builtin_amdgcn_fence(__ATOMIC_ACQUIRE, "agent");
            asm volatile("s_waitcnt vmcnt(0)" ::: "memory");
        }
    }
    __syncthreads();
}

namespace att {
constexpr int D = 128, NW = 8, QBLK = 32, KVBLK = 64;
constexpr float SCALE = 0.088388347648318440f;
constexpr float THR = 8.f;
constexpr size_t SHM_V = KVBLK * D * 2, SHM_K = KVBLK * D * 2, SHM_ATTN = 2 * SHM_V + 2 * SHM_K + NW * 64 * 4;
constexpr size_t SHM_BIAS = SHM_ATTN;
using s16x4  = __attribute__((ext_vector_type(4))) short;
using f32x16 = __attribute__((ext_vector_type(16))) float;
using u32x4  = __attribute__((ext_vector_type(4))) unsigned;
#define KSWZ(row, colB) ((row) * 256 + ((colB) ^ (((row) & 7) << 4)))
#define SBAR() __builtin_amdgcn_sched_barrier(0)
__device__ __forceinline__ int crow(int r, int hi) { return (r & 3) + 8 * (r >> 2) + 4 * hi; }
__device__ __forceinline__ unsigned cvtpk(float lo, float hi) { unsigned r; asm volatile("v_cvt_pk_bf16_f32 %0, %1, %2" : "=v"(r) : "v"(lo), "v"(hi)); return r; }

__device__ __forceinline__ void partialSM(f32x16& p0, f32x16& p1, float& m_reg, float& mn, float& alpha) {
  constexpr float C = SCALE * 1.4426950408889634f;
  float pmax = p0[0];
#pragma unroll
  for (int r = 1; r < 16; ++r) pmax = fmaxf(pmax, p0[r]);
#pragma unroll
  for (int r = 0; r < 16; ++r) pmax = fmaxf(pmax, p1[r]);
  { auto rr = __builtin_amdgcn_permlane32_swap(__float_as_uint(pmax), __float_as_uint(pmax), false, false);
    pmax = fmaxf(__uint_as_float(rr[0]), __uint_as_float(rr[1])); }
  if (__builtin_expect(__all(pmax - m_reg <= THR / SCALE), 1)) { mn = m_reg; alpha = 1.f; }
  else { mn = fmaxf(m_reg, pmax); alpha = __builtin_amdgcn_exp2f((m_reg - mn) * C); m_reg = mn; }
  float mnC = -mn * C;
#pragma unroll
  for (int r = 0; r < 16; ++r) p0[r] = fmaf(p0[r], C, mnC);
#pragma unroll
  for (int r = 0; r < 16; ++r) p1[r] = fmaf(p1[r], C, mnC);
#pragma unroll
  for (int r = 0; r < 16; ++r) p0[r] = __builtin_amdgcn_exp2f(p0[r]);
}
__device__ __forceinline__ void finishSM(f32x16& p0, f32x16& p1, float alpha, float& l_reg, bf16x8& pa0, bf16x8& pa1, bf16x8& pa2, bf16x8& pa3) {
#pragma unroll
  for (int r = 0; r < 16; ++r) p1[r] = __builtin_amdgcn_exp2f(p1[r]);
  float ps = 0;
#pragma unroll
  for (int r = 0; r < 16; ++r) ps += p0[r];
#pragma unroll
  for (int r = 0; r < 16; ++r) ps += p1[r];
  { auto rr = __builtin_amdgcn_permlane32_swap(__float_as_uint(ps), __float_as_uint(ps), false, false);
    ps = __uint_as_float(rr[0]) + __uint_as_float(rr[1]); }
  l_reg = l_reg * alpha + ps;
#define PK4(P, BASE, OUT) do { unsigned a0 = cvtpk(P[BASE + 0], P[BASE + 1]), a1 = cvtpk(P[BASE + 2], P[BASE + 3]);   \
    unsigned b0 = cvtpk(P[BASE + 4], P[BASE + 5]), b1 = cvtpk(P[BASE + 6], P[BASE + 7]);                              \
    auto r0 = __builtin_amdgcn_permlane32_swap(a0, b0, false, false); auto r1 = __builtin_amdgcn_permlane32_swap(a1, b1, false, false); \
    u32x4 w = {r0[0], r1[0], r0[1], r1[1]}; OUT = *reinterpret_cast<bf16x8*>(&w); } while (0)
  PK4(p0, 0, pa0); PK4(p0, 8, pa1); PK4(p1, 0, pa2); PK4(p1, 8, pa3);
#undef PK4
}
__device__ __forceinline__ void qkt(f32x16& p0, f32x16& p1, const bf16* Ks, const bf16x8* qr, int r32, int hi) {
  p0 = f32x16{}; p1 = f32x16{};
#pragma unroll
  for (int d0 = 0; d0 < 8; ++d0) { int cb = (d0 * 16 + hi * 8) * 2;
    bf16x8 b0 = *reinterpret_cast<const bf16x8*>((const char*)Ks + KSWZ(r32, cb));
    bf16x8 b1 = *reinterpret_cast<const bf16x8*>((const char*)Ks + KSWZ(32 + r32, cb));
    p0 = __builtin_amdgcn_mfma_f32_32x32x16_bf16(b0, qr[d0], p0, 0, 0, 0);
    p1 = __builtin_amdgcn_mfma_f32_32x32x16_bf16(b1, qr[d0], p1, 0, 0, 0); }
}
__device__ __forceinline__ int v_st(int k, int c) { const int kk = (k & ~0xC) | ((k & 4) << 1) | ((k & 8) >> 1); return ((kk >> 3) * 4 + (c >> 5)) * 512 + ((kk & 7) * 32 + (c & 31)) * 2; }
__device__ __forceinline__ int v_rd_base(int lane) { return ((lane & 3) << 3) | (((lane >> 2) & 3) << 6) | (((lane >> 4) & 1) << 5) | (((lane >> 5) & 1) << 8); }
constexpr int v_rd_off(int d0, int ks, int half) { return d0 * 512 + ks * 4096 + half * 2048; }
template <int OFF> __device__ __forceinline__ s16x4 tr_read(int vb) {
  s16x4 r; asm volatile("ds_read_b64_tr_b16 %0, %1 offset:%2" : "=&v"(r) : "v"(vb), "i"(OFF) : "memory"); return r;
}
template <int D0> __device__ __forceinline__ void pv_one(f32x16& od, int vb, bf16x8 pa0, bf16x8 pa1, bf16x8 pa2, bf16x8 pa3) {
  const s16x4 l0 = tr_read<v_rd_off(D0, 0, 0)>(vb), h0 = tr_read<v_rd_off(D0, 0, 1)>(vb), l1 = tr_read<v_rd_off(D0, 1, 0)>(vb), h1 = tr_read<v_rd_off(D0, 1, 1)>(vb);
  const s16x4 l2 = tr_read<v_rd_off(D0, 2, 0)>(vb), h2 = tr_read<v_rd_off(D0, 2, 1)>(vb), l3 = tr_read<v_rd_off(D0, 3, 0)>(vb), h3 = tr_read<v_rd_off(D0, 3, 1)>(vb);
  asm volatile("s_waitcnt lgkmcnt(0)" ::: "memory"); SBAR();
#define PK(L, H) (bf16x8){L[0], L[1], L[2], L[3], H[0], H[1], H[2], H[3]}
  od = __builtin_amdgcn_mfma_f32_32x32x16_bf16(pa0, PK(l0, h0), od, 0, 0, 0);
  od = __builtin_amdgcn_mfma_f32_32x32x16_bf16(pa1, PK(l1, h1), od, 0, 0, 0);
  od = __builtin_amdgcn_mfma_f32_32x32x16_bf16(pa2, PK(l2, h2), od, 0, 0, 0);
  od = __builtin_amdgcn_mfma_f32_32x32x16_bf16(pa3, PK(l3, h3), od, 0, 0, 0);
#undef PK
}
__device__ __forceinline__ void pv_d0(f32x16* o, int vb, bf16x8 pa0, bf16x8 pa1, bf16x8 pa2, bf16x8 pa3) {
  pv_one<0>(o[0], vb, pa0, pa1, pa2, pa3); pv_one<1>(o[1], vb, pa0, pa1, pa2, pa3); pv_one<2>(o[2], vb, pa0, pa1, pa2, pa3); pv_one<3>(o[3], vb, pa0, pa1, pa2, pa3);
}

template <class Mask>
__device__ __forceinline__ void attn_body(const bf16* __restrict__ Qw, int ldq, const bf16* __restrict__ Kh, const bf16* __restrict__ Vh, int ldk,
                                          bf16* __restrict__ Ow, int ldo, bool active, int NT, char* lds, const Mask& Mk, int tid) {
  const int wid = tid >> 6, lane = tid & 63, r32 = lane & 31, hi = lane >> 5;
  bf16* V_lds = (bf16*)lds; bf16* K_lds = (bf16*)(lds + 2 * SHM_V);
  float* ws = (float*)(lds + 2 * SHM_V + 2 * SHM_K) + wid * 64; float* li_l = ws; float* al_l = ws + 32;
  float m_reg = -1e30f, l_reg = 0; f32x16 o[4] = {}; bf16x8 qr[8];
  const bf16* Qp = Qw + (long)r32 * ldq + hi * 8;
#pragma unroll
  for (int d0 = 0; d0 < 8; ++d0) qr[d0] = *reinterpret_cast<const bf16x8*>(Qp + d0 * 16);
  const int sr = tid >> 4, sc = (tid & 15) * 8, vst0 = v_st(sr, sc), vst1 = v_st(32 + sr, sc);
  const int vb0 = (int)(uintptr_t)V_lds + v_rd_base(lane);
  struct { bf16x8 vs0, vs1, ks0, ks1; } sr_[1];
#define SLOAD(i, k0) do { sr_[i].vs0 = *reinterpret_cast<const bf16x8*>(&Vh[(long)((k0) + sr) * ldk + sc]); sr_[i].vs1 = *reinterpret_cast<const bf16x8*>(&Vh[(long)((k0) + 32 + sr) * ldk + sc]); \
    sr_[i].ks0 = *reinterpret_cast<const bf16x8*>(&Kh[(long)((k0) + sr) * ldk + sc]); sr_[i].ks1 = *reinterpret_cast<const bf16x8*>(&Kh[(long)((k0) + 32 + sr) * ldk + sc]); } while (0)
#define SWRITE(b, i) do { *(bf16x8*)((char*)V_lds + (b) * SHM_V + vst0) = sr_[i].vs0;          \
    *(bf16x8*)((char*)V_lds + (b) * SHM_V + vst1) = sr_[i].vs1; int kc = sc * 2;               \
    *(bf16x8*)((char*)K_lds + (b) * SHM_K + KSWZ(sr, kc)) = sr_[i].ks0;                       \
    *(bf16x8*)((char*)K_lds + (b) * SHM_K + KSWZ(32 + sr, kc)) = sr_[i].ks1; } while (0)
#define SWAIT() asm volatile("s_waitcnt vmcnt(0)" ::: "memory")
#define RESC(a) do { if (__any((a) < 1.f)) { if (hi == 0) al_l[r32] = (a); asm volatile("s_waitcnt lgkmcnt(0)" ::: "memory"); \
    _Pragma("unroll") for (int d = 0; d < 4; ++d) _Pragma("unroll") for (int r = 0; r < 16; ++r) o[d][r] *= al_l[crow(r, hi)]; } } while (0)
  f32x16 pA0, pA1, pB0, pB1; float mnA, mnB, alA, alB; bf16x8 pa0, pa1, pa2, pa3;
  constexpr int SE = 0, SO = 0;
  SLOAD(SE, 0); asm volatile("s_waitcnt vmcnt(0)" ::: "memory"); SWRITE(0, SE); __syncthreads();
  qkt(pA0, pA1, K_lds, qr, r32, hi); Mk.apply(pA0, pA1, 0, r32, hi); partialSM(pA0, pA1, m_reg, mnA, alA);
  SLOAD(SO, KVBLK);
  SWAIT(); SWRITE(1, SO); __syncthreads();
  for (int j = 1; j + 1 < NT; j += 2) {
    SBAR(); qkt(pB0, pB1, (bf16*)((char*)K_lds + SHM_K), qr, r32, hi); Mk.apply(pB0, pB1, j, r32, hi);
    finishSM(pA0, pA1, alA, l_reg, pa0, pa1, pa2, pa3); SBAR();
    SLOAD(SO, (j + 1) * KVBLK); SBAR();
    pv_d0(o, vb0, pa0, pa1, pa2, pa3); partialSM(pB0, pB1, m_reg, mnB, alB);
    __syncthreads(); SWAIT(); SWRITE(0, SE);
    RESC(alB); __syncthreads();
    SBAR(); qkt(pA0, pA1, K_lds, qr, r32, hi); Mk.apply(pA0, pA1, j + 1, r32, hi);
    finishSM(pB0, pB1, alB, l_reg, pa0, pa1, pa2, pa3); SBAR();
    SLOAD(SE, (j + 2) * KVBLK); SBAR();
    pv_d0(o, vb0 + (int)SHM_V, pa0, pa1, pa2, pa3); partialSM(pA0, pA1, m_reg, mnA, alA);
    __syncthreads(); SWAIT(); SWRITE(1, SO);
    RESC(alA); __syncthreads();
  }
  SBAR(); qkt(pB0, pB1, (bf16*)((char*)K_lds + SHM_K), qr, r32, hi); Mk.apply(pB0, pB1, NT - 1, r32, hi);
  finishSM(pA0, pA1, alA, l_reg, pa0, pa1, pa2, pa3); SBAR();
  pv_d0(o, vb0, pa0, pa1, pa2, pa3); partialSM(pB0, pB1, m_reg, mnB, alB);
  __syncthreads(); RESC(alB);
  finishSM(pB0, pB1, alB, l_reg, pa0, pa1, pa2, pa3); SBAR();
  pv_d0(o, vb0 + (int)SHM_V, pa0, pa1, pa2, pa3);
  if (hi == 0) li_l[r32] = l_reg; asm volatile("s_waitcnt lgkmcnt(0)" ::: "memory");
  float rli[16];
#pragma unroll
  for (int r = 0; r < 16; ++r) rli[r] = __builtin_amdgcn_rcpf(li_l[crow(r, hi)]);
  if (active) {
    bf16* Ob = Ow + r32; int hi_e = hi; asm volatile("" : "+v"(Ob), "+v"(hi_e));
#pragma unroll
    for (int r = 0; r < 16; ++r) { const int orow = crow(r, hi_e);
#pragma unroll
      for (int d0 = 0; d0 < 4; ++d0) { const float v = o[d0][r] * rli[r]; Ob[(long)orow * ldo + d0 * 32] = (bf16)(cvtpk(v, v) & 0xffffu); } }
  }
  __syncthreads();
#undef SLOAD
#undef SWRITE
#undef SWAIT
#undef RESC
}

struct MaskAPrompt {
  const float* bias;
  int qc, kc0, qoff;
  __device__ __forceinline__ void apply(f32x16& p0, f32x16& p1, int j, int r32, int hi) const {
    const int dc = qc - (kc0 + j);
    if (dc < 0 || dc > 8) {
#pragma unroll
      for (int r = 0; r < 16; ++r) { p0[r] = -INFINITY; p1[r] = -INFINITY; }
    } else if (dc >= 3) { const float b = bias[256];
#pragma unroll
      for (int r = 0; r < 16; ++r) { p0[r] += b; p1[r] += b; }
    } else { int base = dc * 64 + qoff + r32 + 128; asm volatile("" : "+v"(base));
#pragma unroll
      for (int r = 0; r < 16; ++r) { const int i0 = base - crow(r, hi), i1 = i0 - 32;
        p0[r] += bias[min(max(i0, 0), 256)]; p1[r] += bias[min(max(i1, 0), 256)]; }
    }
  }
};
struct MaskASample {
  const float* bias;
  __device__ __forceinline__ void apply(f32x16& p0, f32x16& p1, int j, int r32, int hi) const {
    int base = 512 + r32 + 128 - 64 * j; asm volatile("" : "+v"(base));
#pragma unroll
    for (int r = 0; r < 16; ++r) { const int k0 = crow(r, hi), i0 = base - k0, i1 = i0 - 32;
      p0[r] = (64 * j + k0 < 544) ? p0[r] + bias[min(max(i0, 0), 256)] : -INFINITY;
      p1[r] = (64 * j + 32 + k0 < 544) ? p1[r] + bias[min(max(i1, 0), 256)] : -INFINITY; }
  }
};
struct MaskBits {
  const unsigned* mrow;
  __device__ __forceinline__ void apply(f32x16& p0, f32x16& p1, int j, int r32, int hi) const {
    const unsigned w0 = mrow[2 * j], w1 = mrow[2 * j + 1];
#pragma unroll
    for (int r = 0; r < 16; ++r) { const int k0 = crow(r, hi);
      p0[r] = ((w0 >> k0) & 1u) ? p0[r] : -INFINITY; p1[r] = ((w1 >> k0) & 1u) ? p1[r] : -INFINITY; }
  }
};
#undef KSWZ
#undef SBAR
}

struct Args { const float* in[N_IN]; float* out; unsigned char* ws; int ph_lo, ph_hi; };
typedef const __attribute__((address_space(4))) Args* KArgs;
__device__ __forceinline__ KArgs kargs() { KArgs k = (KArgs)__builtin_amdgcn_kernarg_segment_ptr(); asm volatile("" : "+s"(k)); return k; }
struct Frame {
    LAS unsigned char* lds;
    int tid, lane, wave, G, vcu;
};
__device__ __forceinline__ Frame relaunder(Frame F) { int l = __builtin_amdgcn_mbcnt_hi(~0u, __builtin_amdgcn_mbcnt_lo(~0u, 0u)); asm volatile("" : "+v"(l)); F.lane = l; F.tid = F.wave * 64 + l; return F; }
__device__ __forceinline__ int launder_s(int x) { asm volatile("" : "+s"(x)); return x; }
#ifndef EXP_WJ
#define EXP_WJ j
#endif
#ifndef EXP_S0MUL
#define EXP_S0MUL
#endif
#ifndef PROBE_SCALE
#define PROBE_SCALE 1.0f
#endif

__device__ __forceinline__ void transpose_item(const float* __restrict__ W, int K, int N, bf16* __restrict__ WT, LAS float* scr, int item, int nblk, int lane) {
    const int kb = item / nblk, nb = item - kb * nblk, k0 = 64 * kb, n0 = 32 * nb;
    const int kr = lane >> 3, nq = (lane & 7) * 4; const bool ok = n0 + nq < N;
    f32x4 v[8];
#pragma unroll
    for (int i = 0; i < 8; ++i) v[i] = ok ? *(const f32x4*)(W + (size_t)(k0 + 8 * i + kr) * N + n0 + nq) : (f32x4){0.f, 0.f, 0.f, 0.f};
#pragma unroll
    for (int i = 0; i < 8; ++i) { LAS float* d = scr + (8 * i + kr) * 33 + nq; d[0] = v[i][0]; d[1] = v[i][1]; d[2] = v[i][2]; d[3] = v[i][3]; }
    LDS_WAIT(); asm volatile("" ::: "memory");
    const int c = lane & 7;
#pragma unroll
    for (int j = 0; j < 4; ++j) { const int nn = (lane >> 3) + 8 * j; const LAS float* s = scr + (8 * c) * 33 + nn;
        v4u o; o.x = pk2(s[0 * 33], s[1 * 33]); o.y = pk2(s[2 * 33], s[3 * 33]); o.z = pk2(s[4 * 33], s[5 * 33]); o.w = pk2(s[6 * 33], s[7 * 33]);
        *(v4u*)(WT + (size_t)(n0 + nn) * K + k0 + 8 * c) = o; }
    LDS_WAIT(); asm volatile("" ::: "memory");
}
__device__ __forceinline__ void cvt_rows(const Frame& F0, const float* __restrict__ src, bf16* __restrict__ dst, size_t n8) {
    const Frame F = relaunder(F0);
    for (size_t i = (size_t)blockIdx.x * NTHR + F.tid; i < n8; i += (size_t)F.G * NTHR) {
        const f32x4 a = *(const f32x4*)(src + i * 8), b = *(const f32x4*)(src + i * 8 + 4); store8_bf16(dst + i * 8, a, b); }
}
__device__ __forceinline__ void copy_f32(const Frame& F0, const float* __restrict__ src, float* __restrict__ dst, size_t n4) {
    const Frame F = relaunder(F0);
    for (size_t i = (size_t)blockIdx.x * NTHR + F.tid; i < n4; i += (size_t)F.G * NTHR) *(f32x4*)(dst + i * 4) = *(const f32x4*)(src + i * 4);
}
__device__ __forceinline__ void cat_rows(const Frame& F0, const float* __restrict__ src, bf16* __restrict__ dst, int nb, int rows, int w, int dst_rows, int zero_lo, const int rank, const int nblk) {
    if (rank < 0) return;
    const Frame F = relaunder(F0);
    const int w8 = w / 8; const size_t per_b = (size_t)rows * w8, n = per_b * nb;
    for (size_t i = (size_t)rank * NTHR + F.tid; i < n; i += (size_t)nblk * NTHR) {
        const size_t b = i / per_b, r = i - b * per_b;
        const f32x4 x = *(const f32x4*)(src + i * 8), y = *(const f32x4*)(src + i * 8 + 4); store8_bf16(dst + (b * dst_rows) * w + r * 8, x, y); }
    const size_t zper = (size_t)(dst_rows - zero_lo) * w8, zn = zper * nb;
    unsigned z0 = 0u; asm volatile("" : "+v"(z0)); const v4u zz = {z0, z0, z0, z0};
    for (size_t i = (size_t)rank * NTHR + F.tid; i < zn; i += (size_t)nblk * NTHR) {
        const size_t b = i / zper, r = i - b * zper; *(v4u*)(dst + (b * dst_rows + zero_lo) * w + r * 8) = zz; }
}

template <bool DEFERRED> __device__ __forceinline__ void convert_weights(const Frame& F, KArgs a, const int gw, const int NGW) {
    LAS float* scr = (LAS float*)(F.lds + F.wave * 16384);
    unsigned char* ws = a->ws;
    constexpr int I_AIN = 32 * 192, I_AOUT = 32 * 64, I_BIN = 32 * (B_NP / 32), I_BOUT = 32 * 64, I_CIN = 32 * (C_NP / 32), I_COUT = 64 * 64, I_M1 = 32 * 256, I_M2 = 128 * 64;
    if constexpr (!DEFERRED) {
        constexpr int NITEMS = I_AIN + I_AOUT + I_BIN + I_BOUT + I_CIN + 2 * I_M1 + 2 * I_M2;
        for (int it = gw; it < NITEMS; it += NGW) {
            int r = it;
            if (r < I_AIN) { transpose_item(a->in[I_AWIN], DM, A_N, (bf16*)(ws + WS_WA_IN), scr, r, 192, F.lane); continue; } r -= I_AIN;
            if (r < I_AOUT) { transpose_item(a->in[I_AWOUT], DM, DM, (bf16*)(ws + WS_WA_OUT), scr, r, 64, F.lane); continue; } r -= I_AOUT;
            if (r < I_BIN) { transpose_item(a->in[I_BWIN], DM, B_N, (bf16*)(ws + WS_WB_IN), scr, r, B_NP / 32, F.lane); continue; } r -= I_BIN;
            if (r < I_BOUT) { transpose_item(a->in[I_BWOUT], DM, DM, (bf16*)(ws + WS_WB_OUT), scr, r, 64, F.lane); continue; } r -= I_BOUT;
            if (r < I_CIN) { transpose_item(a->in[I_CWIN], DM, C_N, (bf16*)(ws + WS_WC_IN), scr, r, C_NP / 32, F.lane); continue; } r -= I_CIN;
            if (r < 2 * I_M1) { const int j = r / I_M1; r -= j * I_M1; transpose_item(a->in[I_W1] + (size_t)j * DM * DFF, DM, DFF, (bf16*)(ws + WS_W1) + (size_t)j * DFF * DM, scr, r, 256, F.lane); continue; } r -= 2 * I_M1;
            { const int j = r / I_M2; r -= j * I_M2; transpose_item(a->in[I_W2] + (size_t)j * DFF * DM, DFF, DM, (bf16*)(ws + WS_W2) + (size_t)j * DM * DFF, scr, r, 64, F.lane); }
        }
    } else {
        constexpr int NITEMS = I_COUT + I_AIN + I_AOUT + 2 * I_M1 + 2 * I_M2;
        for (int it = gw; it < NITEMS; it += NGW) {
            int r = it;
            if (r < I_COUT) { transpose_item(a->in[I_CWOUT], C_VD, DM, (bf16*)(ws + WS_WC_OUT), scr, r, 64, F.lane); continue; } r -= I_COUT;
            if (r < I_AIN) { transpose_item(a->in[I_AWIN] + (size_t)DM * A_N, DM, A_N, (bf16*)(ws + WS_WA_IN) + (size_t)A_N * DM, scr, r, 192, F.lane); continue; } r -= I_AIN;
            if (r < I_AOUT) { transpose_item(a->in[I_AWOUT] + (size_t)DM * DM, DM, DM, (bf16*)(ws + WS_WA_OUT) + (size_t)DM * DM, scr, r, 64, F.lane); continue; } r -= I_AOUT;
            if (r < 2 * I_M1) { const int j = 2 + r / I_M1; r -= (j - 2) * I_M1; transpose_item(a->in[I_W1] + (size_t)j * DM * DFF, DM, DFF, (bf16*)(ws + WS_W1) + (size_t)j * DFF * DM, scr, r, 256, F.lane); continue; } r -= 2 * I_M1;
            { const int j = 2 + r / I_M2; r -= (j - 2) * I_M2; transpose_item(a->in[I_W2] + (size_t)j * DFF * DM, DFF, DM, (bf16*)(ws + WS_W2) + (size_t)j * DM * DFF, scr, r, 64, F.lane); }
        }
    }
}
__device__ __forceinline__ void p0_prologue(const Frame& F0, KArgs a) {
    const Frame F = relaunder(F0);
    unsigned char* ws = a->ws;
    convert_weights<false>(F, a, blockIdx.x * NWAVES + F.wave, F.G * NWAVES);
    cvt_rows(F, a->in[I_XP], (bf16*)(ws + WS_XN), (size_t)NP * DM / 8);
    cvt_rows(F, a->in[I_XS], (bf16*)(ws + WS_XN) + (size_t)NP * DM, (size_t)NS * DM / 8);
#ifdef TEST_IN8
    if (blockIdx.x == 0 && F.tid == 0) { const float* p = a->in[I_SCS]; ((float*)(ws + WS_SIDE))[0] = p[0] + p[TEST_IN8]; }
#endif
}

struct FnAqkv {
    bf16* qkv; float* out; bf16* catk; bf16* catv; int j;
    __device__ __forceinline__ void operator()(int row, int col, f32x4 v0, f32x4 v1, const pg8::Unit& u) const {
        store8_bf16(qkv + (size_t)row * A_N + col, v0, v1);
        if (u.pn >= 8) {
            const bool isV = u.pn >= 16; const int c = col - (isV ? 4096 : 2048);
            if (u.pm >= 32) {
                const int r = row - NP;
                store8_f32(out + (isV ? O_AVS : O_AKS) + ((size_t)j * 512 + r) * 2048 + c, v0, v1);
                store8_bf16((isV ? catv : catk) + ((size_t)(r >> 5) * A_CATROWS + 512 + (r & 31)) * 2048 + c, v0, v1);
            } else if ((u.pm & 15) >= 14) {
                const int b = u.pm >> 4, tp = (row & 4095) - 3584;
                store8_f32(out + (isV ? O_AVP : O_AKP) + (((size_t)j * 2 + b) * 512 + tp) * 2048 + c, v0, v1);
            }
        }
    }
};
struct FnMix {
    float* mix; float* part;
    __device__ __forceinline__ void operator()(int row, int col, f32x4 v0, f32x4 v1, const pg8::Unit& u) const {
        if (u.pm >= 32) store8_bf16((bf16*)part + ((size_t)u.ks * NS + (row - NP)) * DM + col, v0, v1);
        else store8_bf16((bf16*)mix + (size_t)row * DM + col, v0, v1);
    }
};
struct FnRelu2 {
    bf16* h;
    __device__ __forceinline__ void operator()(int row, int col, f32x4 v0, f32x4 v1, const pg8::Unit&) const {
#pragma unroll
        for (int i = 0; i < 4; ++i) { const float a = fmaxf(v0[i], 0.f), b = fmaxf(v1[i], 0.f); v0[i] = a * a; v1[i] = b * b; }
        store8_bf16(h + (size_t)row * DFF + col, v0, v1);
    }
};
struct FnBproj {
    bf16* big; float* out; float* wi; bf16* catk; bf16* catv; bf16* cati;
    __device__ __forceinline__ void operator()(int row, int col, f32x4 v0, f32x4 v1, const pg8::Unit& u) const {
        store8_bf16(big + (size_t)row * B_NP + col, v0, v1);
        const bool smp = u.pm >= 32; const int r = row - NP;
        if (u.pn >= 8 && u.pn < 12) {
            const bool isV = u.pn >= 10; const int c = col - (isV ? 2560 : 2048);
            if (smp) { store8_f32(out + (isV ? O_BVS : O_BKS) + (size_t)r * 512 + c, v0 * PROBE_SCALE, v1 * PROBE_SCALE);
                       store8_bf16((isV ? catv : catk) + ((size_t)(r >> 5) * B_CATROWS + 1024 + (r & 31)) * 512 + c, v0, v1); }
            else store8_f32(out + (isV ? O_BVP : O_BKP) + (size_t)row * 512 + c, v0 * PROBE_SCALE, v1 * PROBE_SCALE);
        } else if (u.pn == 16) {
            const int c = col - 4096;
            if (c < 64) {
                if (smp) { store8_f32(out + O_BIS + (size_t)r * 64 + c, v0 * PROBE_SCALE, v1 * PROBE_SCALE);
                           store8_bf16(cati + ((size_t)(r >> 5) * B_CATROWS + 1024 + (r & 31)) * 64 + c, v0, v1); }
                else store8_f32(out + O_BIP + (size_t)row * 64 + c, v0 * PROBE_SCALE, v1 * PROBE_SCALE);
            } else if (c < 80) store8_f32(wi + (size_t)row * 16 + (c - 64), v0, v1);
        }
    }
};

struct FnCproj {
    bf16* big; float* out; float* side;
    __device__ __forceinline__ void operator()(int row, int col, f32x4 v0, f32x4 v1, const pg8::Unit& u) const {
        if (col < 12288) {
            store8_bf16(big + (size_t)row * C_NP + col, v0, v1);
            if (col < 8192) {
                if (u.pm >= 32) { const int r = row - NP, s = r & 31; if (s >= 29) store8_f32(out + O_CCS + ((size_t)(r >> 5) * 3 + (s - 29)) * 8192 + col, v0, v1); }
                else { const int t = row & 4095; if (t >= 4093) store8_f32(out + O_CCP + ((size_t)(row >> 12) * 3 + (t - 4093)) * 8192 + col, v0, v1); }
            }
        } else if (col < 12352) store8_f32(side + (size_t)row * 64 + (col - 12288), v0, v1);
    }
};

__device__ __forceinline__ void ln_phase(const Frame& F0, const float* __restrict__ xin_p, const float* __restrict__ xin_s, const bool x_f32, const float* __restrict__ mix, const float* __restrict__ part,
                                         const float* __restrict__ g, const float* __restrict__ bb, float* __restrict__ yout  , bf16* __restrict__ xn) {
    const Frame F = relaunder(F0);
    const int gw = blockIdx.x * NWAVES + F.wave, NGW = F.G * NWAVES;
    for (int row = gw; row < NTOK; row += NGW) {
        const float* xr = row < NP ? xin_p + (size_t)row * DM : xin_s + (size_t)(row - NP) * DM;
        f32x4 v[8]; float s = 0.f;
#pragma unroll
        for (int i = 0; i < 8; ++i) { const int c = (i * 64 + F.lane) * 4; f32x4 x, m;
            if (x_f32) x = *(const f32x4*)(xr + c);
            else { const v2u xb = *(const v2u*)(xn + (size_t)row * DM + c); x = (f32x4){__uint_as_float(xb.x << 16), __uint_as_float(xb.x & 0xffff0000u), __uint_as_float(xb.y << 16), __uint_as_float(xb.y & 0xffff0000u)}; }
            if (row < NP) { const v2u mb = *(const v2u*)((const bf16*)mix + (size_t)row * DM + c); m = (f32x4){__uint_as_float(mb.x << 16), __uint_as_float(mb.x & 0xffff0000u), __uint_as_float(mb.y << 16), __uint_as_float(mb.y & 0xffff0000u)}; }
            else { const bf16* pr = (const bf16*)part + (size_t)(row - NP) * DM + c; m = (f32x4){0.f, 0.f, 0.f, 0.f};
#pragma unroll
                for (int sl = 0; sl < 16; ++sl) { const v2u pb = *(const v2u*)(pr + (size_t)sl * NS * DM); m += (f32x4){__uint_as_float(pb.x << 16), __uint_as_float(pb.x & 0xffff0000u), __uint_as_float(pb.y << 16), __uint_as_float(pb.y & 0xffff0000u)}; } }
            v[i] = x * ALPHA + m; s += (v[i][0] + v[i][1]) + (v[i][2] + v[i][3]); }
        const float mean = wave_sum(s) * (1.f / DM); float q = 0.f;
#pragma unroll
        for (int i = 0; i < 8; ++i) { v[i] = v[i] - mean; q += (v[i][0] * v[i][0] + v[i][1] * v[i][1]) + (v[i][2] * v[i][2] + v[i][3] * v[i][3]); }
        const float rstd = 1.f / sqrtf(wave_sum(q) * (1.f / DM) + LN_EPS);
#pragma unroll
        for (int i = 0; i < 8; ++i) { const int c = (i * 64 + F.lane) * 4; const f32x4 gg = *(const f32x4*)(g + c), be = *(const f32x4*)(bb + c);
            const f32x4 y = v[i] * rstd * gg + be; if (yout) *(f32x4*)(yout + (size_t)row * DM + c) = y;
            v2u w; w.x = pk2(y[0], y[1]); w.y = pk2(y[2], y[3]); *(v2u*)(xn + (size_t)row * DM + c) = w; }
    }
}

__device__ __forceinline__ void attn_a_phase(const Frame& F0, unsigned char* ws, const float* __restrict__ rel_bias  ) {
    char* lds = (char*)F0.lds;
    float* bias_l = (float*)(lds + att::SHM_BIAS);
    const bf16* qkv = (const bf16*)(ws + WS_BIG); bf16* ao = (bf16*)(ws + WS_ATT);
    for (int u = blockIdx.x; u < 512; u += F0.G) {
        const Frame F = relaunder(F0);
        const int c4 = u & 15, h = (u >> 4) & 15, b = u >> 8, c0 = 4 * c4, kc0 = c0 >= 8 ? c0 - 8 : 0, NT = c0 + 4 - kc0;
        if (F.tid < 257) bias_l[F.tid] = rel_bias[h * 257 + F.tid] * (1.0f / att::SCALE);
        const size_t qrow = (size_t)b * SEQ + c0 * 64 + F.wave * 32;
        att::MaskAPrompt Mk{bias_l, c0 + (F.wave >> 1), kc0, (F.wave & 1) * 32};
        att::attn_body(qkv + qrow * A_N + h * 128, A_N, qkv + ((size_t)b * SEQ + kc0 * 64) * A_N + 2048 + h * 128, qkv + ((size_t)b * SEQ + kc0 * 64) * A_N + 4096 + h * 128, A_N,
                       ao + qrow * DM + h * 128, DM, true, NT, lds, Mk, F.tid);
    }
    for (int u = blockIdx.x; u < 256; u += F0.G) {
        const Frame F = relaunder(F0);
        const int h = u & 15, b = u >> 4;
        if (F.tid < 257) bias_l[F.tid] = rel_bias[h * 257 + F.tid] * (1.0f / att::SCALE);
        const size_t qrow = (size_t)NP + b * 32;
        att::MaskASample Mk{bias_l};
        att::attn_body(qkv + qrow * A_N + h * 128, A_N, (const bf16*)(ws + SA_CATK) + (size_t)b * A_CATROWS * 2048 + h * 128, (const bf16*)(ws + SA_CATV) + (size_t)b * A_CATROWS * 2048 + h * 128, 2048,
                       ao + qrow * DM + h * 128, DM, F.wave == 0, 10, lds, Mk, F.tid);
    }
}


typedef float f32x4m __attribute__((ext_vector_type(4)));
__device__ __forceinline__ unsigned fkey(float f) { const unsigned u = __float_as_uint(f); return (u & 0x80000000u) ? ~u : (u | 0x80000000u); }

__device__ __forceinline__ void idx_score_row(const bf16* __restrict__ qi  , const float* __restrict__ wi  , const bf16* __restrict__ kbase, int ldki, int ngrp,
                                              float* __restrict__ srow, int lane) {
    const int c = lane & 15, g = lane >> 4;
    const bf16x8 a0 = *(const bf16x8*)(qi + c * 64 + 8 * g), a1 = *(const bf16x8*)(qi + c * 64 + 32 + 8 * g);
    float w[4];
#pragma unroll
    for (int i = 0; i < 4; ++i) w[i] = wi[4 * g + i] * (0.25f * 0.125f);
    for (int gi = 0; gi < ngrp; ++gi) {
        float p[4];
#pragma unroll
        for (int t = 0; t < 4; ++t) {
            const bf16* kr = kbase + (size_t)(gi * 64 + t * 16 + c) * ldki + 8 * g;
            const bf16x8 b0 = *(const bf16x8*)kr, b1 = *(const bf16x8*)(kr + 32);
            f32x4m d = {0.f, 0.f, 0.f, 0.f};
            d = __builtin_amdgcn_mfma_f32_16x16x32_bf16(a0, b0, d, 0, 0, 0);
            d = __builtin_amdgcn_mfma_f32_16x16x32_bf16(a1, b1, d, 0, 0, 0);
            float s = w[0] * fmaxf(d[0], 0.f); s = fmaf(w[1], fmaxf(d[1], 0.f), s); s = fmaf(w[2], fmaxf(d[2], 0.f), s); s = fmaf(w[3], fmaxf(d[3], 0.f), s);
            s += __shfl_xor(s, 16); s += __shfl_xor(s, 32);
            p[t] = s;
        }
        const float mine = g == 0 ? p[0] : g == 1 ? p[1] : g == 2 ? p[2] : p[3];
        srow[gi * 64 + lane] = mine;
    }
}

__device__ __forceinline__ int wave_sum_i(int v) {
    { auto r = __builtin_amdgcn_permlane32_swap((unsigned)v, (unsigned)v, false, false); v = (int)r[0] + (int)r[1]; }
    { auto r = __builtin_amdgcn_permlane16_swap((unsigned)v, (unsigned)v, false, false); v = (int)r[0] + (int)r[1]; }
    v += __builtin_amdgcn_update_dpp(0, v, 0x128, 0xf, 0xf, false);
    v += __builtin_amdgcn_update_dpp(0, v, 0x124, 0xf, 0xf, false);
    v += __builtin_amdgcn_update_dpp(0, v, 0x122, 0xf, 0xf, false);
    v += __builtin_amdgcn_update_dpp(0, v, 0x121, 0xf, 0xf, false);
    return __builtin_amdgcn_readfirstlane(v);
}
__device__ __forceinline__ void idx_select_row(const float* __restrict__ srow, int L, unsigned* __restrict__ mrow, int nwords, int lane) {
    const int nj = (L + 63) >> 6;
    if (L <= 256) {
        for (int wd = lane; wd < nwords; wd += 64) { const int lo = wd * 32; mrow[wd] = (lo + 32 <= L) ? 0xffffffffu : (lo >= L ? 0u : ((1u << (L - lo)) - 1u)); }
        return;
    }
    unsigned key[64];
#pragma unroll
    for (int jb = 0; jb < 64; jb += 16) {
        if (jb < nj) {
            float sv[16];
#pragma unroll
            for (int j = 0; j < 16; ++j) { const int idx = (jb + j) * 64 + lane; sv[j] = __hip_atomic_load(srow + (idx < L ? idx : 0), __ATOMIC_RELAXED, __HIP_MEMORY_SCOPE_AGENT); }
#pragma unroll
            for (int j = 0; j < 16; ++j) { const int idx = (jb + j) * 64 + lane; key[jb + j] = idx < L ? fkey(sv[j]) : 0u; }
        } else {
#pragma unroll
            for (int j = 0; j < 16; ++j) key[jb + j] = 0u;
        }
    }
    unsigned T = 0u;
    for (int bit = 31; bit >= 0; --bit) {
        const unsigned cand = T | (1u << bit); int cn = 0;
#pragma unroll
        for (int jb = 0; jb < 64; jb += 16) if (jb < nj) {
#pragma unroll
            for (int j = 0; j < 16; ++j) cn += __popcll(__ballot(key[jb + j] >= cand)); }
        if (cn >= 256) T = cand;
        if (cn == 256) break;
    }
    int gv = 0;
#pragma unroll
    for (int j = 0; j < 64; ++j) gv += (key[j] > T) ? 1 : 0;
    int need = 256 - wave_sum_i(gv);
#pragma unroll
    for (int j = 0; j < 64; ++j) {
        unsigned long long sel = 0ull;
        if (j < nj) {
            sel = __ballot(key[j] > T);
            const unsigned long long tb = __ballot(key[j] == T && (j * 64 + lane) < L);
            if (need > 0 && tb != 0ull) { const int cc = __popcll(tb);
                if (cc <= need) { sel |= tb; need -= cc; }
                else { const unsigned long long below = tb & ((1ull << lane) - 1ull); sel |= __ballot(key[j] == T && (j * 64 + lane) < L && __popcll(below) < need); need = 0; } }
        }
        if (2 * j < nwords && lane == 0) { mrow[2 * j] = (unsigned)sel; mrow[2 * j + 1] = (unsigned)(sel >> 32); }
        __builtin_amdgcn_sched_barrier(0);
    }
}

constexpr int IDX_KROW = 144, IDX_KBUF = 64 * IDX_KROW;
__device__ __forceinline__ float xsum16_32(float s) {
    { auto r = __builtin_amdgcn_permlane16_swap(__float_as_uint(s), __float_as_uint(s), false, false); s = __uint_as_float(r[0]) + __uint_as_float(r[1]); }
    { auto r = __builtin_amdgcn_permlane32_swap(__float_as_uint(s), __float_as_uint(s), false, false); s = __uint_as_float(r[0]) + __uint_as_float(r[1]); }
    return s;
}
__device__ __forceinline__ void idx_phase(const Frame& F0, unsigned char* ws) {
    const bf16* big = (const bf16*)(ws + WS_BIG); const float* wi = (const float*)(ws + WS_SIDE);
    float* score = (float*)(ws + SB_SCORE); unsigned* mask = (unsigned*)(ws + SB_MASK);
    char* lds = (char*)F0.lds;
    for (int i = 0, u = blockIdx.x; u < 544; ++i, u += F0.G) {
        const Frame F = relaunder(F0);
        const int tid = F.tid, lane = F.lane;
        int uu = u; if (u < 512 && (i & 1)) uu = (u & ~255) + 255 - (u & 255);
        int rowb, L, ngrp, nwords, ldki; const bf16* kbase;
        if (uu < 512) { rowb = uu * 16; const int b = rowb >> 12, c = (rowb & 4095) >> 6; L = 64 * (c + 1); ngrp = c + 1; nwords = 128; kbase = big + (size_t)b * SEQ * B_NP + 4096; ldki = B_NP; }
        else { rowb = NP + (uu - 512) * 16; const int b = (rowb - NP) >> 5; L = 1056; ngrp = 17; nwords = 36; kbase = (const bf16*)(ws + SB_CATI) + (size_t)b * B_CATROWS * 64; ldki = 64; }
        const int row0 = rowb + 2 * F.wave;
        if (L > 256) {
            const int c = lane & 15, g = lane >> 4;
            bf16x8 a00, a01, a10, a11; float w0[4], w1[4];
            { const bf16* q0 = big + (size_t)row0 * B_NP + 3072 + c * 64 + 8 * g; const bf16* q1 = q0 + B_NP;
              a00 = *(const bf16x8*)q0; a01 = *(const bf16x8*)(q0 + 32); a10 = *(const bf16x8*)q1; a11 = *(const bf16x8*)(q1 + 32);
#pragma unroll
              for (int k = 0; k < 4; ++k) { w0[k] = wi[(size_t)row0 * 16 + 4 * g + k] * (0.25f * 0.125f); w1[k] = wi[(size_t)(row0 + 1) * 16 + 4 * g + k] * (0.25f * 0.125f); } }
            float* s0 = score + (size_t)row0 * 4096; float* s1 = s0 + 4096;
            const int skey = tid >> 3, sseg = tid & 7;
            const bf16* gsrc = kbase + (size_t)skey * ldki + sseg * 8;
            v4u stg = *(const v4u*)gsrc;
            *(v4u*)(lds + skey * IDX_KROW + sseg * 16) = stg;
            __syncthreads();
            for (int gi = 0; gi < ngrp; ++gi) {
                if (gi + 1 < ngrp) stg = *(const v4u*)(gsrc + (size_t)(gi + 1) * 64 * ldki);
                const char* kb = lds + (gi & 1) * IDX_KBUF + c * IDX_KROW + 16 * g;
                float p0[4], p1[4];
#pragma unroll
                for (int t = 0; t < 4; ++t) {
                    const bf16x8 b0 = *(const bf16x8*)(kb + t * 16 * IDX_KROW), b1 = *(const bf16x8*)(kb + t * 16 * IDX_KROW + 64);
                    f32x4m d0 = {0.f, 0.f, 0.f, 0.f}, d1 = {0.f, 0.f, 0.f, 0.f};
                    d0 = __builtin_amdgcn_mfma_f32_16x16x32_bf16(a00, b0, d0, 0, 0, 0); d0 = __builtin_amdgcn_mfma_f32_16x16x32_bf16(a01, b1, d0, 0, 0, 0);
                    d1 = __builtin_amdgcn_mfma_f32_16x16x32_bf16(a10, b0, d1, 0, 0, 0); d1 = __builtin_amdgcn_mfma_f32_16x16x32_bf16(a11, b1, d1, 0, 0, 0);
                    float x0 = w0[0] * fmaxf(d0[0], 0.f); x0 = fmaf(w0[1], fmaxf(d0[1], 0.f), x0); x0 = fmaf(w0[2], fmaxf(d0[2], 0.f), x0); x0 = fmaf(w0[3], fmaxf(d0[3], 0.f), x0);
                    float x1 = w1[0] * fmaxf(d1[0], 0.f); x1 = fmaf(w1[1], fmaxf(d1[1], 0.f), x1); x1 = fmaf(w1[2], fmaxf(d1[2], 0.f), x1); x1 = fmaf(w1[3], fmaxf(d1[3], 0.f), x1);
                    p0[t] = xsum16_32(x0); p1[t] = xsum16_32(x1);
                }
                s0[gi * 64 + lane] = g == 0 ? p0[0] : g == 1 ? p0[1] : g == 2 ? p0[2] : p0[3];
                s1[gi * 64 + lane] = g == 0 ? p1[0] : g == 1 ? p1[1] : g == 2 ? p1[2] : p1[3];
                if (gi + 1 < ngrp) *(v4u*)(lds + ((gi + 1) & 1) * IDX_KBUF + skey * IDX_KROW + sseg * 16) = stg;
                __syncthreads();
            }
            VM_WAIT();
        }
        for (int rr = 0; rr < 2; ++rr) idx_select_row(score + (size_t)(row0 + rr) * 4096, L, mask + (size_t)(row0 + rr) * 128, nwords, lane);
    }
}

__device__ __forceinline__ void attn_b_phase(const Frame& F0, unsigned char* ws) {
    char* lds = (char*)F0.lds;
    const bf16* big = (const bf16*)(ws + WS_BIG); bf16* ao = (bf16*)(ws + WS_ATT); const unsigned* mask = (const unsigned*)(ws + SB_MASK);
    for (int u = blockIdx.x; u < 512; u += F0.G) {
        const Frame F = relaunder(F0);
        const int bg = (u & 255) >> 5, c = (u < 256) ? (u & 31) : 63 - (u & 31), b = bg >> 2, g = bg & 3;
        const int NT = (c + 2) & ~1, head = 4 * g + (F.wave >> 1);
        const size_t qrow = (size_t)b * SEQ + c * 64 + (F.wave & 1) * 32;
        att::MaskBits Mk{mask + (qrow + (F.lane & 31)) * 128};
        att::attn_body(big + qrow * B_NP + head * 128, B_NP, big + (size_t)b * SEQ * B_NP + 2048 + g * 128, big + (size_t)b * SEQ * B_NP + 2560 + g * 128, B_NP,
                       ao + qrow * DM + head * 128, DM, true, NT, lds, Mk, F.tid);
    }
    for (int u = blockIdx.x; u < 64; u += F0.G) {
        const Frame F = relaunder(F0);
        const int b = u >> 2, g = u & 3, head = 4 * g + (F.wave & 3);
        const size_t qrow = (size_t)NP + b * 32;
        att::MaskBits Mk{mask + (qrow + (F.lane & 31)) * 128};
        att::attn_body(big + qrow * B_NP + head * 128, B_NP, (const bf16*)(ws + SB_CATK) + (size_t)b * B_CATROWS * 512 + g * 128, (const bf16*)(ws + SB_CATV) + (size_t)b * B_CATROWS * 512 + g * 128, 512,
                       ao + qrow * DM + head * 128, DM, F.wave < 4, 18, lds, Mk, F.tid);
    }
}

constexpr int C_UNITS = 4096 + 512;
constexpr size_t CU_W = 0, CU_U0T = 16384, CU_QG = 32768, CU_KT = 49152, CU_AQK = 65536, CU_BYTES = 73728;
constexpr size_t SC_UNITS = WS_SCR, SC_DECAY = SC_UNITS + (size_t)C_UNITS * CU_BYTES, SC_END = SC_DECAY + C_UNITS * 4;
static_assert(SC_END <= WS_S0COPY, "C scratch");
typedef float f32x16c __attribute__((ext_vector_type(16)));
__device__ __forceinline__ int crow16(int r, int h) { return (r & 3) + 8 * (r >> 2) + 4 * h; }
__device__ __forceinline__ float sigmoidf_(float x) { return __builtin_amdgcn_rcpf(1.f + __expf(-x)); }
__device__ __forceinline__ float siluf_(float x) { return x * __builtin_amdgcn_rcpf(1.f + __expf(-x)); }

constexpr int PL_QN = 0;
constexpr int PL_KN = PL_QN + 64 * 272;
constexpr int PL_KB = PL_KN + 64 * 272;
constexpr int PL_M = PL_KB + 64 * 272;
constexpr int PL_RHS = PL_M + 64 * 256;
constexpr int PL_VEC = PL_RHS + 64 * 1040;
constexpr int PL_END = PL_VEC + 5 * 256;
static_assert(PL_END <= 147456, "prep LDS");

constexpr int C_TLATE = 56, C_NEARLY = 2 * C_TLATE * 32 + 512, C_NLATE = 2 * (64 - C_TLATE) * 32;
template <int MODE> __device__ __forceinline__ void c_prep_phase(const Frame& F0, KArgs a, const int first, const int stride, const int count) {
    unsigned char* ws = a->ws;
    const bf16* big = (const bf16*)(ws + WS_BIG); const float* side = (const float*)(ws + WS_SIDE);
    const float* convw = a->in[I_CCONVW]; const float* cbuf = a->in[I_SCC];
    char* lds = (char*)F0.lds;
    for (int it = first; it < count; it += stride) {
        const Frame F = relaunder(F0);
        const int tid = F.tid, lane = F.lane, wave = F.wave;
        int uid = it;
        if constexpr (MODE == 0) { const int pe = 2 * C_TLATE * 32, per = C_TLATE * 32; const int sq = it >= per ? 1 : 0, rem = it - sq * per; uid = it < pe ? (sq * 64 + (rem >> 5)) * 32 + (it & 31) : 4096 + (it - pe); }
        if constexpr (MODE == 1) { const int per = (64 - C_TLATE) * 32; const int sq = it >= per ? 1 : 0, rem = it - sq * per; uid = (sq * 64 + C_TLATE + (rem >> 5)) * 32 + (it & 31); }
        const bool smp = uid >= 4096;
        const int hv = uid & 31, hq = hv >> 1;
        const int seq = smp ? (uid - 4096) >> 5 : uid >> 11, chunk = smp ? 0 : (uid >> 5) & 63;
        const int row0 = smp ? NP + seq * 32 : seq * SEQ + chunk * 64, nvalid = smp ? 32 : 64;
        bf16* qn = (bf16*)(lds + PL_QN); bf16* kn = (bf16*)(lds + PL_KN); bf16* kb = (bf16*)(lds + PL_KB);
        float* mL = (float*)(lds + PL_M); float* rhs = (float*)(lds + PL_RHS);
        float* Gv = (float*)(lds + PL_VEC); float* betav = Gv + 64; float* eGv = Gv + 128; float* rqv = Gv + 192; float* rkv = Gv + 256;
        unsigned char* ub = ws + SC_UNITS + (size_t)uid * CU_BYTES;
        if (wave == 7) {
            float beta = 0.f, g = 0.f;
            if (lane < nvalid) { const float* sr = side + (size_t)(row0 + lane) * 64;
                beta = sigmoidf_(sr[hv]); const float x = sr[32 + hv] + a->in[I_CDT][hv]; const float sp = x > 20.f ? x : __logf(1.f + __expf(x)); g = -__expf(a->in[I_CALOG][hv]) * sp; }
            float G = g;
#pragma unroll
            for (int o = 1; o < 64; o <<= 1) { const float t = __shfl_up(G, o); if (lane >= o) G += t; }
            Gv[lane] = G; betav[lane] = beta; eGv[lane] = __expf(G);
        }
        if (tid < 384) {
            const int grp = tid % 48, tb = tid / 48, part = grp >> 4, c8 = (grp & 15) * 8;
            const int ch = part == 0 ? hq * 128 + c8 : part == 1 ? 2048 + hq * 128 + c8 : 4096 + hv * 128 + c8;
            float* dst = part == 2 ? (float*)(lds + PL_QN) + c8 : rhs + (part == 1 ? 128 : 0) + c8; const int dstride = part == 2 ? 132 : 260;
            if (8 * tb < nvalid) {
                float w[4][8], xr[11][8];
#pragma unroll
                for (int j = 0; j < 4; ++j) { const f32x4 a0 = *(const f32x4*)(convw + (size_t)j * 8192 + ch), a1 = *(const f32x4*)(convw + (size_t)j * 8192 + ch + 4);
                    w[j][0] = a0[0]; w[j][1] = a0[1]; w[j][2] = a0[2]; w[j][3] = a0[3]; w[j][4] = a1[0]; w[j][5] = a1[1]; w[j][6] = a1[2]; w[j][7] = a1[3]; }
                bf16x8 xv[11];
#pragma unroll
                for (int i = 0; i < 11; ++i) { const int tt = 8 * tb - 3 + i; const bool ok = tt >= 0 || (!smp && chunk > 0);
                    xv[i] = *(const bf16x8*)(big + (size_t)(row0 + (ok ? tt : 0)) * C_NP + ch); }
#pragma unroll
                for (int i = 0; i < 11; ++i) { const int tt = 8 * tb - 3 + i; const bool ok = tt >= 0 || (!smp && chunk > 0);
#pragma unroll
                    for (int e = 0; e < 8; ++e) xr[i][e] = ok ? bf2f((bf16)xv[i][e]) : 0.f; }
                if (smp) {
#pragma unroll
                    for (int i = 0; i < 3; ++i) { const int tt = 8 * tb - 3 + i; const int r = tt < 0 ? 3 + tt : 0;
                        const float* cb = cbuf + ((size_t)seq * 3 + r) * 8192 + ch; const f32x4 a0 = *(const f32x4*)cb, a1 = *(const f32x4*)(cb + 4);
                        if (tt < 0) { xr[i][0] = a0[0]; xr[i][1] = a0[1]; xr[i][2] = a0[2]; xr[i][3] = a0[3]; xr[i][4] = a1[0]; xr[i][5] = a1[1]; xr[i][6] = a1[2]; xr[i][7] = a1[3]; } }
                }
#pragma unroll
                for (int t8 = 0; t8 < 8; ++t8) { f32x4 y0, y1;
#pragma unroll
                    for (int e = 0; e < 8; ++e) { float y = xr[t8][e] * w[0][e]; y = fmaf(xr[t8 + 1][e], w[1][e], y); y = fmaf(xr[t8 + 2][e], w[2][e], y); y = fmaf(xr[t8 + 3][e], w[3][e], y); y = siluf_(y);
                        if (e < 4) y0[e] = y; else y1[e - 4] = y; }
                    float* d = dst + (8 * tb + t8) * dstride; *(f32x4*)d = y0; *(f32x4*)(d + 4) = y1; }
            } else {
#pragma unroll
                for (int t8 = 0; t8 < 8; ++t8) { float* d = dst + (8 * tb + t8) * dstride; *(f32x4*)d = (f32x4){0.f, 0.f, 0.f, 0.f}; *(f32x4*)(d + 4) = (f32x4){0.f, 0.f, 0.f, 0.f}; }
            }
        }
        __syncthreads();
        { const int t = tid >> 3, sub = tid & 7; float sq = 0.f, sk = 0.f;
#pragma unroll
          for (int e = 0; e < 16; ++e) { const float q = rhs[t * 260 + sub * 16 + e], k = rhs[t * 260 + 128 + sub * 16 + e]; sq = fmaf(q, q, sq); sk = fmaf(k, k, sk); }
          sq += __shfl_xor(sq, 1); sq += __shfl_xor(sq, 2); sq += __shfl_xor(sq, 4); sk += __shfl_xor(sk, 1); sk += __shfl_xor(sk, 2); sk += __shfl_xor(sk, 4);
          if (sub == 0) { rqv[t] = rsqrtf(sq + RMS_EPS) * 0.08838834764831845f; rkv[t] = rsqrtf(sk + RMS_EPS); } }
        __syncthreads();
        { const int t = tid >> 3, sub = tid & 7; float q[16], k[16], vb[16];
          const float* vpark = (const float*)(lds + PL_QN) + t * 132 + sub * 16;
#pragma unroll
          for (int e = 0; e < 16; ++e) { q[e] = rhs[t * 260 + sub * 16 + e] * rqv[t]; k[e] = rhs[t * 260 + 128 + sub * 16 + e] * rkv[t]; vb[e] = vpark[e] * betav[t]; }
          __syncthreads();
          const float be = betav[t], eg = eGv[t];
#pragma unroll
          for (int e = 0; e < 16; e += 2) {
              *(unsigned*)(qn + t * 136 + sub * 16 + e) = pk2(q[e], q[e + 1]); *(unsigned*)(kn + t * 136 + sub * 16 + e) = pk2(k[e], k[e + 1]);
              *(unsigned*)(kb + t * 136 + sub * 16 + e) = pk2(k[e] * be, k[e + 1] * be); }
#pragma unroll
          for (int e = 0; e < 16; ++e) { rhs[t * 260 + sub * 16 + e] = vb[e]; rhs[t * 260 + 128 + sub * 16 + e] = k[e] * be * eg; }
        }
        __syncthreads();
        { const int r32 = lane & 31, h = lane >> 5, tile = wave & 3, mt = tile >> 1, nt = tile & 1;
          const bf16* Ab = (wave < 4 ? kb : qn) + (mt * 32 + r32) * 136 + 8 * h; const bf16* Bb = kn + (nt * 32 + r32) * 136 + 8 * h;
          f32x16c d = {};
#pragma unroll
          for (int s = 0; s < 8; ++s) d = __builtin_amdgcn_mfma_f32_32x32x16_bf16(*(const bf16x8*)(Ab + 16 * s), *(const bf16x8*)(Bb + 16 * s), d, 0, 0, 0);
          const int j = nt * 32 + r32; const float Gj = Gv[j];
          bf16* aqk = (bf16*)(ub + CU_AQK);
#pragma unroll
          for (int r = 0; r < 16; ++r) { const int i = mt * 32 + crow16(r, h); const float dec = __expf(fminf(Gv[i] - Gj, 0.f));
              if (wave < 4) mL[i * 64 + j] = (j < i) ? d[r] * dec : 0.f;
              else aqk[i * 64 + j] = (bf16)(pk2((j <= i) ? d[r] * dec : 0.f, 0.f) & 0xffffu); }
        }
        __syncthreads();
        if (wave < 4) {
            const int c = tid; float x[64];
            const LAS float* mLv = (const LAS float*)mL; asm volatile("" : "+v"(mLv));
#ifdef EXP_SOLVE2
            for (int rep_ = 0; rep_ < 2; ++rep_) { asm volatile("" ::: "memory");
#endif
#pragma unroll
            for (int ib = 0; ib < 16; ++ib) {
                float a0 = rhs[(4 * ib + 0) * 260 + c], a1 = rhs[(4 * ib + 1) * 260 + c], a2 = rhs[(4 * ib + 2) * 260 + c], a3 = rhs[(4 * ib + 3) * 260 + c];
#pragma unroll
                for (int jb = 0; jb < ib; ++jb) {
                    const f32x4 m0 = *(const LAS f32x4*)(mLv + (4 * ib + 0) * 64 + 4 * jb), m1 = *(const LAS f32x4*)(mLv + (4 * ib + 1) * 64 + 4 * jb),
                                m2 = *(const LAS f32x4*)(mLv + (4 * ib + 2) * 64 + 4 * jb), m3 = *(const LAS f32x4*)(mLv + (4 * ib + 3) * 64 + 4 * jb);
#pragma unroll
                    for (int e = 0; e < 4; ++e) { const float xv = x[4 * jb + e]; a0 = fmaf(-m0[e], xv, a0); a1 = fmaf(-m1[e], xv, a1); a2 = fmaf(-m2[e], xv, a2); a3 = fmaf(-m3[e], xv, a3); }
                }
                const f32x4 d1 = *(const LAS f32x4*)(mLv + (4 * ib + 1) * 64 + 4 * ib), d2 = *(const LAS f32x4*)(mLv + (4 * ib + 2) * 64 + 4 * ib), d3 = *(const LAS f32x4*)(mLv + (4 * ib + 3) * 64 + 4 * ib);
                x[4 * ib] = a0;
                a1 = fmaf(-d1[0], a0, a1); x[4 * ib + 1] = a1;
                a2 = fmaf(-d2[0], a0, a2); a2 = fmaf(-d2[1], a1, a2); x[4 * ib + 2] = a2;
                a3 = fmaf(-d3[0], a0, a3); a3 = fmaf(-d3[1], a1, a3); a3 = fmaf(-d3[2], a2, a3); x[4 * ib + 3] = a3;
            }
#ifdef EXP_SOLVE2
            }
#endif
#pragma unroll
            for (int i = 0; i < 64; ++i) rhs[i * 260 + c] = x[i];
        } else {
            const int t2 = tid - 256;
            bf16* qg = (bf16*)(ub + CU_QG); bf16* kt = (bf16*)(ub + CU_KT);
            const float Glast = Gv[63];
            for (int it = t2; it < 64 * 16; it += 256) { const int t = it >> 4, c8 = (it & 15) * 8; const float eg = eGv[t];
                const bf16x8 v = *(const bf16x8*)(qn + t * 136 + c8); v4u o;
                o.x = pk2(bf2f((bf16)v[0]) * eg, bf2f((bf16)v[1]) * eg); o.y = pk2(bf2f((bf16)v[2]) * eg, bf2f((bf16)v[3]) * eg); o.z = pk2(bf2f((bf16)v[4]) * eg, bf2f((bf16)v[5]) * eg); o.w = pk2(bf2f((bf16)v[6]) * eg, bf2f((bf16)v[7]) * eg);
                *(v4u*)(qg + t * 128 + c8) = o; }
            for (int it = t2; it < 128 * 8; it += 256) { const int dk = it & 127, t8 = (it >> 7) * 8; float f[8];
#pragma unroll
                for (int e = 0; e < 8; ++e) f[e] = bf2f(kn[(t8 + e) * 136 + dk]) * __expf(Glast - Gv[t8 + e]);
                v4u o; o.x = pk2(f[0], f[1]); o.y = pk2(f[2], f[3]); o.z = pk2(f[4], f[5]); o.w = pk2(f[6], f[7]);
                *(v4u*)(kt + dk * 64 + t8) = o; }
            if (t2 == 0) ((float*)(ws + SC_DECAY))[uid] = __expf(Glast);
        }
        __syncthreads();
        { bf16* Wg = (bf16*)(ub + CU_W); bf16* U0t = (bf16*)(ub + CU_U0T);
          for (int it = tid; it < 64 * 16; it += NTHR) { const int t = it >> 4, c8 = (it & 15) * 8; const float* s = rhs + t * 260 + 128 + c8;
              v4u o; o.x = pk2(s[0], s[1]); o.y = pk2(s[2], s[3]); o.z = pk2(s[4], s[5]); o.w = pk2(s[6], s[7]); *(v4u*)(Wg + t * 128 + c8) = o; }
          for (int it = tid; it < 128 * 8; it += NTHR) { const int dv = it & 127, t8 = (it >> 7) * 8; const float* s = rhs + t8 * 260 + dv;
              v4u o; o.x = pk2(s[0], s[260]); o.y = pk2(s[520], s[780]); o.z = pk2(s[1040], s[1300]); o.w = pk2(s[1560], s[1820]); *(v4u*)(U0t + dv * 64 + t8) = o; } }
        __syncthreads();
    }
}

constexpr int SL_W = 0, SL_QG = SL_W + 64 * 272, SL_KT = SL_QG + 64 * 272, SL_AQK = SL_KT + 128 * 144, SL_ST = SL_AQK + 64 * 144, SL_UT = SL_ST + 128 * 272, SL_END = SL_UT + 128 * 144;
constexpr int SL_O = 0;
static_assert(64 * 132 * 4 <= SL_KT && SL_END <= 147456, "scan LDS");

struct ScanPf { v4u w0, w1, q0, q1, k0, k1, aq; v2u u0, u1, u2, u3; v4u z0, z1; float decay; };
__device__ __forceinline__ void c_scan_phase(const Frame& F0, KArgs a) {
    unsigned char* ws = a->ws; char* lds = (char*)F0.lds;
    const bf16* big = (const bf16*)(ws + WS_BIG); bf16* og = (bf16*)(ws + WS_ATT); const float* normw = a->in[I_CNORM];
    const int G = F0.G; const bool few = G <= 64;
    gu32* lpw = (gu32*)((unsigned*)(ws + WS_CTL) + CW_QB);
    if (!few && blockIdx.x >= 64) {
        c_prep_phase<1>(F0, a, (int)blockIdx.x - 64, G - 64, C_NLATE);
        asm volatile("s_waitcnt vmcnt(0)" ::: "memory");
        __syncthreads();
        if (relaunder(F0).tid == 0) { __builtin_amdgcn_fence(__ATOMIC_RELEASE, "agent"); asm volatile("s_waitcnt vmcnt(0)" ::: "memory"); (void)__hip_atomic_fetch_add(lpw, 1u, __ATOMIC_RELAXED, __HIP_MEMORY_SCOPE_AGENT); }
    }
    for (int pass = 0; pass < 2; ++pass) {
        int first, stride, count;
        if (pass == 0) { first = blockIdx.x; stride = G; count = 64; if (!few && blockIdx.x >= 64) count = 0; }
        else { if (few) { first = blockIdx.x; stride = G; } else { first = (int)blockIdx.x - 64; stride = G - 64; } count = 512; if (first < 0) { first = 0; count = 0; } }
        for (int ch = first; ch < count; ch += stride) {
            const Frame F = relaunder(F0);
            const int tid = F.tid, lane = F.lane, wave = F.wave, r32 = lane & 31, h = lane >> 5;
            const bool smp = pass == 1;
            const int seq = ch >> 5, hv = ch & 31, nsteps = smp ? 1 : 64, nvalid = smp ? 32 : 64;
            const int mt = wave & 1, nt = wave >> 1;
            const int dvc = nt * 32 + r32;
            const int tn = tid >> 3, sub = tid & 7;
            f32x16c S0 = {}, S1 = {};
            if (smp) { const float* s0 = a->in[I_SCS] + ((size_t)(seq * 32 + hv) * 128) * 128;
#pragma unroll
                for (int r = 0; r < 16; ++r) { S0[r] = s0[(size_t)((2 * mt) * 32 + crow16(r, h)) * 128 + dvc]; S1[r] = s0[(size_t)((2 * mt + 1) * 32 + crow16(r, h)) * 128 + dvc]; } }
            bf16* Wl = (bf16*)(lds + SL_W); bf16* Ql = (bf16*)(lds + SL_QG); bf16* Kl = (bf16*)(lds + SL_KT); bf16* Al = (bf16*)(lds + SL_AQK);
            bf16* St = (bf16*)(lds + SL_ST); bf16* ut = (bf16*)(lds + SL_UT); float* ol = (float*)(lds + SL_O);
#define SCAN_FETCH(P, st) do { const int uid_ = smp ? 4096 + ch : (seq * 64 + (st)) * 32 + hv; const int row0_ = smp ? NP + seq * 32 : seq * SEQ + (st) * 64;                 \
                const unsigned char* ub_ = ws + SC_UNITS + (size_t)uid_ * CU_BYTES;                                                                                                  \
                { const int t_ = tid >> 4, c8_ = (tid & 15) * 8; P.w0 = *(const v4u*)((const bf16*)(ub_ + CU_W) + t_ * 128 + c8_); P.w1 = *(const v4u*)((const bf16*)(ub_ + CU_W) + (t_ + 32) * 128 + c8_);        \
                  P.q0 = *(const v4u*)((const bf16*)(ub_ + CU_QG) + t_ * 128 + c8_); P.q1 = *(const v4u*)((const bf16*)(ub_ + CU_QG) + (t_ + 32) * 128 + c8_); }                                                 \
                { const int dk_ = tid >> 3, c8_ = (tid & 7) * 8; P.k0 = *(const v4u*)((const bf16*)(ub_ + CU_KT) + dk_ * 64 + c8_); P.k1 = *(const v4u*)((const bf16*)(ub_ + CU_KT) + (dk_ + 64) * 64 + c8_);       \
                  P.aq = *(const v4u*)((const bf16*)(ub_ + CU_AQK) + dk_ * 64 + c8_); }                                                                                              \
                { const bf16* U0t_ = (const bf16*)(ub_ + CU_U0T) + dvc * 64 + mt * 32 + 4 * h; P.u0 = *(const v2u*)(U0t_); P.u1 = *(const v2u*)(U0t_ + 8); P.u2 = *(const v2u*)(U0t_ + 16); P.u3 = *(const v2u*)(U0t_ + 24); } \
                { const int tz_ = tn < nvalid ? tn : 0; const bf16* zr_ = big + (size_t)(row0_ + tz_) * C_NP + 8192 + hv * 128 + sub * 16; P.z0 = *(const v4u*)zr_; P.z1 = *(const v4u*)(zr_ + 8); }          \
                P.decay = ((const float*)(ws + SC_DECAY))[uid_]; } while (0)
#define SCAN_STAGE(P) do { { const int t_ = tid >> 4, c8_ = (tid & 15) * 8; *(v4u*)(Wl + t_ * 136 + c8_) = P.w0; *(v4u*)(Wl + (t_ + 32) * 136 + c8_) = P.w1; *(v4u*)(Ql + t_ * 136 + c8_) = P.q0; *(v4u*)(Ql + (t_ + 32) * 136 + c8_) = P.q1; } \
                { const int dk_ = tid >> 3, c8_ = (tid & 7) * 8; *(v4u*)(Kl + dk_ * 72 + c8_) = P.k0; *(v4u*)(Kl + (dk_ + 64) * 72 + c8_) = P.k1; *(v4u*)(Al + dk_ * 72 + c8_) = P.aq; } } while (0)
            ScanPf cur, nxt;
            SCAN_FETCH(cur, 0);
            SCAN_STAGE(cur);
            nxt = cur;
            for (int step = 0; step < nsteps; ++step) {
                const int row0 = smp ? NP + seq * 32 : seq * SEQ + step * 64;
                if (!smp && !few && step + 1 == C_TLATE) {
                    if (tid == 0) { unsigned sp = 0u; while (__hip_atomic_load(lpw, __ATOMIC_RELAXED, __HIP_MEMORY_SCOPE_AGENT) < (unsigned)(G - 64) && ++sp < (1u << 20)) __builtin_amdgcn_s_sleep(2);
                        __builtin_amdgcn_fence(__ATOMIC_ACQUIRE, "agent"); asm volatile("s_waitcnt vmcnt(0)" ::: "memory"); }
                    __syncthreads();
                }
                if (step + 1 < nsteps) SCAN_FETCH(nxt, step + 1);
#pragma unroll
                for (int q = 0; q < 4; ++q) {
                    v2u w0, w1; w0.x = pk2(S0[4 * q], S0[4 * q + 1]); w0.y = pk2(S0[4 * q + 2], S0[4 * q + 3]); w1.x = pk2(S1[4 * q], S1[4 * q + 1]); w1.y = pk2(S1[4 * q + 2], S1[4 * q + 3]);
                    *(v2u*)(St + dvc * 136 + (2 * mt) * 32 + 8 * q + 4 * h) = w0; *(v2u*)(St + dvc * 136 + (2 * mt + 1) * 32 + 8 * q + 4 * h) = w1; }
                f32x16c u;
#define SCAN_U0(q, W) do { u[4 * q] = __uint_as_float(W.x << 16); u[4 * q + 1] = __uint_as_float(W.x & 0xffff0000u); u[4 * q + 2] = __uint_as_float(W.y << 16); u[4 * q + 3] = __uint_as_float(W.y & 0xffff0000u); } while (0)
                SCAN_U0(0, cur.u0); SCAN_U0(1, cur.u1); SCAN_U0(2, cur.u2); SCAN_U0(3, cur.u3);
                __syncthreads();
                f32x16c ws_acc = {}, o = {};
#pragma unroll
                for (int s = 0; s < 8; ++s) { const bf16x8 bS = *(const bf16x8*)(St + dvc * 136 + 16 * s + 8 * h);
                    ws_acc = __builtin_amdgcn_mfma_f32_32x32x16_bf16(*(const bf16x8*)(Wl + (mt * 32 + r32) * 136 + 16 * s + 8 * h), bS, ws_acc, 0, 0, 0);
                    o = __builtin_amdgcn_mfma_f32_32x32x16_bf16(*(const bf16x8*)(Ql + (mt * 32 + r32) * 136 + 16 * s + 8 * h), bS, o, 0, 0, 0); }
#pragma unroll
                for (int r = 0; r < 16; ++r) u[r] -= ws_acc[r];
#pragma unroll
                for (int q = 0; q < 4; ++q) { v2u w; w.x = pk2(u[4 * q], u[4 * q + 1]); w.y = pk2(u[4 * q + 2], u[4 * q + 3]); *(v2u*)(ut + dvc * 72 + mt * 32 + 8 * q + 4 * h) = w; }
                __syncthreads();
                const float decay = cur.decay;
#pragma unroll
                for (int r = 0; r < 16; ++r) { S0[r] *= decay; S1[r] *= decay; }
#pragma unroll
                for (int s = 0; s < 4; ++s) { const bf16x8 bU = *(const bf16x8*)(ut + dvc * 72 + 16 * s + 8 * h);
                    o = __builtin_amdgcn_mfma_f32_32x32x16_bf16(*(const bf16x8*)(Al + (mt * 32 + r32) * 72 + 16 * s + 8 * h), bU, o, 0, 0, 0);
                    S0 = __builtin_amdgcn_mfma_f32_32x32x16_bf16(*(const bf16x8*)(Kl + ((2 * mt) * 32 + r32) * 72 + 16 * s + 8 * h), bU, S0, 0, 0, 0);
                    S1 = __builtin_amdgcn_mfma_f32_32x32x16_bf16(*(const bf16x8*)(Kl + ((2 * mt + 1) * 32 + r32) * 72 + 16 * s + 8 * h), bU, S1, 0, 0, 0); }
#pragma unroll
                for (int r = 0; r < 16; ++r) ol[(mt * 32 + crow16(r, h)) * 132 + dvc] = o[r];
                __syncthreads();
                { float v[16]; float ss = 0.f;
#pragma unroll
                  for (int e = 0; e < 16; ++e) { v[e] = ol[tn * 132 + sub * 16 + e]; ss = fmaf(v[e], v[e], ss); }
                  ss += __shfl_xor(ss, 1); ss += __shfl_xor(ss, 2); ss += __shfl_xor(ss, 4);
                  const float rs = rsqrtf(ss * (1.f / 128.f) + RMS_EPS);
                  if (tn < nvalid) {
                      const unsigned zw[8] = {cur.z0.x, cur.z0.y, cur.z0.z, cur.z0.w, cur.z1.x, cur.z1.y, cur.z1.z, cur.z1.w};
                      float y[16];
#pragma unroll
                      for (int e = 0; e < 16; ++e) { const float z = (e & 1) ? __uint_as_float(zw[e >> 1] & 0xffff0000u) : __uint_as_float(zw[e >> 1] << 16); y[e] = v[e] * rs * normw[sub * 16 + e] * siluf_(z); }
                      v4u o0, o1; o0.x = pk2(y[0], y[1]); o0.y = pk2(y[2], y[3]); o0.z = pk2(y[4], y[5]); o0.w = pk2(y[6], y[7]); o1.x = pk2(y[8], y[9]); o1.y = pk2(y[10], y[11]); o1.z = pk2(y[12], y[13]); o1.w = pk2(y[14], y[15]);
                      bf16* dst = og + (size_t)(row0 + tn) * C_VD + hv * 128 + sub * 16; *(v4u*)dst = o0; *(v4u*)(dst + 8) = o1; } }
                __syncthreads();
                if (step + 1 < nsteps) { SCAN_STAGE(nxt); cur = nxt; }
            }
            { float* so = a->out + (smp ? O_CSS : O_CSP) + ((size_t)(seq * 32 + hv) * 128) * 128;
#pragma unroll
              for (int r = 0; r < 16; ++r) { so[(size_t)((2 * mt) * 32 + crow16(r, h)) * 128 + dvc] = S0[r]; so[(size_t)((2 * mt + 1) * 32 + crow16(r, h)) * 128 + dvc] = S1[r]; } }
#undef SCAN_FETCH
#undef SCAN_STAGE
#undef SCAN_U0
        }
    }
    { const Frame F = relaunder(F0); __syncthreads();
      if (few) convert_weights<true>(F, a, blockIdx.x * NWAVES + F.wave, G * NWAVES);
      else if (blockIdx.x >= 64) convert_weights<true>(F, a, ((int)blockIdx.x - 64) * NWAVES + F.wave, (G - 64) * NWAVES); }
}

template <int PH> __device__ __forceinline__ void run_phase(const Frame& F, const int layer) {
    const KArgs KA = kargs();
    unsigned char* ws = KA->ws;
    const int kind = layer % 3, j = layer / 3;
    if constexpr (PH == 0) { p0_prologue(F, KA); }
    if constexpr (PH == 1) {
        pg8::Gemm g{(const bf16*)(ws + WS_XN), (const bf16*)(ws + WS_WA_IN) + (size_t)j * A_N * DM, NTOK, A_N, DM};
        pg8::StaticOrder S; S.init(NTOK, A_N, F.G, launder_s((int)blockIdx.x), DM);
        pg8::EpiF<FnAqkv> E{{(bf16*)(ws + WS_BIG), KA->out, (bf16*)(ws + SA_CATK), (bf16*)(ws + SA_CATV), j}};
        pg8::gemm_phase<pg8::EpiF<FnAqkv>, pg8::StaticOrder, true, true>(F.lds, g, S, E, relaunder(F).tid);
        { const int ntail = (NTOK / 256) * (A_N / 256) % F.G, rk = F.G == 256 ? (int)blockIdx.x - ntail : (int)blockIdx.x, nbk = F.G == 256 ? F.G - ntail : F.G;
          cat_rows(F, KA->in[I_CAK] + (size_t)j * 16 * 512 * 2048, (bf16*)(ws + SA_CATK), 16, 512, 2048, A_CATROWS, 544, rk, nbk);
          cat_rows(F, KA->in[I_CAV] + (size_t)j * 16 * 512 * 2048, (bf16*)(ws + SA_CATV), 16, 512, 2048, A_CATROWS, 544, rk, nbk); }
    }
    if constexpr (PH == 2) attn_a_phase(F, ws, KA->in[I_ABIAS] + (size_t)j * 16 * 257);
    if constexpr (PH == 3) {
        pg8::Gemm g{(const bf16*)(ws + WS_XN), (const bf16*)(ws + WS_WB_IN), NTOK, B_NP, DM};
        pg8::StaticOrder S; S.init(NTOK, B_NP, F.G, launder_s((int)blockIdx.x), DM);
        pg8::EpiF<FnBproj> E{{(bf16*)(ws + WS_BIG), KA->out, (float*)(ws + WS_SIDE), (bf16*)(ws + SB_CATK), (bf16*)(ws + SB_CATV), (bf16*)(ws + SB_CATI)}};
        pg8::gemm_phase<pg8::EpiF<FnBproj>, pg8::StaticOrder, true, true>(F.lds, g, S, E, relaunder(F).tid);
        { const int ntail = (NTOK / 256) * (B_NP / 256) % F.G, rk = F.G == 256 ? (int)blockIdx.x - ntail : (int)blockIdx.x, nbk = F.G == 256 ? F.G - ntail : F.G;
          cat_rows(F, KA->in[I_CBK], (bf16*)(ws + SB_CATK), 16, 1024, 512, B_CATROWS, 1056, rk, nbk);
          cat_rows(F, KA->in[I_CBV], (bf16*)(ws + SB_CATV), 16, 1024, 512, B_CATROWS, 1056, rk, nbk);
          cat_rows(F, KA->in[I_CBI], (bf16*)(ws + SB_CATI), 16, 1024, 64, B_CATROWS, 1056, rk, nbk); }
    }
    if constexpr (PH == 4) idx_phase(F, ws);
    if constexpr (PH == 5) attn_b_phase(F, ws);
    if constexpr (PH == 6) {
        pg8::Gemm g{(const bf16*)(ws + WS_XN), (const bf16*)(ws + WS_WC_IN), NTOK, C_NP, DM};
        pg8::StaticOrder S; S.init(NTOK, C_NP, F.G, launder_s((int)blockIdx.x), DM);
        pg8::EpiF<FnCproj> E{{(bf16*)(ws + WS_BIG), KA->out, (float*)(ws + WS_SIDE)}};
        pg8::gemm_phase<pg8::EpiF<FnCproj>, pg8::StaticOrder, true, true>(F.lds, g, S, E, relaunder(F).tid);
    }
    if constexpr (PH == 7) { if (F.G > 64) c_prep_phase<0>(F, KA, (int)blockIdx.x, F.G, C_NEARLY); else c_prep_phase<2>(F, KA, (int)blockIdx.x, F.G, C_UNITS); }
    if constexpr (PH == 8) c_scan_phase(F, KA);
    if constexpr (PH == 9) {
        const bf16* wout = kind == 0 ? (const bf16*)(ws + WS_WA_OUT) + (size_t)j * DM * DM : kind == 1 ? (const bf16*)(ws + WS_WB_OUT) : (const bf16*)(ws + WS_WC_OUT);
        pg8::Gemm g{(const bf16*)(ws + WS_ATT), wout, NTOK, DM, kind == 2 ? C_VD : DM};
        pg8::SplitOrder S; S.init(launder_s((int)blockIdx.x), g.K);
        pg8::EpiF<FnMix> E{{(float*)(ws + WS_MIX), (float*)(ws + WS_PART)}};
        pg8::gemm_phase<pg8::EpiF<FnMix>, pg8::SplitOrder, true, true>(F.lds, g, S, E, relaunder(F).tid);
    }
    if constexpr (PH == 10) {
        ln_phase(F, KA->in[I_XP], KA->in[I_XS], layer == 0, (const float*)(ws + WS_MIX), (const float*)(ws + WS_PART), KA->in[I_LN1G] + layer * DM, KA->in[I_LN1B] + layer * DM, nullptr, (bf16*)(ws + WS_XN));
    }
    if constexpr (PH == 11) {
        pg8::Gemm g{(const bf16*)(ws + WS_XN), (const bf16*)(ws + WS_W1) + (size_t)layer * DFF * DM, NTOK, DFF, DM};
        pg8::StaticOrder S; S.init(NTOK, DFF, F.G, launder_s((int)blockIdx.x), DM);
        pg8::EpiF<FnRelu2> E{{(bf16*)(ws + WS_BIG)}};
        pg8::gemm_phase<pg8::EpiF<FnRelu2>, pg8::StaticOrder, true, true>(F.lds, g, S, E, relaunder(F).tid);
    }
    if constexpr (PH == 12) {
        pg8::Gemm g{(const bf16*)(ws + WS_BIG), (const bf16*)(ws + WS_W2) + (size_t)layer * DM * DFF, NTOK, DM, DFF};
        pg8::SplitOrder S; S.init(launder_s((int)blockIdx.x), DFF);
        pg8::EpiF<FnMix> E{{(float*)(ws + WS_MIX), (float*)(ws + WS_PART)}};
        pg8::gemm_phase<pg8::EpiF<FnMix>, pg8::SplitOrder, true, true>(F.lds, g, S, E, relaunder(F).tid);
    }
    if constexpr (PH == 13) ln_phase(F, KA->in[I_XP], KA->in[I_XS], false, (const float*)(ws + WS_MIX), (const float*)(ws + WS_PART), KA->in[I_LN2G] + layer * DM, KA->in[I_LN2B] + layer * DM, layer == DEPTH - 1 ? KA->out + O_YP : nullptr, (bf16*)(ws + WS_XN));
}

constexpr int LDS_BYTES = 147456, MISC_OFF = LDS_BYTES - 64;
#ifndef MK_SINGLE
#define MK_SINGLE 1
#endif
#ifndef MULTIK
__global__ void __launch_bounds__(NTHR, 2) mk_fwd(Args args) {
    extern __shared__ __attribute__((aligned(16))) unsigned char lds_raw[];
    Frame F; F.lds = (LAS unsigned char*)lds_raw;
    F.tid = threadIdx.x; F.lane = F.tid & 63; F.wave = __builtin_amdgcn_readfirstlane(F.tid >> 6);
    F.G = gridDim.x; { const int bx = blockIdx.x; F.vcu = (F.G % 8 == 0) ? (bx % 8) * (F.G / 8) + bx / 8 : bx; }
    const int lo = args.ph_lo, hi = args.ph_hi;
    volatile LAS unsigned* misc = (volatile LAS unsigned*)(F.lds + MISC_OFF);
    if (F.tid < 16) misc[F.tid] = 0u;
    __syncthreads();
    XcdBarrier bar; bar.bar = (unsigned*)(args.ws + WS_CTL) + CW_BAR; bar.x = 0; bar.st = misc;
    if (MK_SINGLE) bar = xcd_barrier_post((unsigned*)(args.ws + WS_CTL) + CW_BAR, misc);
#define IN(k) (lo <= (k) && (k) < hi)
#define SEAM(k) do { if (MK_SINGLE && hi > (k) + 1) xcd_barrier(bar); } while (0)
    if (IN(0)) { run_phase<0>(F, 0); SEAM(0); }
    for (int layer = 0; layer < DEPTH; ++layer) {
        const int kind = layer % 3, base = 1 + 8 * layer;
        if (kind == 0) {
            if (IN(base + 0)) { run_phase<1>(F, layer); SEAM(base + 0); }
            if (IN(base + 1)) { run_phase<2>(F, layer); SEAM(base + 1); }
        } else if (kind == 1) {
            if (IN(base + 0)) { run_phase<3>(F, layer); SEAM(base + 0); }
            if (IN(base + 1)) { run_phase<4>(F, layer); SEAM(base + 1); }
            if (IN(base + 2)) { run_phase<5>(F, layer); SEAM(base + 2); }
        } else {
            if (IN(base + 0)) { run_phase<6>(F, layer); SEAM(base + 0); }
            if (IN(base + 1)) { run_phase<7>(F, layer); SEAM(base + 1); }
            if (IN(base + 2)) { run_phase<8>(F, layer); SEAM(base + 2); }
        }
        if (IN(base + 3)) { run_phase<9>(F, layer); SEAM(base + 3); }
        if (IN(base + 4)) { run_phase<10>(F, layer); SEAM(base + 4); }
        if (IN(base + 5)) { run_phase<11>(F, layer); SEAM(base + 5); }
        if (IN(base + 6)) { run_phase<12>(F, layer); SEAM(base + 6); }
        if (IN(base + 7)) { run_phase<13>(F, layer); SEAM(base + 7); }
    }
#undef IN
#undef SEAM
}
#endif

#ifdef MULTIK
template <int PH> __global__ void __launch_bounds__(NTHR, 2) k_phase(Args args, int layer) {
    extern __shared__ __attribute__((aligned(16))) unsigned char lds_raw[];
    Frame F; F.lds = (LAS unsigned char*)lds_raw;
    F.tid = threadIdx.x; F.lane = F.tid & 63; F.wave = __builtin_amdgcn_readfirstlane(F.tid >> 6);
    F.G = gridDim.x; F.vcu = blockIdx.x;
    run_phase<PH>(F, layer);
}
template <int PH> static void launch_phase(const Args& a, int layer, int grid, hipStream_t stream) {
    static bool attr = false;
    if (!attr) { (void)hipFuncSetAttribute((const void*)k_phase<PH>, hipFuncAttributeMaxDynamicSharedMemorySize, LDS_BYTES); attr = true; }
    hipLaunchKernelGGL(k_phase<PH>, dim3(grid), dim3(NTHR), LDS_BYTES, stream, a, layer);
#ifdef DBL_K
    if (PH == DBL_K) hipLaunchKernelGGL(k_phase<PH>, dim3(grid), dim3(NTHR), LDS_BYTES, stream, a, layer);
#endif
}
#endif
extern "C" void kernel_launch(void* const* d_in, const int* in_sizes, int n_in, void* d_out, int out_size, void* d_ws, size_t ws_size, hipStream_t stream) {
    static int grid = 0;
    if (grid == 0) {
        if (n_in != N_IN || (size_t)out_size != O_END || ws_size < WS_END) { fprintf(stderr, "kernel_launch: shape mismatch n_in %d out %d ws %zu (need %zu)\n", n_in, out_size, ws_size, (size_t)WS_END); grid = -1; return; }
        { const long exp_sz[N_IN] = {(long)NP * DM, (long)NS * DM, 2L * 16 * 512 * 2048, 2L * 16 * 512 * 2048, 16L * 1024 * 512, 16L * 1024 * 512, 16L * 1024 * 64, 16L * 3 * 8192, 16L * 32 * 128 * 128,
                                       2L * DM * A_N, 2L * 16 * 257, 2L * DM * DM, (long)DM * B_N, (long)DM * DM, (long)DM * C_N, 4L * 8192, 32, 32, 128, (long)C_VD * DM,
                                       4L * DM, 4L * DM, 4L * DM * DFF, 4L * DFF * DM, 4L * DM, 4L * DM};
          for (int i = 0; i < N_IN; ++i) if ((long)in_sizes[i] != exp_sz[i]) { fprintf(stderr, "kernel_launch: input %d has %d elements, expected %ld\n", i, in_sizes[i], exp_sz[i]); grid = -1; return; } }
        int dev = 0, cus = 0, per_cu = 0;
        if (hipGetDevice(&dev) != hipSuccess || hipDeviceGetAttribute(&cus, hipDeviceAttributeMultiprocessorCount, dev) != hipSuccess) { grid = -1; return; }
#ifndef MULTIK
        if (hipFuncSetAttribute((const void*)mk_fwd, hipFuncAttributeMaxDynamicSharedMemorySize, LDS_BYTES) != hipSuccess) { grid = -1; return; }
        if (hipOccupancyMaxActiveBlocksPerMultiprocessor(&per_cu, (const void*)mk_fwd, NTHR, LDS_BYTES) != hipSuccess || per_cu < 1) fprintf(stderr, "kernel_launch: occupancy query says %d workgroups per CU\n", per_cu);
#endif
        (void)hipGetLastError();
        grid = cus;
        if (grid != 256) { fprintf(stderr, "kernel_launch: built for a 256-CU device (split-K deal), found %d CUs; nothing launched\n", grid); grid = -1; return; }
    }
    if (grid < 0) return;
    (void)hipMemsetAsync((char*)d_ws + WS_CTL, 0, CTL_ZERO_BYTES, stream);
    Args a{};
    for (int i = 0; i < N_IN; ++i) a.in[i] = (const float*)d_in[i];
    a.out = (float*)d_out; a.ws = (unsigned char*)d_ws;
#ifdef MULTIK
    launch_phase<0>(a, 0, grid, stream);
    for (int layer = 0; layer < DEPTH; ++layer) {
        const int kind = layer % 3;
        if (kind == 0) { launch_phase<1>(a, layer, grid, stream); launch_phase<2>(a, layer, grid, stream); }
        else if (kind == 1) { launch_phase<3>(a, layer, grid, stream); launch_phase<4>(a, layer, grid, stream); launch_phase<5>(a, layer, grid, stream); }
        else { launch_phase<6>(a, layer, grid, stream); launch_phase<7>(a, layer, grid, stream); launch_phase<8>(a, layer, grid, stream); }
        launch_phase<9>(a, layer, grid, stream); launch_phase<10>(a, layer, grid, stream); launch_phase<11>(a, layer, grid, stream); launch_phase<12>(a, layer, grid, stream); launch_phase<13>(a, layer, grid, stream);
    }
    return;
#else
    if (MK_SINGLE) { a.ph_lo = 0; a.ph_hi = 1 + 8 * DEPTH; hipLaunchKernelGGL(mk_fwd, dim3(grid), dim3(NTHR), LDS_BYTES, stream, a); }
    else for (int ph = 0; ph < 1 + 8 * DEPTH; ++ph) { if (ph == 3 || ph == 27) continue; a.ph_lo = ph; a.ph_hi = ph + 1; hipLaunchKernelGGL(mk_fwd, dim3(grid), dim3(NTHR), LDS_BYTES, stream, a); }
#endif
}
```

```cpp
#include <hip/hip_runtime.h>
#include <cstdio>
#include <cstdint>
namespace pg8 {
#define PG8_LAS __attribute__((address_space(3)))
typedef unsigned short bf16_t;
typedef short bf16x8 __attribute__((ext_vector_type(8)));
typedef float f32x4 __attribute__((ext_vector_type(4)));
typedef unsigned u32x4 __attribute__((ext_vector_type(4)));
constexpr int BM = 256, BK = 64, HALF = 128, HTB = HALF * BK * 2  , STAGE_BYTES = 8 * HTB, NXCD = 8, WGM = 8;

__host__ __device__ __forceinline__ int lds_byte(int r, int c) { const int st = (r >> 4) * 2 + (c >> 5), rr = r & 15, cc = c & 31, ob = rr * 64 + cc * 2; return st * 1024 + (ob ^ (((ob >> 9) & 1) << 5)); }
__host__ __device__ __forceinline__ void stage_rc(int b, int& R, int& C) { const int st = b / 1024, sb = b % 1024, swz = sb ^ (((sb >> 9) & 1) << 5); R = (st >> 1) * 16 + swz / 64; C = (st & 1) * 32 + (swz % 64) / 2; }
__host__ __device__ __forceinline__ int perm32(int rho) { const int n = rho >> 4, i = rho & 15; return 8 * (i >> 2) + 4 * n + (i & 3); }

struct Unit { int pm, pn, k0, nt, ks; };
struct Gemm { const bf16_t* A; const bf16_t* Bt; int M, N, K; };

struct StaticOrder {
    int nM, nN, nwg, G, c, Kt;
    __host__ __device__ void init(int M, int N, int G_, int c_, int K_) { nM = M / BM; nN = N / BM; nwg = nM * nN; G = G_; c = c_; Kt = K_ / BK; }
    __host__ __device__ bool next(int i, Unit& u) const {
        const long L = (long)i * G + c; if (L >= nwg) return false;
        int wgid = (int)L; { const int q = nwg / NXCD, r = nwg % NXCD, xcd = wgid % NXCD, off = wgid / NXCD; wgid = (xcd < r ? xcd * (q + 1) : r * (q + 1) + (xcd - r) * q) + off; }
        const int nig = WGM * nN, gid = wgid / nig, fm = gid * WGM, gsz = (nM - fm) < WGM ? (nM - fm) : WGM;
        u.pm = fm + ((wgid % nig) % gsz); u.pn = (wgid % nig) / gsz; u.k0 = 0; u.nt = Kt; u.ks = 0; return true;
    }
    __device__ __forceinline__ void a_ready(const Unit&) const {}
    __device__ __forceinline__ void done(const Unit&) const {}
};


struct SplitOrder {
    int c, Kt;
    __host__ __device__ void init(int c_, int K_) { c = c_; Kt = K_ / BK; }
    __host__ __device__ bool next(int i, Unit& u) const {
        if (i == 0) { const int xcd = c & 7, off = c >> 3;
            const int w = xcd * 32 + off; u.pm = (w >> 5) * 4 + (w & 3); u.pn = (w >> 2) & 7; u.k0 = 0; u.nt = Kt; u.ks = 0; return true; }
        if (i == 1) { u.pm = 32 + (c >> 7); u.pn = (c >> 4) & 7; u.ks = c & 15; u.nt = Kt / 16; u.k0 = u.ks * u.nt * BK; return true; }
        return false;
    }
    __device__ __forceinline__ void a_ready(const Unit&) const {}
    __device__ __forceinline__ void done(const Unit&) const {}
};
__device__ __forceinline__ unsigned cvt_pk_bf16(float lo, float hi) { unsigned r; asm volatile("v_cvt_pk_bf16_f32 %0, %1, %2" : "=v"(r) : "v"(lo), "v"(hi)); return r; }
template <class F> struct EpiF {
    static constexpr bool PERM = true, AFTER_DRAIN = false;
    F f;
    __device__ __forceinline__ void operator()(const f32x4 (&acc)[2][2][4][2], const Unit& u, int wr, int wc, int fr, int fq) const {
        const int row0 = u.pm * BM + wr * 64 + fr, col0 = u.pn * BM + wc * 32 + 8 * fq;
#pragma unroll
        for (int ai = 0; ai < 2; ++ai)
#pragma unroll
            for (int m = 0; m < 4; ++m)
#pragma unroll
                for (int bj = 0; bj < 2; ++bj) f(row0 + ai * HALF + m * 16, col0 + bj * HALF, acc[ai][bj][m][0], acc[ai][bj][m][1], u);
    }
};
template <class Epi, class Sched, bool ALIGN_EPI = false, bool SP2 = false>
__device__ __forceinline__ void gemm_phase(PG8_LAS unsigned char* lds, const Gemm g, const Sched& S, const Epi& E, const int tid  ) {
    const int wid = __builtin_amdgcn_readfirstlane(tid >> 6), lane = tid & 63, wr = wid >> 2, wc = wid & 3, fr = lane & 15, fq = lane >> 4;
    const int K = g.K;
    unsigned voffA[2], voffB[2];
#pragma unroll
    for (int i = 0; i < 2; ++i) { int R, C; stage_rc(tid * 16 + i * 8192, R, C); const int Rb = Epi::PERM ? ((R & ~31) + perm32(R & 31)) : R;
        voffA[i] = (unsigned)(R * K + C) * 2u; voffB[i] = (unsigned)(Rb * K + C) * 2u; }
    const size_t kstep = (size_t)(BK * 2);
    const size_t hstep = (size_t)HALF * K * 2;
    const size_t tstep = 2 * hstep;
    const unsigned ldsw = (unsigned)wid * 1024u;
    const int aoff = lds_byte(wr * 64 + fr, fq * 8), boff = lds_byte(wc * 32 + fr, fq * 8);
#define PG8_SA(b, h) (((b) * 2 + (h)) * HTB)
#define PG8_SB(b, h) ((4 + (b) * 2 + (h)) * HTB)
#define PG8_STAGE(bufoff, gbase, voff) do { _Pragma("unroll") for (int _i = 0; _i < 2; ++_i) \
        __builtin_amdgcn_global_load_lds((const unsigned*)((const char*)(gbase) + (voff)[_i]), (PG8_LAS unsigned*)(lds + (bufoff) + ldsw + _i * 8192), 16, 0, 0); } while (0)
#define PG8_LDA(dst, b, h) do { _Pragma("unroll") for (int m = 0; m < 4; ++m) _Pragma("unroll") for (int k = 0; k < 2; ++k) dst[m][k] = *(const PG8_LAS bf16x8*)(lds + PG8_SA(b, h) + aoff + m * 2048 + k * 1024); } while (0)
#define PG8_LDB(dst, b, h) do { _Pragma("unroll") for (int n = 0; n < 2; ++n) _Pragma("unroll") for (int k = 0; k < 2; ++k) dst[n][k] = *(const PG8_LAS bf16x8*)(lds + PG8_SB(b, h) + boff + n * 2048 + k * 1024); } while (0)
#define PG8_MMA(ai, bj, At, Bt) do { __builtin_amdgcn_s_setprio(1); _Pragma("unroll") for (int m = 0; m < 4; ++m) _Pragma("unroll") for (int n = 0; n < 2; ++n) _Pragma("unroll") for (int k = 0; k < 2; ++k) \
        acc[ai][bj][m][n] = __builtin_amdgcn_mfma_f32_16x16x32_bf16(Bt[n][k], At[m][k], acc[ai][bj][m][n], 0, 0, 0); __builtin_amdgcn_s_setprio(0); } while (0)
#define PG8_WAIT_V(n) asm volatile("s_waitcnt vmcnt(" #n ")" ::: "memory")
#define PG8_WAIT_L(n) asm volatile("s_waitcnt lgkmcnt(" #n ")" ::: "memory")
#define PG8_BAR __builtin_amdgcn_s_barrier()
#define PG8_SCHED __builtin_amdgcn_sched_barrier(0)
    Unit cur, nxt; int ui = 0;
    if (!S.next(0, cur)) return;
    f32x4 acc[2][2][4][2];
#pragma unroll
    for (int a = 0; a < 2; ++a)
#pragma unroll
        for (int b = 0; b < 2; ++b)
#pragma unroll
            for (int m = 0; m < 4; ++m)
#pragma unroll
                for (int n = 0; n < 2; ++n) acc[a][b][m][n] = (f32x4){0.f, 0.f, 0.f, 0.f};
    bf16x8 At[4][2], B0[2][2], B1[2][2];
    const char* cA = (const char*)g.A + (size_t)cur.pm * tstep + (size_t)cur.k0 * 2; const char* cB = (const char*)g.Bt + (size_t)cur.pn * tstep + (size_t)cur.k0 * 2;
    S.a_ready(cur);
    if constexpr (SP2) {
        PG8_STAGE(PG8_SB(0, 0), cB, voffB); PG8_STAGE(PG8_SB(0, 1), cB + hstep, voffB); PG8_STAGE(PG8_SA(0, 0), cA, voffA); PG8_STAGE(PG8_SA(0, 1), cA + hstep, voffA);
        if (wr == 1) PG8_BAR;
        PG8_WAIT_V(2); PG8_BAR;
        PG8_STAGE(PG8_SB(1, 0), cB + kstep, voffB); PG8_STAGE(PG8_SA(1, 0), cA + kstep, voffA); PG8_STAGE(PG8_SB(1, 1), cB + hstep + kstep, voffB);
        PG8_WAIT_V(6); PG8_BAR;
    } else {
        PG8_STAGE(PG8_SB(0, 0), cB, voffB); PG8_STAGE(PG8_SA(0, 0), cA, voffA); PG8_STAGE(PG8_SB(0, 1), cB + hstep, voffB); PG8_STAGE(PG8_SA(0, 1), cA + hstep, voffA);
        if (wr == 1) PG8_BAR;
        PG8_WAIT_V(4); PG8_BAR;
        PG8_STAGE(PG8_SB(1, 0), cB + kstep, voffB); PG8_STAGE(PG8_SA(1, 0), cA + kstep, voffA); PG8_STAGE(PG8_SB(1, 1), cB + hstep + kstep, voffB);
        PG8_WAIT_V(6); PG8_BAR;
    }
    for (;;) {
        const bool has_next = S.next(ui + 1, nxt);
        const char* nA = has_next ? (const char*)g.A + (size_t)nxt.pm * tstep + (size_t)nxt.k0 * 2 : cA; const char* nB = has_next ? (const char*)g.Bt + (size_t)nxt.pn * tstep + (size_t)nxt.k0 * 2 : cB;
        const int nt = cur.nt;
        for (int t = 0; t < nt; t += 2) {
            const bool last = (t == nt - 2);
            const char* a1 = cA + (size_t)(t + 1) * kstep;
            const char* a2 = last ? nA : cA + (size_t)(t + 2) * kstep; const char* b2 = last ? nB : cB + (size_t)(t + 2) * kstep;
            const char* a3 = a2 + kstep; const char* b3 = b2 + kstep;
            if (last && has_next) S.a_ready(nxt);
            if constexpr (SP2) {
            PG8_LDB(B0, 0, 0); PG8_LDB(B1, 0, 1); PG8_SCHED; PG8_LDA(At, 0, 0); PG8_STAGE(PG8_SA(1, 1), a1 + hstep, voffA);
            PG8_WAIT_V(8); PG8_WAIT_L(0); PG8_BAR; PG8_MMA(0, 0, At, B0); PG8_MMA(0, 1, At, B1); PG8_BAR; PG8_SCHED;
            PG8_LDA(At, 0, 1); PG8_STAGE(PG8_SB(0, 0), b2, voffB); PG8_STAGE(PG8_SB(0, 1), b2 + hstep, voffB); PG8_STAGE(PG8_SA(0, 0), a2, voffA);
            PG8_WAIT_V(8); PG8_WAIT_L(0); PG8_BAR; PG8_MMA(1, 0, At, B0); PG8_MMA(1, 1, At, B1); PG8_BAR; PG8_SCHED;
            PG8_LDB(B0, 1, 0); PG8_LDB(B1, 1, 1); PG8_SCHED; PG8_LDA(At, 1, 0); PG8_STAGE(PG8_SA(0, 1), a2 + hstep, voffA);
            PG8_WAIT_V(8); PG8_WAIT_L(0); PG8_BAR; PG8_MMA(0, 0, At, B0); PG8_MMA(0, 1, At, B1); PG8_BAR; PG8_SCHED;
            PG8_LDA(At, 1, 1); PG8_STAGE(PG8_SB(1, 0), b3, voffB); PG8_STAGE(PG8_SB(1, 1), b3 + hstep, voffB); PG8_STAGE(PG8_SA(1, 0), a3, voffA);
            PG8_WAIT_V(8); PG8_WAIT_L(0); PG8_BAR; PG8_MMA(1, 0, At, B0); PG8_MMA(1, 1, At, B1); PG8_BAR; PG8_SCHED;
            } else {
            PG8_LDB(B0, 0, 0); PG8_SCHED; PG8_LDA(At, 0, 0); PG8_STAGE(PG8_SA(1, 1), a1 + hstep, voffA);
            PG8_WAIT_L(8); PG8_BAR; PG8_WAIT_L(0); PG8_MMA(0, 0, At, B0); PG8_BAR; PG8_SCHED;
            PG8_LDB(B1, 0, 1); PG8_STAGE(PG8_SB(0, 0), b2, voffB);
            PG8_BAR; PG8_WAIT_L(0); PG8_MMA(0, 1, At, B1); PG8_BAR;
            PG8_LDA(At, 0, 1); PG8_STAGE(PG8_SA(0, 0), a2, voffA);
            PG8_BAR; PG8_WAIT_L(0); PG8_MMA(1, 0, At, B0); PG8_BAR; PG8_SCHED;
            PG8_STAGE(PG8_SB(0, 1), b2 + hstep, voffB);
            PG8_WAIT_V(6); PG8_BAR; PG8_MMA(1, 1, At, B1); PG8_BAR;
            PG8_LDB(B0, 1, 0); PG8_SCHED; PG8_LDA(At, 1, 0); PG8_STAGE(PG8_SA(0, 1), a2 + hstep, voffA);
            PG8_WAIT_L(8); PG8_BAR; PG8_WAIT_L(0); PG8_MMA(0, 0, At, B0); PG8_BAR; PG8_SCHED;
            PG8_LDB(B1, 1, 1); PG8_STAGE(PG8_SB(1, 0), b3, voffB);
            PG8_BAR; PG8_WAIT_L(0); PG8_MMA(0, 1, At, B1); PG8_BAR;
            PG8_LDA(At, 1, 1); PG8_STAGE(PG8_SA(1, 0), a3, voffA);
            PG8_BAR; PG8_WAIT_L(0); PG8_MMA(1, 0, At, B0); PG8_BAR; PG8_SCHED;
            PG8_STAGE(PG8_SB(1, 1), b3 + hstep, voffB);
            PG8_WAIT_V(6); PG8_BAR; PG8_MMA(1, 1, At, B1); PG8_BAR;
            }
        }
        if constexpr (ALIGN_EPI) { if (wr == 0) PG8_BAR; }
        if constexpr (!Epi::AFTER_DRAIN) { E(acc, cur, wr, wc, fr, fq); S.done(cur); }
        if (!has_next) break;
#pragma unroll
        for (int a = 0; a < 2; ++a)
#pragma unroll
            for (int b = 0; b < 2; ++b)
#pragma unroll
                for (int m = 0; m < 4; ++m)
#pragma unroll
                    for (int n = 0; n < 2; ++n) acc[a][b][m][n] = (f32x4){0.f, 0.f, 0.f, 0.f};
        cur = nxt; cA = nA; cB = nB; ++ui;
        if constexpr (ALIGN_EPI) { if (wr == 1) PG8_BAR; }
    }
    PG8_WAIT_V(0);
    if constexpr (!ALIGN_EPI) { if (wr == 0) PG8_BAR; }
    PG8_BAR;
    if constexpr (Epi::AFTER_DRAIN) { E.fused(acc, cur, wr, wc, fr, fq, lds, wid, lane); S.done(cur); }
#undef PG8_SA
#undef PG8_SB
#undef PG8_STAGE
#undef PG8_LDA
#undef PG8_LDB
#undef PG8_MMA
#undef PG8_WAIT_V
#undef PG8_WAIT_L
#undef PG8_BAR
#undef PG8_SCHED
}
}

constexpr int NP = 8192, NS = 512, NTOK = NP + NS, DM = 2048, DFF = 8192, SEQ = 4096, DEPTH = 4;
constexpr int A_N = 6144, B_N = 4176, B_NP = 4352, C_N = 12352, C_NP = 12544, C_VD = 4096;
constexpr int A_LD = A_N + 128, B_LD = B_NP + 128;
constexpr float ALPHA = 1.681792830507429f;
constexpr float LN_EPS = 1e-5f, RMS_EPS = 1e-6f;
constexpr size_t O_YP = 0, O_YS = O_YP + (size_t)NP * DM, O_AKP = O_YS + (size_t)NS * DM, O_AVP = O_AKP + 2ull * 2 * 512 * 2048, O_AKS = O_AVP + 2ull * 2 * 512 * 2048,
    O_AVS = O_AKS + 2ull * 16 * 32 * 2048, O_BKP = O_AVS + 2ull * 16 * 32 * 2048, O_BVP = O_BKP + (size_t)NP * 512, O_BIP = O_BVP + (size_t)NP * 512, O_BKS = O_BIP + (size_t)NP * 64,
    O_BVS = O_BKS + (size_t)NS * 512, O_BIS = O_BVS + (size_t)NS * 512, O_CCP = O_BIS + (size_t)NS * 64, O_CSP = O_CCP + 2ull * 3 * 8192, O_CCS = O_CSP + 2ull * 32 * 128 * 128,
    O_CSS = O_CCS + 16ull * 3 * 8192, O_END = O_CSS + 16ull * 32 * 128 * 128;
enum { I_XP = 0, I_XS, I_CAK, I_CAV, I_CBK, I_CBV, I_CBI, I_SCC, I_SCS, I_AWIN, I_ABIAS, I_AWOUT, I_BWIN, I_BWOUT, I_CWIN, I_CCONVW, I_CALOG, I_CDT, I_CNORM, I_CWOUT,
       I_LN1G, I_LN1B, I_W1, I_W2, I_LN2G, I_LN2B, N_IN };

constexpr size_t MiB = 1u << 20;
constexpr size_t WS_CTL = 0, CTL_ZERO_BYTES = 1 * MiB;
constexpr size_t WS_WA_IN = 1 * MiB;
constexpr size_t WS_WA_OUT = WS_WA_IN + 48 * MiB;
constexpr size_t WS_WB_IN = WS_WA_OUT + 16 * MiB;
constexpr size_t WS_WB_OUT = WS_WB_IN + 17 * MiB;
constexpr size_t WS_WC_IN = WS_WB_OUT + 8 * MiB;
constexpr size_t WS_WC_OUT = WS_WC_IN + 49 * MiB;
constexpr size_t WS_W1 = WS_WC_OUT + 16 * MiB;
constexpr size_t WS_W2 = WS_W1 + 128 * MiB;
constexpr size_t WS_XN = WS_W2 + 128 * MiB;
constexpr size_t WS_BIG = WS_XN + 34 * MiB;
constexpr size_t WS_ATT = WS_BIG + 209 * MiB;
constexpr size_t WS_MIX = WS_ATT + 68 * MiB;
constexpr size_t WS_SIDE = WS_MIX + 68 * MiB;
constexpr size_t WS_SCR = WS_SIDE + 4 * MiB;
constexpr size_t WS_S0COPY = WS_SCR + 330 * MiB;
constexpr size_t WS_PART = WS_S0COPY + 32 * MiB;
constexpr size_t WS_END = WS_PART + 64 * MiB;
constexpr int A_CATROWS = 640;
constexpr size_t SA_CATK = WS_SCR, SA_CATV = SA_CATK + 16ull * A_CATROWS * 2048 * 2;
constexpr int B_CATROWS = 1152;
constexpr size_t SB_CATK = WS_SCR, SB_CATV = SB_CATK + 16ull * B_CATROWS * 512 * 2, SB_CATI = SB_CATV + 16ull * B_CATROWS * 512 * 2,
    SB_SCORE = SB_CATI + 16ull * B_CATROWS * 64 * 2 + MiB / 2, SB_MASK = SB_SCORE + (size_t)NTOK * 4096 * 4, SB_END = SB_MASK + (size_t)NTOK * 512;
static_assert(SB_END <= WS_S0COPY && SA_CATV + 16ull * A_CATROWS * 2048 * 2 <= WS_S0COPY, "scratch map");
constexpr int CW_BAR = 4096, CW_QB = 8192, CW_TF = 16384;

#define GAS __attribute__((address_space(1)))
#define LAS __attribute__((address_space(3)))
typedef unsigned short bf16;
typedef unsigned v4u __attribute__((ext_vector_type(4)));
typedef unsigned v2u __attribute__((ext_vector_type(2)));
typedef float f32x4 __attribute__((ext_vector_type(4)));
typedef float f32x2 __attribute__((ext_vector_type(2)));
typedef short bf16x8 __attribute__((ext_vector_type(8)));
typedef GAS unsigned gu32;
#define LDS_WAIT() asm volatile("s_waitcnt lgkmcnt(0)" ::: "memory")
#define VM_WAIT() asm volatile("s_waitcnt vmcnt(0)" ::: "memory")
constexpr int NWAVES = 8, NTHR = 512;
__device__ __forceinline__ unsigned pk2(float lo, float hi) { return pg8::cvt_pk_bf16(lo, hi); }
__device__ __forceinline__ float bf2f(bf16 b) { return __uint_as_float((unsigned)b << 16); }
__device__ __forceinline__ float wave_sum(float v) {
#pragma unroll
    for (int o = 1; o < 64; o <<= 1) v += __shfl_xor(v, o);
    return v;
}
__device__ __forceinline__ void store8_bf16(bf16* p, f32x4 v0, f32x4 v1) { v4u w; w.x = pk2(v0[0], v0[1]); w.y = pk2(v0[2], v0[3]); w.z = pk2(v1[0], v1[1]); w.w = pk2(v1[2], v1[3]); *(v4u*)p = w; }
__device__ __forceinline__ void store8_f32(float* p, f32x4 v0, f32x4 v1) { *(f32x4*)p = v0; *(f32x4*)(p + 4) = v1; }

#define XB_TMO      128
#define XB_XCNT(j)  (256  + 64 * (j))
#define XB_XSUB(j)  (1280 + 64 * (j))
#define XB_XGEN(j)  (2304 + 64 * (j))
#define XB_TOP      3328
#define XB_TOPGEN   3392
#define XCD_BAR_WORDS 3456
#define XB_SPIN_CAP (1u << 18)

__device__ __forceinline__ unsigned xb_ld(unsigned* p)              { return __hip_atomic_load(p, __ATOMIC_RELAXED, __HIP_MEMORY_SCOPE_AGENT); }
__device__ __forceinline__ unsigned xb_add(unsigned* p, unsigned v) { return __hip_atomic_fetch_add(p, v, __ATOMIC_RELAXED, __HIP_MEMORY_SCOPE_AGENT); }
__device__ __forceinline__ unsigned xb_xcc_id() { return (unsigned)__builtin_amdgcn_s_getreg((3 << 11) | 20) & 0xFu; }
#define XB_SPIN(cond, bar) do { unsigned _sp = 0; while (cond) { __builtin_amdgcn_s_sleep(1); \
    if ((++_sp & 255u) == 0u) { if (xb_ld(&(bar)[XB_TMO])) break; if (_sp > XB_SPIN_CAP) { atomicAdd(&(bar)[XB_TMO], 1u); break; } } } } while (0)

struct XcdBarrier {
    unsigned* bar; unsigned x;
    volatile LAS unsigned* st;
};

__device__ __forceinline__ XcdBarrier xcd_barrier_post(unsigned* bar, volatile LAS unsigned* st) {
    XcdBarrier b; b.bar = bar; b.x = xb_xcc_id(); b.st = st;
    if (threadIdx.x == 0) (void)xb_add(&bar[XB_XCNT(b.x)], 1u);
    return b;
}
__device__ __forceinline__ void xcd_barrier_complete(unsigned* bar, unsigned x, unsigned& nloc, unsigned& nx) {
    const unsigned G = gridDim.x * gridDim.y * gridDim.z;
    unsigned sum, cnt, mine, sp = 0u;
    for (;;) {
        sum = 0u; cnt = 0u; mine = 0u;
#pragma unroll
        for (unsigned j = 0; j < 16; ++j) { const unsigned c = xb_ld(&bar[XB_XCNT(j)]); sum += c; cnt += (c > 0u) ? 1u : 0u; mine = (j == x) ? c : mine; }
        if (sum == G) break;
        __builtin_amdgcn_s_sleep(1);
        if ((++sp & 255u) == 0u) { if (xb_ld(&bar[XB_TMO])) break; if (sp > XB_SPIN_CAP) { atomicAdd(&bar[XB_TMO], 1u); break; } }
    }
    nloc = mine > 0u ? mine : 1u; nx = cnt > 0u ? cnt : 1u;
}

__device__ __forceinline__ void xcd_barrier(const XcdBarrier& b) {
    asm volatile("s_waitcnt vmcnt(0)" ::: "memory");
    __syncthreads();
    if (threadIdx.x == 0) {
        unsigned* bar = b.bar;
        __builtin_amdgcn_s_waitcnt(0);
        unsigned nloc = b.st[0], nx = b.st[1];
        if (nloc == 0u) { xcd_barrier_complete(bar, b.x, nloc, nx); b.st[0] = nloc; b.st[1] = nx; }
        const unsigned old = xb_add(&bar[XB_XSUB(b.x)], 1u);
        const unsigned gen = old / nloc;
        if (old + 1u == (gen + 1u) * nloc) {
            __builtin_amdgcn_fence(__ATOMIC_RELEASE, "agent");
            asm volatile("s_waitcnt vmcnt(0)" ::: "memory");
            const unsigned og = xb_add(&bar[XB_TOP], 1u);
            const unsigned tg = og / nx;
            if (og + 1u == (tg + 1u) * nx) xb_add(&bar[XB_TOPGEN], 1u);
            else XB_SPIN(xb_ld(&bar[XB_TOPGEN]) == tg, bar);
            __builtin_amdgcn_fence(__ATOMIC_ACQUIRE, "agent");
            xb_add(&bar[XB_XGEN(b.x)], 1u);
            asm volatile("s_waitcnt vmcnt(0)" ::: "memory");
        } else {
            XB_SPIN(xb_ld(&bar[XB_XGEN(b.x)]) == gen, bar);
            __builtin_amdgcn_fence(__ATOMIC_ACQUIRE, "agent");
            asm volatile("s_waitcnt vmcnt(0)" ::: "memory");
        }
    }
    __syncthreads();
}

namespace att {
constexpr int D = 128, NW = 8, QBLK = 32, KVBLK = 64;
constexpr float SCALE = 0.088388347648318440f;
constexpr float THR = 8.f;
constexpr size_t SHM_V = KVBLK * D * 2, SHM_K = KVBLK * D * 2, SHM_ATTN = 2 * SHM_V + 2 * SHM_K + NW * 64 * 4;
constexpr size_t SHM_BIAS = SHM_ATTN;
using s16x4  = __attribute__((ext_vector_type(4))) short;
using f32x16 = __attribute__((ext_vector_type(16))) float;
using u32x4  = __attribute__((ext_vector_type(4))) unsigned;
#define KSWZ(row, colB) ((row) * 256 + ((colB) ^ (((row) & 7) << 4)))
#define SBAR() __builtin_amdgcn_sched_barrier(0)
__device__ __forceinline__ int crow(int r, int hi) { return (r & 3) + 8 * (r >> 2) + 4 * hi; }
__device__ __forceinline__ unsigned cvtpk(float lo, float hi) { unsigned r; asm volatile("v_cvt_pk_bf16_f32 %0, %1, %2" : "=v"(r) : "v"(lo), "v"(hi)); return r; }

__device__ __forceinline__ void partialSM(f32x16& p0, f32x16& p1, float& m_reg, float& mn, float& alpha) {
  constexpr float C = SCALE * 1.4426950408889634f;
  float pmax = p0[0];
#pragma unroll
  for (int r = 1; r < 16; ++r) pmax = fmaxf(pmax, p0[r]);
#pragma unroll
  for (int r = 0; r < 16; ++r) pmax = fmaxf(pmax, p1[r]);
  { auto rr = __builtin_amdgcn_permlane32_swap(__float_as_uint(pmax), __float_as_uint(pmax), false, false);
    pmax = fmaxf(__uint_as_float(rr[0]), __uint_as_float(rr[1])); }
  if (__builtin_expect(__all(pmax - m_reg <= THR / SCALE), 1)) { mn = m_reg; alpha = 1.f; }
  else { mn = fmaxf(m_reg, pmax); alpha = __builtin_amdgcn_exp2f((m_reg - mn) * C); m_reg = mn; }
  float mnC = -mn * C;
#pragma unroll
  for (int r = 0; r < 16; ++r) p0[r] = fmaf(p0[r], C, mnC);
#pragma unroll
  for (int r = 0; r < 16; ++r) p1[r] = fmaf(p1[r], C, mnC);
#pragma unroll
  for (int r = 0; r < 16; ++r) p0[r] = __builtin_amdgcn_exp2f(p0[r]);
}
__device__ __forceinline__ void finishSM(f32x16& p0, f32x16& p1, float alpha, float& l_reg, bf16x8& pa0, bf16x8& pa1, bf16x8& pa2, bf16x8& pa3) {
#pragma unroll
  for (int r = 0; r < 16; ++r) p1[r] = __builtin_amdgcn_exp2f(p1[r]);
  float ps = 0;
#pragma unroll
  for (int r = 0; r < 16; ++r) ps += p0[r];
#pragma unroll
  for (int r = 0; r < 16; ++r) ps += p1[r];
  { auto rr = __builtin_amdgcn_permlane32_swap(__float_as_uint(ps), __float_as_uint(ps), false, false);
    ps = __uint_as_float(rr[0]) + __uint_as_float(rr[1]); }
  l_reg = l_reg * alpha + ps;
#define PK4(P, BASE, OUT) do { unsigned a0 = cvtpk(P[BASE + 0], P[BASE + 1]), a1 = cvtpk(P[BASE + 2], P[BASE + 3]);   \
    unsigned b0 = cvtpk(P[BASE + 4], P[BASE + 5]), b1 = cvtpk(P[BASE + 6], P[BASE + 7]);                              \
    auto r0 = __builtin_amdgcn_permlane32_swap(a0, b0, false, false); auto r1 = __builtin_amdgcn_permlane32_swap(a1, b1, false, false); \
    u32x4 w = {r0[0], r1[0], r0[1], r1[1]}; OUT = *reinterpret_cast<bf16x8*>(&w); } while (0)
  PK4(p0, 0, pa0); PK4(p0, 8, pa1); PK4(p1, 0, pa2); PK4(p1, 8, pa3);
#undef PK4
}
__device__ __forceinline__ void qkt(f32x16& p0, f32x16& p1, const bf16* Ks, const bf16x8* qr, int r32, int hi) {
  p0 = f32x16{}; p1 = f32x16{};
#pragma unroll
  for (int d0 = 0; d0 < 8; ++d0) { int cb = (d0 * 16 + hi * 8) * 2;
    bf16x8 b0 = *reinterpret_cast<const bf16x8*>((const char*)Ks + KSWZ(r32, cb));
    bf16x8 b1 = *reinterpret_cast<const bf16x8*>((const char*)Ks + KSWZ(32 + r32, cb));
    p0 = __builtin_amdgcn_mfma_f32_32x32x16_bf16(b0, qr[d0], p0, 0, 0, 0);
    p1 = __builtin_amdgcn_mfma_f32_32x32x16_bf16(b1, qr[d0], p1, 0, 0, 0); }
}
__device__ __forceinline__ int v_st(int k, int c) { const int kk = (k & ~0xC) | ((k & 4) << 1) | ((k & 8) >> 1); return ((kk >> 3) * 4 + (c >> 5)) * 512 + ((kk & 7) * 32 + (c & 31)) * 2; }
__device__ __forceinline__ int v_rd_base(int lane) { return ((lane & 3) << 3) | (((lane >> 2) & 3) << 6) | (((lane >> 4) & 1) << 5) | (((lane >> 5) & 1) << 8); }
constexpr int v_rd_off(int d0, int ks, int half) { return d0 * 512 + ks * 4096 + half * 2048; }
template <int OFF> __device__ __forceinline__ s16x4 tr_read(int vb) {
  s16x4 r; asm volatile("ds_read_b64_tr_b16 %0, %1 offset:%2" : "=&v"(r) : "v"(vb), "i"(OFF) : "memory"); return r;
}
template <int D0> __device__ __forceinline__ void pv_one(f32x16& od, int vb, bf16x8 pa0, bf16x8 pa1, bf16x8 pa2, bf16x8 pa3) {
  const s16x4 l0 = tr_read<v_rd_off(D0, 0, 0)>(vb), h0 = tr_read<v_rd_off(D0, 0, 1)>(vb), l1 = tr_read<v_rd_off(D0, 1, 0)>(vb), h1 = tr_read<v_rd_off(D0, 1, 1)>(vb);
  const s16x4 l2 = tr_read<v_rd_off(D0, 2, 0)>(vb), h2 = tr_read<v_rd_off(D0, 2, 1)>(vb), l3 = tr_read<v_rd_off(D0, 3, 0)>(vb), h3 = tr_read<v_rd_off(D0, 3, 1)>(vb);
  asm volatile("s_waitcnt lgkmcnt(0)" ::: "memory"); SBAR();
#define PK(L, H) (bf16x8){L[0], L[1], L[2], L[3], H[0], H[1], H[2], H[3]}
  od = __builtin_amdgcn_mfma_f32_32x32x16_bf16(pa0, PK(l0, h0), od, 0, 0, 0);
  od = __builtin_amdgcn_mfma_f32_32x32x16_bf16(pa1, PK(l1, h1), od, 0, 0, 0);
  od = __builtin_amdgcn_mfma_f32_32x32x16_bf16(pa2, PK(l2, h2), od, 0, 0, 0);
  od = __builtin_amdgcn_mfma_f32_32x32x16_bf16(pa3, PK(l3, h3), od, 0, 0, 0);
#undef PK
}
__device__ __forceinline__ void pv_d0(f32x16* o, int vb, bf16x8 pa0, bf16x8 pa1, bf16x8 pa2, bf16x8 pa3) {
  pv_one<0>(o[0], vb, pa0, pa1, pa2, pa3); pv_one<1>(o[1], vb, pa0, pa1, pa2, pa3); pv_one<2>(o[2], vb, pa0, pa1, pa2, pa3); pv_one<3>(o[3], vb, pa0, pa1, pa2, pa3);
}

template <class Mask>
__device__ __forceinline__ void attn_body(const bf16* __restrict__ Qw, int ldq, const bf16* __restrict__ Kh, const bf16* __restrict__ Vh, int ldk,
                                          bf16* __restrict__ Ow, int ldo, bool active, int NT, char* lds, const Mask& Mk, int tid) {
  const int wid = tid >> 6, lane = tid & 63, r32 = lane & 31, hi = lane >> 5;
  bf16* V_lds = (bf16*)lds; bf16* K_lds = (bf16*)(lds + 2 * SHM_V);
  float* ws = (float*)(lds + 2 * SHM_V + 2 * SHM_K) + wid * 64; float* li_l = ws; float* al_l = ws + 32;
  float m_reg = -1e30f, l_reg = 0; f32x16 o[4] = {}; bf16x8 qr[8];
  const bf16* Qp = Qw + (long)r32 * ldq + hi * 8;
#pragma unroll
  for (int d0 = 0; d0 < 8; ++d0) qr[d0] = *reinterpret_cast<const bf16x8*>(Qp + d0 * 16);
  const int sr = tid >> 4, sc = (tid & 15) * 8, vst0 = v_st(sr, sc), vst1 = v_st(32 + sr, sc);
  const int vb0 = (int)(uintptr_t)V_lds + v_rd_base(lane);
  struct { bf16x8 vs0, vs1, ks0, ks1; } sr_[1];
#define SLOAD(i, k0) do { sr_[i].vs0 = *reinterpret_cast<const bf16x8*>(&Vh[(long)((k0) + sr) * ldk + sc]); sr_[i].vs1 = *reinterpret_cast<const bf16x8*>(&Vh[(long)((k0) + 32 + sr) * ldk + sc]); \
    sr_[i].ks0 = *reinterpret_cast<const bf16x8*>(&Kh[(long)((k0) + sr) * ldk + sc]); sr_[i].ks1 = *reinterpret_cast<const bf16x8*>(&Kh[(long)((k0) + 32 + sr) * ldk + sc]); } while (0)
#define SWRITE(b, i) do { *(bf16x8*)((char*)V_lds + (b) * SHM_V + vst0) = sr_[i].vs0;          \
    *(bf16x8*)((char*)V_lds + (b) * SHM_V + vst1) = sr_[i].vs1; int kc = sc * 2;               \
    *(bf16x8*)((char*)K_lds + (b) * SHM_K + KSWZ(sr, kc)) = sr_[i].ks0;                       \
    *(bf16x8*)((char*)K_lds + (b) * SHM_K + KSWZ(32 + sr, kc)) = sr_[i].ks1; } while (0)
#define SWAIT() asm volatile("s_waitcnt vmcnt(0)" ::: "memory")
#define RESC(a) do { if (__any((a) < 1.f)) { if (hi == 0) al_l[r32] = (a); asm volatile("s_waitcnt lgkmcnt(0)" ::: "memory"); \
    _Pragma("unroll") for (int d = 0; d < 4; ++d) _Pragma("unroll") for (int r = 0; r < 16; ++r) o[d][r] *= al_l[crow(r, hi)]; } } while (0)
  f32x16 pA0, pA1, pB0, pB1; float mnA, mnB, alA, alB; bf16x8 pa0, pa1, pa2, pa3;
  constexpr int SE = 0, SO = 0;
  SLOAD(SE, 0); asm volatile("s_waitcnt vmcnt(0)" ::: "memory"); SWRITE(0, SE); __syncthreads();
  qkt(pA0, pA1, K_lds, qr, r32, hi); Mk.apply(pA0, pA1, 0, r32, hi); partialSM(pA0, pA1, m_reg, mnA, alA);
  SLOAD(SO, KVBLK);
  SWAIT(); SWRITE(1, SO); __syncthreads();
  for (int j = 1; j + 1 < NT; j += 2) {
    SBAR(); qkt(pB0, pB1, (bf16*)((char*)K_lds + SHM_K), qr, r32, hi); Mk.apply(pB0, pB1, j, r32, hi);
    finishSM(pA0, pA1, alA, l_reg, pa0, pa1, pa2, pa3); SBAR();
    SLOAD(SO, (j + 1) * KVBLK); SBAR();
    pv_d0(o, vb0, pa0, pa1, pa2, pa3); partialSM(pB0, pB1, m_reg, mnB, alB);
    __syncthreads(); SWAIT(); SWRITE(0, SE);
    RESC(alB); __syncthreads();
    SBAR(); qkt(pA0, pA1, K_lds, qr, r32, hi); Mk.apply(pA0, pA1, j + 1, r32, hi);
    finishSM(pB0, pB1, alB, l_reg, pa0, pa1, pa2, pa3); SBAR();
    SLOAD(SE, (j + 2) * KVBLK); SBAR();
    pv_d0(o, vb0 + (int)SHM_V, pa0, pa1, pa2, pa3); partialSM(pA0, pA1, m_reg, mnA, alA);
    __syncthreads(); SWAIT(); SWRITE(1, SO);
    RESC(alA); __syncthreads();
  }
  SBAR(); qkt(pB0, pB1, (bf16*)((char*)K_lds + SHM_K), qr, r32, hi); Mk.apply(pB0, pB1, NT - 1, r32, hi);
  finishSM(pA0, pA1, alA, l_reg, pa0, pa1, pa2, pa3); SBAR();
  pv_d0(o, vb0, pa0, pa1, pa2, pa3); partialSM(pB0, pB1, m_reg, mnB, alB);
  __syncthreads(); RESC(alB);
  finishSM(pB0, pB1, alB, l_reg, pa0, pa1, pa2, pa3); SBAR();
  pv_d0(o, vb0 + (int)SHM_V, pa0, pa1, pa2, pa3);
  if (hi == 0) li_l[r32] = l_reg; asm volatile("s_waitcnt lgkmcnt(0)" ::: "memory");
  float rli[16];
#pragma unroll
  for (int r = 0; r < 16; ++r) rli[r] = __builtin_amdgcn_rcpf(li_l[crow(r, hi)]);
  if (active) {
    bf16* Ob = Ow + r32; int hi_e = hi; asm volatile("" : "+v"(Ob), "+v"(hi_e));
#pragma unroll
    for (int r = 0; r < 16; ++r) { const int orow = crow(r, hi_e);
#pragma unroll
      for (int d0 = 0; d0 < 4; ++d0) { const float v = o[d0][r] * rli[r]; Ob[(long)orow * ldo + d0 * 32] = (bf16)(cvtpk(v, v) & 0xffffu); } }
  }
  __syncthreads();
#undef SLOAD
#undef SWRITE
#undef SWAIT
#undef RESC
}

struct MaskAPrompt {
  const float* bias;
  int qc, kc0, qoff;
  __device__ __forceinline__ void apply(f32x16& p0, f32x16& p1, int j, int r32, int hi) const {
    const int dc = qc - (kc0 + j);
    if (dc < 0 || dc > 8) {
#pragma unroll
      for (int r = 0; r < 16; ++r) { p0[r] = -INFINITY; p1[r] = -INFINITY; }
    } else if (dc >= 3) { const float b = bias[256];
#pragma unroll
      for (int r = 0; r < 16; ++r) { p0[r] += b; p1[r] += b; }
    } else { int base = dc * 64 + qoff + r32 + 128; asm volatile("" : "+v"(base));
#pragma unroll
      for (int r = 0; r < 16; ++r) { const int i0 = base - crow(r, hi), i1 = i0 - 32;
        p0[r] += bias[min(max(i0, 0), 256)]; p1[r] += bias[min(max(i1, 0), 256)]; }
    }
  }
};
struct MaskASample {
  const float* bias;
  __device__ __forceinline__ void apply(f32x16& p0, f32x16& p1, int j, int r32, int hi) const {
    int base = 512 + r32 + 128 - 64 * j; asm volatile("" : "+v"(base));
#pragma unroll
    for (int r = 0; r < 16; ++r) { const int k0 = crow(r, hi), i0 = base - k0, i1 = i0 - 32;
      p0[r] = (64 * j + k0 < 544) ? p0[r] + bias[min(max(i0, 0), 256)] : -INFINITY;
      p1[r] = (64 * j + 32 + k0 < 544) ? p1[r] + bias[min(max(i1, 0), 256)] : -INFINITY; }
  }
};
struct MaskBits {
  const unsigned* mrow;
  __device__ __forceinline__ void apply(f32x16& p0, f32x16& p1, int j, int r32, int hi) const {
    const unsigned w0 = mrow[2 * j], w1 = mrow[2 * j + 1];
#pragma unroll
    for (int r = 0; r < 16; ++r) { const int k0 = crow(r, hi);
      p0[r] = ((w0 >> k0) & 1u) ? p0[r] : -INFINITY; p1[r] = ((w1 >> k0) & 1u) ? p1[r] : -INFINITY; }
  }
};
#undef KSWZ
#undef SBAR
}

struct Args { const float* in[N_IN]; float* out; unsigned char* ws; int ph_lo, ph_hi; };
typedef const __attribute__((address_space(4))) Args* KArgs;
__device__ __forceinline__ KArgs kargs() { KArgs k = (KArgs)__builtin_amdgcn_kernarg_segment_ptr(); asm volatile("" : "+s"(k)); return k; }
struct Frame {
    LAS unsigned char* lds;
    int tid, lane, wave, G, vcu;
};
__device__ __forceinline__ Frame relaunder(Frame F) { int l = __builtin_amdgcn_mbcnt_hi(~0u, __builtin_amdgcn_mbcnt_lo(~0u, 0u)); asm volatile("" : "+v"(l)); F.lane = l; F.tid = F.wave * 64 + l; return F; }
__device__ __forceinline__ int launder_s(int x) { asm volatile("" : "+s"(x)); return x; }
#ifndef EXP_WJ
#define EXP_WJ j
#endif
#ifndef EXP_S0MUL
#define EXP_S0MUL
#endif
#ifndef PROBE_SCALE
#define PROBE_SCALE 1.0f
#endif

__device__ __forceinline__ void transpose_item(const float* __restrict__ W, int K, int N, bf16* __restrict__ WT, LAS float* scr, int item, int nblk, int lane) {
    const int kb = item / nblk, nb = item - kb * nblk, k0 = 64 * kb, n0 = 32 * nb;
    const int kr = lane >> 3, nq = (lane & 7) * 4; const bool ok = n0 + nq < N;
    f32x4 v[8];
#pragma unroll
    for (int i = 0; i < 8; ++i) v[i] = ok ? *(const f32x4*)(W + (size_t)(k0 + 8 * i + kr) * N + n0 + nq) : (f32x4){0.f, 0.f, 0.f, 0.f};
#pragma unroll
    for (int i = 0; i < 8; ++i) { LAS float* d = scr + (8 * i + kr) * 33 + nq; d[0] = v[i][0]; d[1] = v[i][1]; d[2] = v[i][2]; d[3] = v[i][3]; }
    LDS_WAIT(); asm volatile("" ::: "memory");
    const int c = lane & 7;
#pragma unroll
    for (int j = 0; j < 4; ++j) { const int nn = (lane >> 3) + 8 * j; const LAS float* s = scr + (8 * c) * 33 + nn;
        v4u o; o.x = pk2(s[0 * 33], s[1 * 33]); o.y = pk2(s[2 * 33], s[3 * 33]); o.z = pk2(s[4 * 33], s[5 * 33]); o.w = pk2(s[6 * 33], s[7 * 33]);
        *(v4u*)(WT + (size_t)(n0 + nn) * K + k0 + 8 * c) = o; }
    LDS_WAIT(); asm volatile("" ::: "memory");
}
__device__ __forceinline__ void cvt_rows(const Frame& F0, const float* __restrict__ src, bf16* __restrict__ dst, size_t n8) {
    const Frame F = relaunder(F0);
    for (size_t i = (size_t)blockIdx.x * NTHR + F.tid; i < n8; i += (size_t)F.G * NTHR) {
        const f32x4 a = *(const f32x4*)(src + i * 8), b = *(const f32x4*)(src + i * 8 + 4); store8_bf16(dst + i * 8, a, b); }
}
__device__ __forceinline__ void copy_f32(const Frame& F0, const float* __restrict__ src, float* __restrict__ dst, size_t n4) {
    const Frame F = relaunder(F0);
    for (size_t i = (size_t)blockIdx.x * NTHR + F.tid; i < n4; i += (size_t)F.G * NTHR) *(f32x4*)(dst + i * 4) = *(const f32x4*)(src + i * 4);
}
__device__ __forceinline__ void cat_rows(const Frame& F0, const float* __restrict__ src, bf16* __restrict__ dst, int nb, int rows, int w, int dst_rows, int zero_lo, const int rank, const int nblk) {
    if (rank < 0) return;
    const Frame F = relaunder(F0);
    const int w8 = w / 8; const size_t per_b = (size_t)rows * w8, n = per_b * nb;
    for (size_t i = (size_t)rank * NTHR + F.tid; i < n; i += (size_t)nblk * NTHR) {
        const size_t b = i / per_b, r = i - b * per_b;
        const f32x4 x = *(const f32x4*)(src + i * 8), y = *(const f32x4*)(src + i * 8 + 4); store8_bf16(dst + (b * dst_rows) * w + r * 8, x, y); }
    const size_t zper = (size_t)(dst_rows - zero_lo) * w8, zn = zper * nb;
    unsigned z0 = 0u; asm volatile("" : "+v"(z0)); const v4u zz = {z0, z0, z0, z0};
    for (size_t i = (size_t)rank * NTHR + F.tid; i < zn; i += (size_t)nblk * NTHR) {
        const size_t b = i / zper, r = i - b * zper; *(v4u*)(dst + (b * dst_rows + zero_lo) * w + r * 8) = zz; }
}

template <bool DEFERRED> __device__ __forceinline__ void convert_weights(const Frame& F, KArgs a, const int gw, const int NGW, const int lo = 0, const int hi = 1 << 30) {
    LAS float* scr = (LAS float*)(F.lds + F.wave * 16384);
    unsigned char* ws = a->ws;
    constexpr int I_AIN = 32 * 192, I_AOUT = 32 * 64, I_BIN = 32 * (B_NP / 32), I_BOUT = 32 * 64, I_CIN = 32 * (C_NP / 32), I_COUT = 64 * 64, I_M1 = 32 * 256, I_M2 = 128 * 64;
    if constexpr (!DEFERRED) {
        constexpr int NITEMS = I_AIN + I_AOUT + I_BIN + I_BOUT + I_CIN + 2 * I_M1 + 2 * I_M2;
        for (int it = gw; it < NITEMS; it += NGW) {
            int r = it;
            if (r < I_AIN) { transpose_item(a->in[I_AWIN], DM, A_N, (bf16*)(ws + WS_WA_IN), scr, r, 192, F.lane); continue; } r -= I_AIN;
            if (r < I_AOUT) { transpose_item(a->in[I_AWOUT], DM, DM, (bf16*)(ws + WS_WA_OUT), scr, r, 64, F.lane); continue; } r -= I_AOUT;
            if (r < I_BIN) { transpose_item(a->in[I_BWIN], DM, B_N, (bf16*)(ws + WS_WB_IN), scr, r, B_NP / 32, F.lane); continue; } r -= I_BIN;
            if (r < I_BOUT) { transpose_item(a->in[I_BWOUT], DM, DM, (bf16*)(ws + WS_WB_OUT), scr, r, 64, F.lane); continue; } r -= I_BOUT;
            if (r < I_CIN) { transpose_item(a->in[I_CWIN], DM, C_N, (bf16*)(ws + WS_WC_IN), scr, r, C_NP / 32, F.lane); continue; } r -= I_CIN;
            if (r < 2 * I_M1) { const int j = r / I_M1; r -= j * I_M1; transpose_item(a->in[I_W1] + (size_t)j * DM * DFF, DM, DFF, (bf16*)(ws + WS_W1) + (size_t)j * DFF * DM, scr, r, 256, F.lane); continue; } r -= 2 * I_M1;
            { const int j = r / I_M2; r -= j * I_M2; transpose_item(a->in[I_W2] + (size_t)j * DFF * DM, DFF, DM, (bf16*)(ws + WS_W2) + (size_t)j * DM * DFF, scr, r, 64, F.lane); }
        }
    } else {
        constexpr int NITEMS = I_COUT + I_AIN + I_AOUT + 2 * I_M1 + 2 * I_M2;
        for (int it = lo + gw; it < (hi < NITEMS ? hi : NITEMS); it += NGW) {
            int r = it;
            if (r < I_COUT) { transpose_item(a->in[I_CWOUT], C_VD, DM, (bf16*)(ws + WS_WC_OUT), scr, r, 64, F.lane); continue; } r -= I_COUT;
            if (r < I_AIN) { transpose_item(a->in[I_AWIN] + (size_t)DM * A_N, DM, A_N, (bf16*)(ws + WS_WA_IN) + (size_t)A_N * DM, scr, r, 192, F.lane); continue; } r -= I_AIN;
            if (r < I_AOUT) { transpose_item(a->in[I_AWOUT] + (size_t)DM * DM, DM, DM, (bf16*)(ws + WS_WA_OUT) + (size_t)DM * DM, scr, r, 64, F.lane); continue; } r -= I_AOUT;
            if (r < 2 * I_M1) { const int j = 2 + r / I_M1; r -= (j - 2) * I_M1; transpose_item(a->in[I_W1] + (size_t)j * DM * DFF, DM, DFF, (bf16*)(ws + WS_W1) + (size_t)j * DFF * DM, scr, r, 256, F.lane); continue; } r -= 2 * I_M1;
            { const int j = 2 + r / I_M2; r -= (j - 2) * I_M2; transpose_item(a->in[I_W2] + (size_t)j * DFF * DM, DFF, DM, (bf16*)(ws + WS_W2) + (size_t)j * DM * DFF, scr, r, 64, F.lane); }
        }
    }
}
__device__ __forceinline__ void p0_prologue(const Frame& F0, KArgs a) {
    const Frame F = relaunder(F0);
    unsigned char* ws = a->ws;
    convert_weights<false>(F, a, blockIdx.x * NWAVES + F.wave, F.G * NWAVES);
    cvt_rows(F, a->in[I_XP], (bf16*)(ws + WS_XN), (size_t)NP * DM / 8);
    cvt_rows(F, a->in[I_XS], (bf16*)(ws + WS_XN) + (size_t)NP * DM, (size_t)NS * DM / 8);
#ifdef TEST_IN8
    if (blockIdx.x == 0 && F.tid == 0) { const float* p = a->in[I_SCS]; ((float*)(ws + WS_SIDE))[0] = p[0] + p[TEST_IN8]; }
#endif
}

struct FnAqkv {
    bf16* qkv; float* out; bf16* catk; bf16* catv; int j;
    __device__ __forceinline__ void operator()(int row, int col, f32x4 v0, f32x4 v1, const pg8::Unit& u) const {
        store8_bf16(qkv + (size_t)row * A_N + col, v0, v1);
        if (u.pn >= 8) {
            const bool isV = u.pn >= 16; const int c = col - (isV ? 4096 : 2048);
            if (u.pm >= 32) {
                const int r = row - NP;
                store8_f32(out + (isV ? O_AVS : O_AKS) + ((size_t)j * 512 + r) * 2048 + c, v0, v1);
                store8_bf16((isV ? catv : catk) + ((size_t)(r >> 5) * A_CATROWS + 512 + (r & 31)) * 2048 + c, v0, v1);
            } else if ((u.pm & 15) >= 14) {
                const int b = u.pm >> 4, tp = (row & 4095) - 3584;
                store8_f32(out + (isV ? O_AVP : O_AKP) + (((size_t)j * 2 + b) * 512 + tp) * 2048 + c, v0, v1);
            }
        }
    }
};
struct FnMix {
    float* mix; float* part;
    __device__ __forceinline__ void operator()(int row, int col, f32x4 v0, f32x4 v1, const pg8::Unit& u) const {
        if (u.pm >= 32) store8_bf16((bf16*)part + ((size_t)u.ks * NS + (row - NP)) * DM + col, v0, v1);
        else store8_bf16((bf16*)mix + (size_t)row * DM + col, v0, v1);
    }
};
struct FnRelu2 {
    bf16* h;
    __device__ __forceinline__ void operator()(int row, int col, f32x4 v0, f32x4 v1, const pg8::Unit&) const {
#pragma unroll
        for (int i = 0; i < 4; ++i) { const float a = fmaxf(v0[i], 0.f), b = fmaxf(v1[i], 0.f); v0[i] = a * a; v1[i] = b * b; }
        store8_bf16(h + (size_t)row * DFF + col, v0, v1);
    }
};
struct FnBproj {
    bf16* big; float* out; float* wi; bf16* catk; bf16* catv; bf16* cati;
    __device__ __forceinline__ void operator()(int row, int col, f32x4 v0, f32x4 v1, const pg8::Unit& u) const {
        store8_bf16(big + (size_t)row * B_NP + col, v0, v1);
        const bool smp = u.pm >= 32; const int r = row - NP;
        if (u.pn >= 8 && u.pn < 12) {
            const bool isV = u.pn >= 10; const int c = col - (isV ? 2560 : 2048);
            if (smp) { store8_f32(out + (isV ? O_BVS : O_BKS) + (size_t)r * 512 + c, v0 * PROBE_SCALE, v1 * PROBE_SCALE);
                       store8_bf16((isV ? catv : catk) + ((size_t)(r >> 5) * B_CATROWS + 1024 + (r & 31)) * 512 + c, v0, v1); }
            else store8_f32(out + (isV ? O_BVP : O_BKP) + (size_t)row * 512 + c, v0 * PROBE_SCALE, v1 * PROBE_SCALE);
        } else if (u.pn == 16) {
            const int c = col - 4096;
            if (c < 64) {
                if (smp) { store8_f32(out + O_BIS + (size_t)r * 64 + c, v0 * PROBE_SCALE, v1 * PROBE_SCALE);
                           store8_bf16(cati + ((size_t)(r >> 5) * B_CATROWS + 1024 + (r & 31)) * 64 + c, v0, v1); }
                else store8_f32(out + O_BIP + (size_t)row * 64 + c, v0 * PROBE_SCALE, v1 * PROBE_SCALE);
            } else if (c < 80) store8_f32(wi + (size_t)row * 16 + (c - 64), v0, v1);
        }
    }
};

struct FnCproj {
    bf16* big; float* out; float* side;
    __device__ __forceinline__ void operator()(int row, int col, f32x4 v0, f32x4 v1, const pg8::Unit& u) const {
        if (col < 12288) {
            store8_bf16(big + (size_t)row * C_NP + col, v0, v1);
            if (col < 8192) {
                if (u.pm >= 32) { const int r = row - NP, s = r & 31; if (s >= 29) store8_f32(out + O_CCS + ((size_t)(r >> 5) * 3 + (s - 29)) * 8192 + col, v0, v1); }
                else { const int t = row & 4095; if (t >= 4093) store8_f32(out + O_CCP + ((size_t)(row >> 12) * 3 + (t - 4093)) * 8192 + col, v0, v1); }
            }
        } else if (col < 12352) store8_f32(side + (size_t)row * 64 + (col - 12288), v0, v1);
    }
};

__device__ __forceinline__ void ln_phase(const Frame& F0, const float* __restrict__ xin_p, const float* __restrict__ xin_s, const bool x_f32, const float* __restrict__ mix, const float* __restrict__ part,
                                         const float* __restrict__ g, const float* __restrict__ bb, float* __restrict__ yout  , bf16* __restrict__ xn) {
    const Frame F = relaunder(F0);
    const int gw = blockIdx.x * NWAVES + F.wave, NGW = F.G * NWAVES;
    for (int row = gw; row < NTOK; row += NGW) {
        const float* xr = row < NP ? xin_p + (size_t)row * DM : xin_s + (size_t)(row - NP) * DM;
        f32x4 v[8]; float s = 0.f;
#pragma unroll
        for (int i = 0; i < 8; ++i) { const int c = (i * 64 + F.lane) * 4; f32x4 x, m;
            if (x_f32) x = *(const f32x4*)(xr + c);
            else { const v2u xb = *(const v2u*)(xn + (size_t)row * DM + c); x = (f32x4){__uint_as_float(xb.x << 16), __uint_as_float(xb.x & 0xffff0000u), __uint_as_float(xb.y << 16), __uint_as_float(xb.y & 0xffff0000u)}; }
            if (row < NP) { const v2u mb = *(const v2u*)((const bf16*)mix + (size_t)row * DM + c); m = (f32x4){__uint_as_float(mb.x << 16), __uint_as_float(mb.x & 0xffff0000u), __uint_as_float(mb.y << 16), __uint_as_float(mb.y & 0xffff0000u)}; }
            else { const bf16* pr = (const bf16*)part + (size_t)(row - NP) * DM + c; m = (f32x4){0.f, 0.f, 0.f, 0.f};
#pragma unroll
                for (int sl = 0; sl < 16; ++sl) { const v2u pb = *(const v2u*)(pr + (size_t)sl * NS * DM); m += (f32x4){__uint_as_float(pb.x << 16), __uint_as_float(pb.x & 0xffff0000u), __uint_as_float(pb.y << 16), __uint_as_float(pb.y & 0xffff0000u)}; } }
            v[i] = x * ALPHA + m; s += (v[i][0] + v[i][1]) + (v[i][2] + v[i][3]); }
        const float mean = wave_sum(s) * (1.f / DM); float q = 0.f;
#pragma unroll
        for (int i = 0; i < 8; ++i) { v[i] = v[i] - mean; q += (v[i][0] * v[i][0] + v[i][1] * v[i][1]) + (v[i][2] * v[i][2] + v[i][3] * v[i][3]); }
        const float rstd = 1.f / sqrtf(wave_sum(q) * (1.f / DM) + LN_EPS);
#pragma unroll
        for (int i = 0; i < 8; ++i) { const int c = (i * 64 + F.lane) * 4; const f32x4 gg = *(const f32x4*)(g + c), be = *(const f32x4*)(bb + c);
            const f32x4 y = v[i] * rstd * gg + be; if (yout) *(f32x4*)(yout + (size_t)row * DM + c) = y;
            v2u w; w.x = pk2(y[0], y[1]); w.y = pk2(y[2], y[3]); *(v2u*)(xn + (size_t)row * DM + c) = w; }
    }
}

__device__ __forceinline__ void attn_a_phase(const Frame& F0, unsigned char* ws, const float* __restrict__ rel_bias  ) {
    char* lds = (char*)F0.lds;
    float* bias_l = (float*)(lds + att::SHM_BIAS);
    const bf16* qkv = (const bf16*)(ws + WS_BIG); bf16* ao = (bf16*)(ws + WS_ATT);
    for (int u = blockIdx.x; u < 512; u += F0.G) {
        const Frame F = relaunder(F0);
        const int c4 = u & 15, h = (u >> 4) & 15, b = u >> 8, c0 = 4 * c4, kc0 = c0 >= 8 ? c0 - 8 : 0, NT = c0 + 4 - kc0;
        if (F.tid < 257) bias_l[F.tid] = rel_bias[h * 257 + F.tid] * (1.0f / att::SCALE);
        const size_t qrow = (size_t)b * SEQ + c0 * 64 + F.wave * 32;
        att::MaskAPrompt Mk{bias_l, c0 + (F.wave >> 1), kc0, (F.wave & 1) * 32};
        att::attn_body(qkv + qrow * A_N + h * 128, A_N, qkv + ((size_t)b * SEQ + kc0 * 64) * A_N + 2048 + h * 128, qkv + ((size_t)b * SEQ + kc0 * 64) * A_N + 4096 + h * 128, A_N,
                       ao + qrow * DM + h * 128, DM, true, NT, lds, Mk, F.tid);
    }
    for (int u = blockIdx.x; u < 256; u += F0.G) {
        const Frame F = relaunder(F0);
        const int h = u & 15, b = u >> 4;
        if (F.tid < 257) bias_l[F.tid] = rel_bias[h * 257 + F.tid] * (1.0f / att::SCALE);
        const size_t qrow = (size_t)NP + b * 32;
        att::MaskASample Mk{bias_l};
        att::attn_body(qkv + qrow * A_N + h * 128, A_N, (const bf16*)(ws + SA_CATK) + (size_t)b * A_CATROWS * 2048 + h * 128, (const bf16*)(ws + SA_CATV) + (size_t)b * A_CATROWS * 2048 + h * 128, 2048,
                       ao + qrow * DM + h * 128, DM, F.wave == 0, 10, lds, Mk, F.tid);
    }
}


typedef float f32x4m __attribute__((ext_vector_type(4)));
__device__ __forceinline__ unsigned fkey(float f) { const unsigned u = __float_as_uint(f); return (u & 0x80000000u) ? ~u : (u | 0x80000000u); }

__device__ __forceinline__ void idx_score_row(const bf16* __restrict__ qi  , const float* __restrict__ wi  , const bf16* __restrict__ kbase, int ldki, int ngrp,
                                              float* __restrict__ srow, int lane) {
    const int c = lane & 15, g = lane >> 4;
    const bf16x8 a0 = *(const bf16x8*)(qi + c * 64 + 8 * g), a1 = *(const bf16x8*)(qi + c * 64 + 32 + 8 * g);
    float w[4];
#pragma unroll
    for (int i = 0; i < 4; ++i) w[i] = wi[4 * g + i] * (0.25f * 0.125f);
    for (int gi = 0; gi < ngrp; ++gi) {
        float p[4];
#pragma unroll
        for (int t = 0; t < 4; ++t) {
            const bf16* kr = kbase + (size_t)(gi * 64 + t * 16 + c) * ldki + 8 * g;
            const bf16x8 b0 = *(const bf16x8*)kr, b1 = *(const bf16x8*)(kr + 32);
            f32x4m d = {0.f, 0.f, 0.f, 0.f};
            d = __builtin_amdgcn_mfma_f32_16x16x32_bf16(a0, b0, d, 0, 0, 0);
            d = __builtin_amdgcn_mfma_f32_16x16x32_bf16(a1, b1, d, 0, 0, 0);
            float s = w[0] * fmaxf(d[0], 0.f); s = fmaf(w[1], fmaxf(d[1], 0.f), s); s = fmaf(w[2], fmaxf(d[2], 0.f), s); s = fmaf(w[3], fmaxf(d[3], 0.f), s);
            s += __shfl_xor(s, 16); s += __shfl_xor(s, 32);
            p[t] = s;
        }
        const float mine = g == 0 ? p[0] : g == 1 ? p[1] : g == 2 ? p[2] : p[3];
        srow[gi * 64 + lane] = mine;
    }
}

__device__ __forceinline__ int wave_sum_i(int v) {
    { auto r = __builtin_amdgcn_permlane32_swap((unsigned)v, (unsigned)v, false, false); v = (int)r[0] + (int)r[1]; }
    { auto r = __builtin_amdgcn_permlane16_swap((unsigned)v, (unsigned)v, false, false); v = (int)r[0] + (int)r[1]; }
    v += __builtin_amdgcn_update_dpp(0, v, 0x128, 0xf, 0xf, false);
    v += __builtin_amdgcn_update_dpp(0, v, 0x124, 0xf, 0xf, false);
    v += __builtin_amdgcn_update_dpp(0, v, 0x122, 0xf, 0xf, false);
    v += __builtin_amdgcn_update_dpp(0, v, 0x121, 0xf, 0xf, false);
    return __builtin_amdgcn_readfirstlane(v);
}
__device__ __forceinline__ void idx_select_row(const float* __restrict__ srow, int L, unsigned* __restrict__ mrow, int nwords, int lane) {
    const int nj = (L + 63) >> 6;
    if (L <= 256) {
        for (int wd = lane; wd < nwords; wd += 64) { const int lo = wd * 32; mrow[wd] = (lo + 32 <= L) ? 0xffffffffu : (lo >= L ? 0u : ((1u << (L - lo)) - 1u)); }
        return;
    }
    unsigned key[64];
#pragma unroll
    for (int jb = 0; jb < 64; jb += 16) {
        if (jb < nj) {
            float sv[16];
#pragma unroll
            for (int j = 0; j < 16; ++j) { const int idx = (jb + j) * 64 + lane; sv[j] = __hip_atomic_load(srow + (idx < L ? idx : 0), __ATOMIC_RELAXED, __HIP_MEMORY_SCOPE_AGENT); }
#pragma unroll
            for (int j = 0; j < 16; ++j) { const int idx = (jb + j) * 64 + lane; key[jb + j] = idx < L ? fkey(sv[j]) : 0u; }
        } else {
#pragma unroll
            for (int j = 0; j < 16; ++j) key[jb + j] = 0u;
        }
    }
    unsigned T = 0u;
    for (int bit = 31; bit >= 0; --bit) {
        const unsigned cand = T | (1u << bit); int cn = 0;
#pragma unroll
        for (int jb = 0; jb < 64; jb += 16) if (jb < nj) {
#pragma unroll
            for (int j = 0; j < 16; ++j) cn += __popcll(__ballot(key[jb + j] >= cand)); }
        if (cn >= 256) T = cand;
        if (cn == 256) break;
    }
    int gv = 0;
#pragma unroll
    for (int j = 0; j < 64; ++j) gv += (key[j] > T) ? 1 : 0;
    int need = 256 - wave_sum_i(gv);
#pragma unroll
    for (int j = 0; j < 64; ++j) {
        unsigned long long sel = 0ull;
        if (j < nj) {
            sel = __ballot(key[j] > T);
            const unsigned long long tb = __ballot(key[j] == T && (j * 64 + lane) < L);
            if (need > 0 && tb != 0ull) { const int cc = __popcll(tb);
                if (cc <= need) { sel |= tb; need -= cc; }
                else { const unsigned long long below = tb & ((1ull << lane) - 1ull); sel |= __ballot(key[j] == T && (j * 64 + lane) < L && __popcll(below) < need); need = 0; } }
        }
        if (2 * j < nwords && lane == 0) { mrow[2 * j] = (unsigned)sel; mrow[2 * j + 1] = (unsigned)(sel >> 32); }
        __builtin_amdgcn_sched_barrier(0);
    }
}

constexpr int IDX_KROW = 144, IDX_KBUF = 64 * IDX_KROW;
__device__ __forceinline__ float xsum16_32(float s) {
    { auto r = __builtin_amdgcn_permlane16_swap(__float_as_uint(s), __float_as_uint(s), false, false); s = __uint_as_float(r[0]) + __uint_as_float(r[1]); }
    { auto r = __builtin_amdgcn_permlane32_swap(__float_as_uint(s), __float_as_uint(s), false, false); s = __uint_as_float(r[0]) + __uint_as_float(r[1]); }
    return s;
}
__device__ __forceinline__ void idx_phase(const Frame& F0, unsigned char* ws) {
    const bf16* big = (const bf16*)(ws + WS_BIG); const float* wi = (const float*)(ws + WS_SIDE);
    float* score = (float*)(ws + SB_SCORE); unsigned* mask = (unsigned*)(ws + SB_MASK);
    char* lds = (char*)F0.lds;
    for (int i = 0, u = blockIdx.x; u < 544; ++i, u += F0.G) {
        const Frame F = relaunder(F0);
        const int tid = F.tid, lane = F.lane;
        int uu = u; if (u < 512 && (i & 1)) uu = (u & ~255) + 255 - (u & 255);
        int rowb, L, ngrp, nwords, ldki; const bf16* kbase;
        if (uu < 512) { rowb = uu * 16; const int b = rowb >> 12, c = (rowb & 4095) >> 6; L = 64 * (c + 1); ngrp = c + 1; nwords = 128; kbase = big + (size_t)b * SEQ * B_NP + 4096; ldki = B_NP; }
        else { rowb = NP + (uu - 512) * 16; const int b = (rowb - NP) >> 5; L = 1056; ngrp = 17; nwords = 36; kbase = (const bf16*)(ws + SB_CATI) + (size_t)b * B_CATROWS * 64; ldki = 64; }
        const int row0 = rowb + 2 * F.wave;
        if (L > 256) {
            const int c = lane & 15, g = lane >> 4;
            bf16x8 a00, a01, a10, a11; float w0[4], w1[4];
            { const bf16* q0 = big + (size_t)row0 * B_NP + 3072 + c * 64 + 8 * g; const bf16* q1 = q0 + B_NP;
              a00 = *(const bf16x8*)q0; a01 = *(const bf16x8*)(q0 + 32); a10 = *(const bf16x8*)q1; a11 = *(const bf16x8*)(q1 + 32);
#pragma unroll
              for (int k = 0; k < 4; ++k) { w0[k] = wi[(size_t)row0 * 16 + 4 * g + k] * (0.25f * 0.125f); w1[k] = wi[(size_t)(row0 + 1) * 16 + 4 * g + k] * (0.25f * 0.125f); } }
            float* s0 = score + (size_t)row0 * 4096; float* s1 = s0 + 4096;
            const int skey = tid >> 3, sseg = tid & 7;
            const bf16* gsrc = kbase + (size_t)skey * ldki + sseg * 8;
            v4u stg = *(const v4u*)gsrc;
            *(v4u*)(lds + skey * IDX_KROW + sseg * 16) = stg;
            __syncthreads();
            for (int gi = 0; gi < ngrp; ++gi) {
                if (gi + 1 < ngrp) stg = *(const v4u*)(gsrc + (size_t)(gi + 1) * 64 * ldki);
                const char* kb = lds + (gi & 1) * IDX_KBUF + c * IDX_KROW + 16 * g;
                float p0[4], p1[4];
#pragma unroll
                for (int t = 0; t < 4; ++t) {
                    const bf16x8 b0 = *(const bf16x8*)(kb + t * 16 * IDX_KROW), b1 = *(const bf16x8*)(kb + t * 16 * IDX_KROW + 64);
                    f32x4m d0 = {0.f, 0.f, 0.f, 0.f}, d1 = {0.f, 0.f, 0.f, 0.f};
                    d0 = __builtin_amdgcn_mfma_f32_16x16x32_bf16(a00, b0, d0, 0, 0, 0); d0 = __builtin_amdgcn_mfma_f32_16x16x32_bf16(a01, b1, d0, 0, 0, 0);
                    d1 = __builtin_amdgcn_mfma_f32_16x16x32_bf16(a10, b0, d1, 0, 0, 0); d1 = __builtin_amdgcn_mfma_f32_16x16x32_bf16(a11, b1, d1, 0, 0, 0);
                    float x0 = w0[0] * fmaxf(d0[0], 0.f); x0 = fmaf(w0[1], fmaxf(d0[1], 0.f), x0); x0 = fmaf(w0[2], fmaxf(d0[2], 0.f), x0); x0 = fmaf(w0[3], fmaxf(d0[3], 0.f), x0);
                    float x1 = w1[0] * fmaxf(d1[0], 0.f); x1 = fmaf(w1[1], fmaxf(d1[1], 0.f), x1); x1 = fmaf(w1[2], fmaxf(d1[2], 0.f), x1); x1 = fmaf(w1[3], fmaxf(d1[3], 0.f), x1);
                    p0[t] = xsum16_32(x0); p1[t] = xsum16_32(x1);
                }
                s0[gi * 64 + lane] = g == 0 ? p0[0] : g == 1 ? p0[1] : g == 2 ? p0[2] : p0[3];
                s1[gi * 64 + lane] = g == 0 ? p1[0] : g == 1 ? p1[1] : g == 2 ? p1[2] : p1[3];
                if (gi + 1 < ngrp) *(v4u*)(lds + ((gi + 1) & 1) * IDX_KBUF + skey * IDX_KROW + sseg * 16) = stg;
                __syncthreads();
            }
            VM_WAIT();
        }
        for (int rr = 0; rr < 2; ++rr) idx_select_row(score + (size_t)(row0 + rr) * 4096, L, mask + (size_t)(row0 + rr) * 128, nwords, lane);
    }
}

__device__ __forceinline__ void attn_b_phase(const Frame& F0, unsigned char* ws) {
    char* lds = (char*)F0.lds;
    const bf16* big = (const bf16*)(ws + WS_BIG); bf16* ao = (bf16*)(ws + WS_ATT); const unsigned* mask = (const unsigned*)(ws + SB_MASK);
    for (int u = blockIdx.x; u < 512; u += F0.G) {
        const Frame F = relaunder(F0);
        const int bg = (u & 255) >> 5, c = (u < 256) ? (u & 31) : 63 - (u & 31), b = bg >> 2, g = bg & 3;
        const int NT = (c + 2) & ~1, head = 4 * g + (F.wave >> 1);
        const size_t qrow = (size_t)b * SEQ + c * 64 + (F.wave & 1) * 32;
        att::MaskBits Mk{mask + (qrow + (F.lane & 31)) * 128};
        att::attn_body(big + qrow * B_NP + head * 128, B_NP, big + (size_t)b * SEQ * B_NP + 2048 + g * 128, big + (size_t)b * SEQ * B_NP + 2560 + g * 128, B_NP,
                       ao + qrow * DM + head * 128, DM, true, NT, lds, Mk, F.tid);
    }
    for (int u = blockIdx.x; u < 64; u += F0.G) {
        const Frame F = relaunder(F0);
        const int b = u >> 2, g = u & 3, head = 4 * g + (F.wave & 3);
        const size_t qrow = (size_t)NP + b * 32;
        att::MaskBits Mk{mask + (qrow + (F.lane & 31)) * 128};
        att::attn_body(big + qrow * B_NP + head * 128, B_NP, (const bf16*)(ws + SB_CATK) + (size_t)b * B_CATROWS * 512 + g * 128, (const bf16*)(ws + SB_CATV) + (size_t)b * B_CATROWS * 512 + g * 128, 512,
                       ao + qrow * DM + head * 128, DM, F.wave < 4, 18, lds, Mk, F.tid);
    }
}

constexpr int C_UNITS = 4096 + 512;
constexpr size_t CU_W = 0, CU_U0T = 16384, CU_QG = 32768, CU_KT = 49152, CU_AQK = 65536, CU_BYTES = 73728;
constexpr size_t SC_UNITS = WS_SCR, SC_DECAY = SC_UNITS + (size_t)C_UNITS * CU_BYTES, SC_END = SC_DECAY + C_UNITS * 4;
static_assert(SC_END <= WS_S0COPY, "C scratch");
typedef float f32x16c __attribute__((ext_vector_type(16)));
__device__ __forceinline__ int crow16(int r, int h) { return (r & 3) + 8 * (r >> 2) + 4 * h; }
__device__ __forceinline__ float sigmoidf_(float x) { return __builtin_amdgcn_rcpf(1.f + __expf(-x)); }
__device__ __forceinline__ float siluf_(float x) { return x * __builtin_amdgcn_rcpf(1.f + __expf(-x)); }

constexpr int PL_QN = 0;
constexpr int PL_KN = PL_QN + 64 * 272;
constexpr int PL_KB = PL_KN + 64 * 272;
constexpr int PL_M = PL_KB + 64 * 272;
constexpr int PL_RHS = PL_M + 64 * 256;
constexpr int PL_VEC = PL_RHS + 64 * 1040;
constexpr int PL_END = PL_VEC + 5 * 256;
static_assert(PL_END <= 147456, "prep LDS");

constexpr int C_DEF_SPLIT = 7168;
constexpr int C_TLATE = 52, C_NEARLY = 2 * C_TLATE * 32 + 512, C_NLATE = 2 * (64 - C_TLATE) * 32;
template <int MODE> __device__ __forceinline__ void c_prep_phase(const Frame& F0, KArgs a, const int first, const int stride, const int count) {
    unsigned char* ws = a->ws;
    const bf16* big = (const bf16*)(ws + WS_BIG); const float* side = (const float*)(ws + WS_SIDE);
    const float* convw = a->in[I_CCONVW]; const float* cbuf = a->in[I_SCC];
    char* lds = (char*)F0.lds;
    for (int it = first; it < count; it += stride) {
        const Frame F = relaunder(F0);
        const int tid = F.tid, lane = F.lane, wave = F.wave;
        int uid = it;
        if constexpr (MODE == 0) { const int pe = 2 * C_TLATE * 32, per = C_TLATE * 32; const int sq = it >= per ? 1 : 0, rem = it - sq * per; uid = it < pe ? (sq * 64 + (rem >> 5)) * 32 + (it & 31) : 4096 + (it - pe); }
        if constexpr (MODE == 1) { const int per = (64 - C_TLATE) * 32; const int sq = it >= per ? 1 : 0, rem = it - sq * per; uid = (sq * 64 + C_TLATE + (rem >> 5)) * 32 + (it & 31); }
        const bool smp = uid >= 4096;
        const int hv = uid & 31, hq = hv >> 1;
        const int seq = smp ? (uid - 4096) >> 5 : uid >> 11, chunk = smp ? 0 : (uid >> 5) & 63;
        const int row0 = smp ? NP + seq * 32 : seq * SEQ + chunk * 64, nvalid = smp ? 32 : 64;
        bf16* qn = (bf16*)(lds + PL_QN); bf16* kn = (bf16*)(lds + PL_KN); bf16* kb = (bf16*)(lds + PL_KB);
        float* mL = (float*)(lds + PL_M); float* rhs = (float*)(lds + PL_RHS);
        float* Gv = (float*)(lds + PL_VEC); float* betav = Gv + 64; float* eGv = Gv + 128; float* rqv = Gv + 192; float* rkv = Gv + 256;
        unsigned char* ub = ws + SC_UNITS + (size_t)uid * CU_BYTES;
        if (wave == 7) {
            float beta = 0.f, g = 0.f;
            if (lane < nvalid) { const float* sr = side + (size_t)(row0 + lane) * 64;
                beta = sigmoidf_(sr[hv]); const float x = sr[32 + hv] + a->in[I_CDT][hv]; const float sp = x > 20.f ? x : __logf(1.f + __expf(x)); g = -__expf(a->in[I_CALOG][hv]) * sp; }
            float G = g;
#pragma unroll
            for (int o = 1; o < 64; o <<= 1) { const float t = __shfl_up(G, o); if (lane >= o) G += t; }
            Gv[lane] = G; betav[lane] = beta; eGv[lane] = __expf(G);
        }
        if (tid < 384) {
            const int grp = tid % 48, tb = tid / 48, part = grp >> 4, c8 = (grp & 15) * 8;
            const int ch = part == 0 ? hq * 128 + c8 : part == 1 ? 2048 + hq * 128 + c8 : 4096 + hv * 128 + c8;
            float* dst = part == 2 ? (float*)(lds + PL_QN) + c8 : rhs + (part == 1 ? 128 : 0) + c8; const int dstride = part == 2 ? 132 : 260;
            if (8 * tb < nvalid) {
                float w[4][8], xr[11][8];
#pragma unroll
                for (int j = 0; j < 4; ++j) { const f32x4 a0 = *(const f32x4*)(convw + (size_t)j * 8192 + ch), a1 = *(const f32x4*)(convw + (size_t)j * 8192 + ch + 4);
                    w[j][0] = a0[0]; w[j][1] = a0[1]; w[j][2] = a0[2]; w[j][3] = a0[3]; w[j][4] = a1[0]; w[j][5] = a1[1]; w[j][6] = a1[2]; w[j][7] = a1[3]; }
                bf16x8 xv[11];
#pragma unroll
                for (int i = 0; i < 11; ++i) { const int tt = 8 * tb - 3 + i; const bool ok = tt >= 0 || (!smp && chunk > 0);
                    xv[i] = *(const bf16x8*)(big + (size_t)(row0 + (ok ? tt : 0)) * C_NP + ch); }
#pragma unroll
                for (int i = 0; i < 11; ++i) { const int tt = 8 * tb - 3 + i; const bool ok = tt >= 0 || (!smp && chunk > 0);
#pragma unroll
                    for (int e = 0; e < 8; ++e) xr[i][e] = ok ? bf2f((bf16)xv[i][e]) : 0.f; }
                if (smp) {
#pragma unroll
                    for (int i = 0; i < 3; ++i) { const int tt = 8 * tb - 3 + i; const int r = tt < 0 ? 3 + tt : 0;
                        const float* cb = cbuf + ((size_t)seq * 3 + r) * 8192 + ch; const f32x4 a0 = *(const f32x4*)cb, a1 = *(const f32x4*)(cb + 4);
                        if (tt < 0) { xr[i][0] = a0[0]; xr[i][1] = a0[1]; xr[i][2] = a0[2]; xr[i][3] = a0[3]; xr[i][4] = a1[0]; xr[i][5] = a1[1]; xr[i][6] = a1[2]; xr[i][7] = a1[3]; } }
                }
#pragma unroll
                for (int t8 = 0; t8 < 8; ++t8) { f32x4 y0, y1;
#pragma unroll
                    for (int e = 0; e < 8; ++e) { float y = xr[t8][e] * w[0][e]; y = fmaf(xr[t8 + 1][e], w[1][e], y); y = fmaf(xr[t8 + 2][e], w[2][e], y); y = fmaf(xr[t8 + 3][e], w[3][e], y); y = siluf_(y);
                        if (e < 4) y0[e] = y; else y1[e - 4] = y; }
                    float* d = dst + (8 * tb + t8) * dstride; *(f32x4*)d = y0; *(f32x4*)(d + 4) = y1; }
            } else {
#pragma unroll
                for (int t8 = 0; t8 < 8; ++t8) { float* d = dst + (8 * tb + t8) * dstride; *(f32x4*)d = (f32x4){0.f, 0.f, 0.f, 0.f}; *(f32x4*)(d + 4) = (f32x4){0.f, 0.f, 0.f, 0.f}; }
            }
        }
        __syncthreads();
        { const int t = tid >> 3, sub = tid & 7; float sq = 0.f, sk = 0.f;
#pragma unroll
          for (int e = 0; e < 16; ++e) { const float q = rhs[t * 260 + sub * 16 + e], k = rhs[t * 260 + 128 + sub * 16 + e]; sq = fmaf(q, q, sq); sk = fmaf(k, k, sk); }
          sq += __shfl_xor(sq, 1); sq += __shfl_xor(sq, 2); sq += __shfl_xor(sq, 4); sk += __shfl_xor(sk, 1); sk += __shfl_xor(sk, 2); sk += __shfl_xor(sk, 4);
          if (sub == 0) { rqv[t] = rsqrtf(sq + RMS_EPS) * 0.08838834764831845f; rkv[t] = rsqrtf(sk + RMS_EPS); } }
        __syncthreads();
        { const int t = tid >> 3, sub = tid & 7; float q[16], k[16], vb[16];
          const float* vpark = (const float*)(lds + PL_QN) + t * 132 + sub * 16;
#pragma unroll
          for (int e = 0; e < 16; ++e) { q[e] = rhs[t * 260 + sub * 16 + e] * rqv[t]; k[e] = rhs[t * 260 + 128 + sub * 16 + e] * rkv[t]; vb[e] = vpark[e] * betav[t]; }
          __syncthreads();
          const float be = betav[t], eg = eGv[t];
#pragma unroll
          for (int e = 0; e < 16; e += 2) {
              *(unsigned*)(qn + t * 136 + sub * 16 + e) = pk2(q[e], q[e + 1]); *(unsigned*)(kn + t * 136 + sub * 16 + e) = pk2(k[e], k[e + 1]);
              *(unsigned*)(kb + t * 136 + sub * 16 + e) = pk2(k[e] * be, k[e + 1] * be); }
#pragma unroll
          for (int e = 0; e < 16; ++e) { rhs[t * 260 + sub * 16 + e] = vb[e]; rhs[t * 260 + 128 + sub * 16 + e] = k[e] * be * eg; }
        }
        __syncthreads();
        { const int r32 = lane & 31, h = lane >> 5, tile = wave & 3, mt = tile >> 1, nt = tile & 1;
          const bf16* Ab = (wave < 4 ? kb : qn) + (mt * 32 + r32) * 136 + 8 * h; const bf16* Bb = kn + (nt * 32 + r32) * 136 + 8 * h;
          f32x16c d = {};
#pragma unroll
          for (int s = 0; s < 8; ++s) d = __builtin_amdgcn_mfma_f32_32x32x16_bf16(*(const bf16x8*)(Ab + 16 * s), *(const bf16x8*)(Bb + 16 * s), d, 0, 0, 0);
          const int j = nt * 32 + r32; const float Gj = Gv[j];
          bf16* aqk = (bf16*)(ub + CU_AQK);
#pragma unroll
          for (int r = 0; r < 16; ++r) { const int i = mt * 32 + crow16(r, h); const float dec = __expf(fminf(Gv[i] - Gj, 0.f));
              if (wave < 4) mL[i * 64 + j] = (j < i) ? d[r] * dec : 0.f;
              else aqk[i * 64 + j] = (bf16)(pk2((j <= i) ? d[r] * dec : 0.f, 0.f) & 0xffffu); }
        }
        __syncthreads();
        if (wave < 4) {
            const int c = tid; float x[64];
            const LAS float* mLv = (const LAS float*)mL; asm volatile("" : "+v"(mLv));
#ifdef EXP_SOLVE2
            for (int rep_ = 0; rep_ < 2; ++rep_) { asm volatile("" ::: "memory");
#endif
#pragma unroll
            for (int ib = 0; ib < 16; ++ib) {
                float a0 = rhs[(4 * ib + 0) * 260 + c], a1 = rhs[(4 * ib + 1) * 260 + c], a2 = rhs[(4 * ib + 2) * 260 + c], a3 = rhs[(4 * ib + 3) * 260 + c];
#pragma unroll
                for (int jb = 0; jb < ib; ++jb) {
                    const f32x4 m0 = *(const LAS f32x4*)(mLv + (4 * ib + 0) * 64 + 4 * jb), m1 = *(const LAS f32x4*)(mLv + (4 * ib + 1) * 64 + 4 * jb),
                                m2 = *(const LAS f32x4*)(mLv + (4 * ib + 2) * 64 + 4 * jb), m3 = *(const LAS f32x4*)(mLv + (4 * ib + 3) * 64 + 4 * jb);
#pragma unroll
                    for (int e = 0; e < 4; ++e) { const float xv = x[4 * jb + e]; a0 = fmaf(-m0[e], xv, a0); a1 = fmaf(-m1[e], xv, a1); a2 = fmaf(-m2[e], xv, a2); a3 = fmaf(-m3[e], xv, a3); }
                }
                const f32x4 d1 = *(const LAS f32x4*)(mLv + (4 * ib + 1) * 64 + 4 * ib), d2 = *(const LAS f32x4*)(mLv + (4 * ib + 2) * 64 + 4 * ib), d3 = *(const LAS f32x4*)(mLv + (4 * ib + 3) * 64 + 4 * ib);
                x[4 * ib] = a0;
                a1 = fmaf(-d1[0], a0, a1); x[4 * ib + 1] = a1;
                a2 = fmaf(-d2[0], a0, a2); a2 = fmaf(-d2[1], a1, a2); x[4 * ib + 2] = a2;
                a3 = fmaf(-d3[0], a0, a3); a3 = fmaf(-d3[1], a1, a3); a3 = fmaf(-d3[2], a2, a3); x[4 * ib + 3] = a3;
            }
#ifdef EXP_SOLVE2
            }
#endif
#pragma unroll
            for (int i = 0; i < 64; ++i) rhs[i * 260 + c] = x[i];
        } else {
            const int t2 = tid - 256;
            bf16* qg = (bf16*)(ub + CU_QG); bf16* kt = (bf16*)(ub + CU_KT);
            const float Glast = Gv[63];
            for (int it = t2; it < 64 * 16; it += 256) { const int t = it >> 4, c8 = (it & 15) * 8; const float eg = eGv[t];
                const bf16x8 v = *(const bf16x8*)(qn + t * 136 + c8); v4u o;
                o.x = pk2(bf2f((bf16)v[0]) * eg, bf2f((bf16)v[1]) * eg); o.y = pk2(bf2f((bf16)v[2]) * eg, bf2f((bf16)v[3]) * eg); o.z = pk2(bf2f((bf16)v[4]) * eg, bf2f((bf16)v[5]) * eg); o.w = pk2(bf2f((bf16)v[6]) * eg, bf2f((bf16)v[7]) * eg);
                *(v4u*)(qg + t * 128 + c8) = o; }
            for (int it = t2; it < 128 * 8; it += 256) { const int dk = it & 127, t8 = (it >> 7) * 8; float f[8];
#pragma unroll
                for (int e = 0; e < 8; ++e) f[e] = bf2f(kn[(t8 + e) * 136 + dk]) * __expf(Glast - Gv[t8 + e]);
                v4u o; o.x = pk2(f[0], f[1]); o.y = pk2(f[2], f[3]); o.z = pk2(f[4], f[5]); o.w = pk2(f[6], f[7]);
                *(v4u*)(kt + dk * 64 + t8) = o; }
            if (t2 == 0) ((float*)(ws + SC_DECAY))[uid] = __expf(Glast);
        }
        __syncthreads();
        { bf16* Wg = (bf16*)(ub + CU_W); bf16* U0t = (bf16*)(ub + CU_U0T);
          for (int it = tid; it < 64 * 16; it += NTHR) { const int t = it >> 4, c8 = (it & 15) * 8; const float* s = rhs + t * 260 + 128 + c8;
              v4u o; o.x = pk2(s[0], s[1]); o.y = pk2(s[2], s[3]); o.z = pk2(s[4], s[5]); o.w = pk2(s[6], s[7]); *(v4u*)(Wg + t * 128 + c8) = o; }
          for (int it = tid; it < 128 * 8; it += NTHR) { const int dv = it & 127, t8 = (it >> 7) * 8; const float* s = rhs + t8 * 260 + dv;
              v4u o; o.x = pk2(s[0], s[260]); o.y = pk2(s[520], s[780]); o.z = pk2(s[1040], s[1300]); o.w = pk2(s[1560], s[1820]); *(v4u*)(U0t + dv * 64 + t8) = o; } }
        __syncthreads();
    }
}

constexpr int SL_W = 0, SL_QG = SL_W + 64 * 272, SL_KT = SL_QG + 64 * 272, SL_AQK = SL_KT + 128 * 144, SL_ST = SL_AQK + 64 * 144, SL_UT = SL_ST + 128 * 272, SL_END = SL_UT + 128 * 144;
constexpr int SL_O = 0;
static_assert(64 * 132 * 4 <= SL_KT && SL_END <= 147456, "scan LDS");

struct ScanPf { v4u w0, w1, q0, q1, k0, k1, aq; v2u u0, u1, u2, u3; v4u z0, z1; float decay; };
__device__ __forceinline__ void c_scan_phase(const Frame& F0, KArgs a) {
    unsigned char* ws = a->ws; char* lds = (char*)F0.lds;
    const bf16* big = (const bf16*)(ws + WS_BIG); bf16* og = (bf16*)(ws + WS_ATT); const float* normw = a->in[I_CNORM];
    const int G = F0.G; const bool few = G <= 64;
    gu32* lpw = (gu32*)((unsigned*)(ws + WS_CTL) + CW_QB);
    if (!few && blockIdx.x >= 64) {
        c_prep_phase<1>(F0, a, (int)blockIdx.x - 64, G - 64, C_NLATE);
        asm volatile("s_waitcnt vmcnt(0)" ::: "memory");
        __syncthreads();
        if (relaunder(F0).tid == 0) { __builtin_amdgcn_fence(__ATOMIC_RELEASE, "agent"); asm volatile("s_waitcnt vmcnt(0)" ::: "memory"); (void)__hip_atomic_fetch_add(lpw, 1u, __ATOMIC_RELAXED, __HIP_MEMORY_SCOPE_AGENT); }
    }
    for (int pass = 0; pass < 2; ++pass) {
        int first, stride, count;
        if (pass == 0) { first = blockIdx.x; stride = G; count = 64; if (!few && blockIdx.x >= 64) count = 0; }
        else { if (few) { first = blockIdx.x; stride = G; } else { first = (int)blockIdx.x - 64; stride = G - 64; } count = 512; if (first < 0) { first = 0; count = 0; } }
        for (int ch = first; ch < count; ch += stride) {
            const Frame F = relaunder(F0);
            const int tid = F.tid, lane = F.lane, wave = F.wave, r32 = lane & 31, h = lane >> 5;
            const bool smp = pass == 1;
            const int seq = ch >> 5, hv = ch & 31, nsteps = smp ? 1 : 64, nvalid = smp ? 32 : 64;
            const int mt = wave & 1, nt = wave >> 1;
            const int dvc = nt * 32 + r32;
            const int tn = tid >> 3, sub = tid & 7;
            f32x16c S0 = {}, S1 = {};
            if (smp) { const float* s0 = a->in[I_SCS] + ((size_t)(seq * 32 + hv) * 128) * 128;
#pragma unroll
                for (int r = 0; r < 16; ++r) { S0[r] = s0[(size_t)((2 * mt) * 32 + crow16(r, h)) * 128 + dvc]; S1[r] = s0[(size_t)((2 * mt + 1) * 32 + crow16(r, h)) * 128 + dvc]; } }
            bf16* Wl = (bf16*)(lds + SL_W); bf16* Ql = (bf16*)(lds + SL_QG); bf16* Kl = (bf16*)(lds + SL_KT); bf16* Al = (bf16*)(lds + SL_AQK);
            bf16* St = (bf16*)(lds + SL_ST); bf16* ut = (bf16*)(lds + SL_UT); float* ol = (float*)(lds + SL_O);
#define SCAN_FETCH(P, st) do { const int uid_ = smp ? 4096 + ch : (seq * 64 + (st)) * 32 + hv; const int row0_ = smp ? NP + seq * 32 : seq * SEQ + (st) * 64;                 \
                const unsigned char* ub_ = ws + SC_UNITS + (size_t)uid_ * CU_BYTES;                                                                                                  \
                { const int t_ = tid >> 4, c8_ = (tid & 15) * 8; P.w0 = *(const v4u*)((const bf16*)(ub_ + CU_W) + t_ * 128 + c8_); P.w1 = *(const v4u*)((const bf16*)(ub_ + CU_W) + (t_ + 32) * 128 + c8_);        \
                  P.q0 = *(const v4u*)((const bf16*)(ub_ + CU_QG) + t_ * 128 + c8_); P.q1 = *(const v4u*)((const bf16*)(ub_ + CU_QG) + (t_ + 32) * 128 + c8_); }                                                 \
                { const int dk_ = tid >> 3, c8_ = (tid & 7) * 8; P.k0 = *(const v4u*)((const bf16*)(ub_ + CU_KT) + dk_ * 64 + c8_); P.k1 = *(const v4u*)((const bf16*)(ub_ + CU_KT) + (dk_ + 64) * 64 + c8_);       \
                  P.aq = *(const v4u*)((const bf16*)(ub_ + CU_AQK) + dk_ * 64 + c8_); }                                                                                              \
                { const bf16* U0t_ = (const bf16*)(ub_ + CU_U0T) + dvc * 64 + mt * 32 + 4 * h; P.u0 = *(const v2u*)(U0t_); P.u1 = *(const v2u*)(U0t_ + 8); P.u2 = *(const v2u*)(U0t_ + 16); P.u3 = *(const v2u*)(U0t_ + 24); } \
                { const int tz_ = tn < nvalid ? tn : 0; const bf16* zr_ = big + (size_t)(row0_ + tz_) * C_NP + 8192 + hv * 128 + sub * 16; P.z0 = *(const v4u*)zr_; P.z1 = *(const v4u*)(zr_ + 8); }          \
                P.decay = ((const float*)(ws + SC_DECAY))[uid_]; } while (0)
#define SCAN_STAGE(P) do { { const int t_ = tid >> 4, c8_ = (tid & 15) * 8; *(v4u*)(Wl + t_ * 136 + c8_) = P.w0; *(v4u*)(Wl + (t_ + 32) * 136 + c8_) = P.w1; *(v4u*)(Ql + t_ * 136 + c8_) = P.q0; *(v4u*)(Ql + (t_ + 32) * 136 + c8_) = P.q1; } \
                { const int dk_ = tid >> 3, c8_ = (tid & 7) * 8; *(v4u*)(Kl + dk_ * 72 + c8_) = P.k0; *(v4u*)(Kl + (dk_ + 64) * 72 + c8_) = P.k1; *(v4u*)(Al + dk_ * 72 + c8_) = P.aq; } } while (0)
            ScanPf cur, nxt;
            SCAN_FETCH(cur, 0);
            SCAN_STAGE(cur);
            nxt = cur;
            for (int step = 0; step < nsteps; ++step) {
                const int row0 = smp ? NP + seq * 32 : seq * SEQ + step * 64;
                if (!smp && !few && step + 1 == C_TLATE) {
                    if (tid == 0) { unsigned sp = 0u; while (__hip_atomic_load(lpw, __ATOMIC_RELAXED, __HIP_MEMORY_SCOPE_AGENT) < (unsigned)(G - 64) && ++sp < (1u << 20)) __builtin_amdgcn_s_sleep(2);
                        __builtin_amdgcn_fence(__ATOMIC_ACQUIRE, "agent"); asm volatile("s_waitcnt vmcnt(0)" ::: "memory"); }
                    __syncthreads();
                }
                if (step + 1 < nsteps) SCAN_FETCH(nxt, step + 1);
#pragma unroll
                for (int q = 0; q < 4; ++q) {
                    v2u w0, w1; w0.x = pk2(S0[4 * q], S0[4 * q + 1]); w0.y = pk2(S0[4 * q + 2], S0[4 * q + 3]); w1.x = pk2(S1[4 * q], S1[4 * q + 1]); w1.y = pk2(S1[4 * q + 2], S1[4 * q + 3]);
                    *(v2u*)(St + dvc * 136 + (2 * mt) * 32 + 8 * q + 4 * h) = w0; *(v2u*)(St + dvc * 136 + (2 * mt + 1) * 32 + 8 * q + 4 * h) = w1; }
                f32x16c u;
#define SCAN_U0(q, W) do { u[4 * q] = __uint_as_float(W.x << 16); u[4 * q + 1] = __uint_as_float(W.x & 0xffff0000u); u[4 * q + 2] = __uint_as_float(W.y << 16); u[4 * q + 3] = __uint_as_float(W.y & 0xffff0000u); } while (0)
                SCAN_U0(0, cur.u0); SCAN_U0(1, cur.u1); SCAN_U0(2, cur.u2); SCAN_U0(3, cur.u3);
                __syncthreads();
                f32x16c ws_acc = {}, o = {};
#pragma unroll
                for (int s = 0; s < 8; ++s) { const bf16x8 bS = *(const bf16x8*)(St + dvc * 136 + 16 * s + 8 * h);
                    ws_acc = __builtin_amdgcn_mfma_f32_32x32x16_bf16(*(const bf16x8*)(Wl + (mt * 32 + r32) * 136 + 16 * s + 8 * h), bS, ws_acc, 0, 0, 0);
                    o = __builtin_amdgcn_mfma_f32_32x32x16_bf16(*(const bf16x8*)(Ql + (mt * 32 + r32) * 136 + 16 * s + 8 * h), bS, o, 0, 0, 0); }
#pragma unroll
                for (int r = 0; r < 16; ++r) u[r] -= ws_acc[r];
#pragma unroll
                for (int q = 0; q < 4; ++q) { v2u w; w.x = pk2(u[4 * q], u[4 * q + 1]); w.y = pk2(u[4 * q + 2], u[4 * q + 3]); *(v2u*)(ut + dvc * 72 + mt * 32 + 8 * q + 4 * h) = w; }
                __syncthreads();
                const float decay = cur.decay;
#pragma unroll
                for (int r = 0; r < 16; ++r) { S0[r] *= decay; S1[r] *= decay; }
#pragma unroll
                for (int s = 0; s < 4; ++s) { const bf16x8 bU = *(const bf16x8*)(ut + dvc * 72 + 16 * s + 8 * h);
                    o = __builtin_amdgcn_mfma_f32_32x32x16_bf16(*(const bf16x8*)(Al + (mt * 32 + r32) * 72 + 16 * s + 8 * h), bU, o, 0, 0, 0);
                    S0 = __builtin_amdgcn_mfma_f32_32x32x16_bf16(*(const bf16x8*)(Kl + ((2 * mt) * 32 + r32) * 72 + 16 * s + 8 * h), bU, S0, 0, 0, 0);
                    S1 = __builtin_amdgcn_mfma_f32_32x32x16_bf16(*(const bf16x8*)(Kl + ((2 * mt + 1) * 32 + r32) * 72 + 16 * s + 8 * h), bU, S1, 0, 0, 0); }
#pragma unroll
                for (int r = 0; r < 16; ++r) ol[(mt * 32 + crow16(r, h)) * 132 + dvc] = o[r];
                __syncthreads();
                { float v[16]; float ss = 0.f;
#pragma unroll
                  for (int e = 0; e < 16; ++e) { v[e] = ol[tn * 132 + sub * 16 + e]; ss = fmaf(v[e], v[e], ss); }
                  ss += __shfl_xor(ss, 1); ss += __shfl_xor(ss, 2); ss += __shfl_xor(ss, 4);
                  const float rs = rsqrtf(ss * (1.f / 128.f) + RMS_EPS);
                  if (tn < nvalid) {
                      const unsigned zw[8] = {cur.z0.x, cur.z0.y, cur.z0.z, cur.z0.w, cur.z1.x, cur.z1.y, cur.z1.z, cur.z1.w};
                      float y[16];
#pragma unroll
                      for (int e = 0; e < 16; ++e) { const float z = (e & 1) ? __uint_as_float(zw[e >> 1] & 0xffff0000u) : __uint_as_float(zw[e >> 1] << 16); y[e] = v[e] * rs * normw[sub * 16 + e] * siluf_(z); }
                      v4u o0, o1; o0.x = pk2(y[0], y[1]); o0.y = pk2(y[2], y[3]); o0.z = pk2(y[4], y[5]); o0.w = pk2(y[6], y[7]); o1.x = pk2(y[8], y[9]); o1.y = pk2(y[10], y[11]); o1.z = pk2(y[12], y[13]); o1.w = pk2(y[14], y[15]);
                      bf16* dst = og + (size_t)(row0 + tn) * C_VD + hv * 128 + sub * 16; *(v4u*)dst = o0; *(v4u*)(dst + 8) = o1; } }
                __syncthreads();
                if (step + 1 < nsteps) { SCAN_STAGE(nxt); cur = nxt; }
            }
            { float* so = a->out + (smp ? O_CSS : O_CSP) + ((size_t)(seq * 32 + hv) * 128) * 128;
#pragma unroll
              for (int r = 0; r < 16; ++r) { so[(size_t)((2 * mt) * 32 + crow16(r, h)) * 128 + dvc] = S0[r]; so[(size_t)((2 * mt + 1) * 32 + crow16(r, h)) * 128 + dvc] = S1[r]; } }
#undef SCAN_FETCH
#undef SCAN_STAGE
#undef SCAN_U0
        }
    }
    { const Frame F = relaunder(F0); __syncthreads();
      if (few) convert_weights<true>(F, a, blockIdx.x * NWAVES + F.wave, G * NWAVES);
      else if (blockIdx.x >= 64) convert_weights<true>(F, a, ((int)blockIdx.x - 64) * NWAVES + F.wave, (G - 64) * NWAVES, G == 256 ? C_DEF_SPLIT : 0); }
}

template <int PH> __device__ __forceinline__ void run_phase(const Frame& F, const int layer) {
    const KArgs KA = kargs();
    unsigned char* ws = KA->ws;
    const int kind = layer % 3, j = layer / 3;
    if constexpr (PH == 0) { p0_prologue(F, KA); }
    if constexpr (PH == 1) {
        pg8::Gemm g{(const bf16*)(ws + WS_XN), (const bf16*)(ws + WS_WA_IN) + (size_t)j * A_N * DM, NTOK, A_N, DM};
        pg8::StaticOrder S; S.init(NTOK, A_N, F.G, launder_s((int)blockIdx.x), DM);
        pg8::EpiF<FnAqkv> E{{(bf16*)(ws + WS_BIG), KA->out, (bf16*)(ws + SA_CATK), (bf16*)(ws + SA_CATV), j}};
        pg8::gemm_phase<pg8::EpiF<FnAqkv>, pg8::StaticOrder, true, true>(F.lds, g, S, E, relaunder(F).tid);
        { const int ntail = (NTOK / 256) * (A_N / 256) % F.G, rk = F.G == 256 ? (int)blockIdx.x - ntail : (int)blockIdx.x, nbk = F.G == 256 ? F.G - ntail : F.G;
          cat_rows(F, KA->in[I_CAK] + (size_t)j * 16 * 512 * 2048, (bf16*)(ws + SA_CATK), 16, 512, 2048, A_CATROWS, 544, rk, nbk);
          cat_rows(F, KA->in[I_CAV] + (size_t)j * 16 * 512 * 2048, (bf16*)(ws + SA_CATV), 16, 512, 2048, A_CATROWS, 544, rk, nbk); }
    }
    if constexpr (PH == 2) attn_a_phase(F, ws, KA->in[I_ABIAS] + (size_t)j * 16 * 257);
    if constexpr (PH == 3) {
        pg8::Gemm g{(const bf16*)(ws + WS_XN), (const bf16*)(ws + WS_WB_IN), NTOK, B_NP, DM};
        pg8::StaticOrder S; S.init(NTOK, B_NP, F.G, launder_s((int)blockIdx.x), DM);
        pg8::EpiF<FnBproj> E{{(bf16*)(ws + WS_BIG), KA->out, (float*)(ws + WS_SIDE), (bf16*)(ws + SB_CATK), (bf16*)(ws + SB_CATV), (bf16*)(ws + SB_CATI)}};
        pg8::gemm_phase<pg8::EpiF<FnBproj>, pg8::StaticOrder, true, true>(F.lds, g, S, E, relaunder(F).tid);
        { const int ntail = (NTOK / 256) * (B_NP / 256) % F.G, rk = F.G == 256 ? (int)blockIdx.x - ntail : (int)blockIdx.x, nbk = F.G == 256 ? F.G - ntail : F.G;
          cat_rows(F, KA->in[I_CBK], (bf16*)(ws + SB_CATK), 16, 1024, 512, B_CATROWS, 1056, rk, nbk);
          cat_rows(F, KA->in[I_CBV], (bf16*)(ws + SB_CATV), 16, 1024, 512, B_CATROWS, 1056, rk, nbk);
          cat_rows(F, KA->in[I_CBI], (bf16*)(ws + SB_CATI), 16, 1024, 64, B_CATROWS, 1056, rk, nbk); }
    }
    if constexpr (PH == 4) idx_phase(F, ws);
    if constexpr (PH == 5) attn_b_phase(F, ws);
    if constexpr (PH == 6) {
        pg8::Gemm g{(const bf16*)(ws + WS_XN), (const bf16*)(ws + WS_WC_IN), NTOK, C_NP, DM};
        pg8::StaticOrder S; S.init(NTOK, C_NP, F.G, launder_s((int)blockIdx.x), DM);
        pg8::EpiF<FnCproj> E{{(bf16*)(ws + WS_BIG), KA->out, (float*)(ws + WS_SIDE)}};
        pg8::gemm_phase<pg8::EpiF<FnCproj>, pg8::StaticOrder, true, true>(F.lds, g, S, E, relaunder(F).tid);
        { const int ntail = (NTOK / 256) * (C_NP / 256) % F.G; if (F.G == 256 && (int)blockIdx.x >= ntail) { const Frame Fc = relaunder(F); convert_weights<true>(Fc, KA, ((int)blockIdx.x - ntail) * NWAVES + Fc.wave, (F.G - ntail) * NWAVES, 0, C_DEF_SPLIT); } }
    }
    if constexpr (PH == 7) { if (F.G > 64) c_prep_phase<0>(F, KA, (int)blockIdx.x, F.G, C_NEARLY); else c_prep_phase<2>(F, KA, (int)blockIdx.x, F.G, C_UNITS); }
    if constexpr (PH == 8) c_scan_phase(F, KA);
    if constexpr (PH == 9) {
        const bf16* wout = kind == 0 ? (const bf16*)(ws + WS_WA_OUT) + (size_t)j * DM * DM : kind == 1 ? (const bf16*)(ws + WS_WB_OUT) : (const bf16*)(ws + WS_WC_OUT);
        pg8::Gemm g{(const bf16*)(ws + WS_ATT), wout, NTOK, DM, kind == 2 ? C_VD : DM};
        pg8::SplitOrder S; S.init(launder_s((int)blockIdx.x), g.K);
        pg8::EpiF<FnMix> E{{(float*)(ws + WS_MIX), (float*)(ws + WS_PART)}};
        pg8::gemm_phase<pg8::EpiF<FnMix>, pg8::SplitOrder, true, true>(F.lds, g, S, E, relaunder(F).tid);
    }
    if constexpr (PH == 10) {
        ln_phase(F, KA->in[I_XP], KA->in[I_XS], layer == 0, (const float*)(ws + WS_MIX), (const float*)(ws + WS_PART), KA->in[I_LN1G] + layer * DM, KA->in[I_LN1B] + layer * DM, nullptr, (bf16*)(ws + WS_XN));
    }
    if constexpr (PH == 11) {
        pg8::Gemm g{(const bf16*)(ws + WS_XN), (const bf16*)(ws + WS_W1) + (size_t)layer * DFF * DM, NTOK, DFF, DM};
        pg8::StaticOrder S; S.init(NTOK, DFF, F.G, launder_s((int)blockIdx.x), DM);
        pg8::EpiF<FnRelu2> E{{(bf16*)(ws + WS_BIG)}};
        pg8::gemm_phase<pg8::EpiF<FnRelu2>, pg8::StaticOrder, true, true>(F.lds, g, S, E, relaunder(F).tid);
    }
    if constexpr (PH == 12) {
        pg8::Gemm g{(const bf16*)(ws + WS_BIG), (const bf16*)(ws + WS_W2) + (size_t)layer * DM * DFF, NTOK, DM, DFF};
        pg8::SplitOrder S; S.init(launder_s((int)blockIdx.x), DFF);
        pg8::EpiF<FnMix> E{{(float*)(ws + WS_MIX), (float*)(ws + WS_PART)}};
        pg8::gemm_phase<pg8::EpiF<FnMix>, pg8::SplitOrder, true, true>(F.lds, g, S, E, relaunder(F).tid);
    }
    if constexpr (PH == 13) ln_phase(F, KA->in[I_XP], KA->in[I_XS], false, (const float*)(ws + WS_MIX), (const float*)(ws + WS_PART), KA->in[I_LN2G] + layer * DM, KA->in[I_LN2B] + layer * DM, layer == DEPTH - 1 ? KA->out + O_YP : nullptr, (bf16*)(ws + WS_XN));
}

constexpr int LDS_BYTES = 147456, MISC_OFF = LDS_BYTES - 64;
#ifndef MK_SINGLE
#define MK_SINGLE 1
#endif
#ifndef MULTIK
__global__ void __launch_bounds__(NTHR, 2) mk_fwd(Args args) {
    extern __shared__ __attribute__((aligned(16))) unsigned char lds_raw[];
    Frame F; F.lds = (LAS unsigned char*)lds_raw;
    F.tid = threadIdx.x; F.lane = F.tid & 63; F.wave = __builtin_amdgcn_readfirstlane(F.tid >> 6);
    F.G = gridDim.x; { const int bx = blockIdx.x; F.vcu = (F.G % 8 == 0) ? (bx % 8) * (F.G / 8) + bx / 8 : bx; }
    const int lo = args.ph_lo, hi = args.ph_hi;
    volatile LAS unsigned* misc = (volatile LAS unsigned*)(F.lds + MISC_OFF);
    if (F.tid < 16) misc[F.tid] = 0u;
    __syncthreads();
    XcdBarrier bar; bar.bar = (unsigned*)(args.ws + WS_CTL) + CW_BAR; bar.x = 0; bar.st = misc;
    if (MK_SINGLE) bar = xcd_barrier_post((unsigned*)(args.ws + WS_CTL) + CW_BAR, misc);
#define IN(k) (lo <= (k) && (k) < hi)
#define SEAM(k) do { if (MK_SINGLE && hi > (k) + 1) xcd_barrier(bar); } while (0)
    if (IN(0)) { run_phase<0>(F, 0); SEAM(0); }
    for (int layer = 0; layer < DEPTH; ++layer) {
        const int kind = layer % 3, base = 1 + 8 * layer;
        if (kind == 0) {
            if (IN(base + 0)) { run_phase<1>(F, layer); SEAM(base + 0); }
            if (IN(base + 1)) { run_phase<2>(F, layer); SEAM(base + 1); }
        } else if (kind == 1) {
            if (IN(base + 0)) { run_phase<3>(F, layer); SEAM(base + 0); }
            if (IN(base + 1)) { run_phase<4>(F, layer); SEAM(base + 1); }
            if (IN(base + 2)) { run_phase<5>(F, layer); SEAM(base + 2); }
        } else {
            if (IN(base + 0)) { run_phase<6>(F, layer); SEAM(base + 0); }
            if (IN(base + 1)) { run_phase<7>(F, layer); SEAM(base + 1); }
            if (IN(base + 2)) { run_phase<8>(F, layer); SEAM(base + 2); }
        }
        if (IN(base + 3)) { run_phase<9>(F, layer); SEAM(base + 3); }
        if (IN(base + 4)) { run_phase<10>(F, layer); SEAM(base + 4); }
        if (IN(base + 5)) { run_phase<11>(F, layer); SEAM(base + 5); }
        if (IN(base + 6)) { run_phase<12>(F, layer); SEAM(base + 6); }
        if (IN(base + 7)) { run_phase<13>(F, layer); SEAM(base + 7); }
    }
#undef IN
#undef SEAM
}
#endif

#ifdef MULTIK
template <int PH> __global__ void __launch_bounds__(NTHR, 2) k_phase(Args args, int layer) {
    extern __shared__ __attribute__((aligned(16))) unsigned char lds_raw[];
    Frame F; F.lds = (LAS unsigned char*)lds_raw;
    F.tid = threadIdx.x; F.lane = F.tid & 63; F.wave = __builtin_amdgcn_readfirstlane(F.tid >> 6);
    F.G = gridDim.x; F.vcu = blockIdx.x;
    run_phase<PH>(F, layer);
}
template <int PH> static void launch_phase(const Args& a, int layer, int grid, hipStream_t stream) {
    static bool attr = false;
    if (!attr) { (void)hipFuncSetAttribute((const void*)k_phase<PH>, hipFuncAttributeMaxDynamicSharedMemorySize, LDS_BYTES); attr = true; }
    hipLaunchKernelGGL(k_phase<PH>, dim3(grid), dim3(NTHR), LDS_BYTES, stream, a, layer);
#ifdef DBL_K
    if (PH == DBL_K) hipLaunchKernelGGL(k_phase<PH>, dim3(grid), dim3(NTHR), LDS_BYTES, stream, a, layer);
#endif
}
#endif
extern "C" void kernel_launch(void* const* d_in, const int* in_sizes, int n_in, void* d_out, int out_size, void* d_ws, size_t ws_size, hipStream_t stream) {
    static int grid = 0;
    if (grid == 0) {
        if (n_in != N_IN || (size_t)out_size != O_END || ws_size < WS_END) { fprintf(stderr, "kernel_launch: shape mismatch n_in %d out %d ws %zu (need %zu)\n", n_in, out_size, ws_size, (size_t)WS_END); grid = -1; return; }
        { const long exp_sz[N_IN] = {(long)NP * DM, (long)NS * DM, 2L * 16 * 512 * 2048, 2L * 16 * 512 * 2048, 16L * 1024 * 512, 16L * 1024 * 512, 16L * 1024 * 64, 16L * 3 * 8192, 16L * 32 * 128 * 128,
                                       2L * DM * A_N, 2L * 16 * 257, 2L * DM * DM, (long)DM * B_N, (long)DM * DM, (long)DM * C_N, 4L * 8192, 32, 32, 128, (long)C_VD * DM,
                                       4L * DM, 4L * DM, 4L * DM * DFF, 4L * DFF * DM, 4L * DM, 4L * DM};
          for (int i = 0; i < N_IN; ++i) if ((long)in_sizes[i] != exp_sz[i]) { fprintf(stderr, "kernel_launch: input %d has %d elements, expected %ld\n", i, in_sizes[i], exp_sz[i]); grid = -1; return; } }
        int dev = 0, cus = 0, per_cu = 0;
        if (hipGetDevice(&dev) != hipSuccess || hipDeviceGetAttribute(&cus, hipDeviceAttributeMultiprocessorCount, dev) != hipSuccess) { grid = -1; return; }
#ifndef MULTIK
        if (hipFuncSetAttribute((const void*)mk_fwd, hipFuncAttributeMaxDynamicSharedMemorySize, LDS_BYTES) != hipSuccess) { grid = -1; return; }
        if (hipOccupancyMaxActiveBlocksPerMultiprocessor(&per_cu, (const void*)mk_fwd, NTHR, LDS_BYTES) != hipSuccess || per_cu < 1) fprintf(stderr, "kernel_launch: occupancy query says %d workgroups per CU\n", per_cu);
#endif
        (void)hipGetLastError();
        grid = cus;
        if (grid != 256) { fprintf(stderr, "kernel_launch: built for a 256-CU device (split-K deal), found %d CUs; nothing launched\n", grid); grid = -1; return; }
    }
    if (grid < 0) return;
    (void)hipMemsetAsync((char*)d_ws + WS_CTL, 0, CTL_ZERO_BYTES, stream);
    Args a{};
    for (int i = 0; i < N_IN; ++i) a.in[i] = (const float*)d_in[i];
    a.out = (float*)d_out; a.ws = (unsigned char*)d_ws;
#ifdef MULTIK
    launch_phase<0>(a, 0, grid, stream);
    for (int layer = 0; layer < DEPTH; ++layer) {
        const int kind = layer % 3;
        if (kind == 0) { launch_phase<1>(a, layer, grid, stream); launch_phase<2>(a, layer, grid, stream); }
        else if (kind == 1) { launch_phase<3>(a, layer, grid, stream); launch_phase<4>(a, layer, grid, stream); launch_phase<5>(a, layer, grid, stream); }
        else { launch_phase<6>(a, layer, grid, stream); launch_phase<7>(a, layer, grid, stream); launch_phase<8>(a, layer, grid, stream); }
        launch_phase<9>(a, layer, grid, stream); launch_phase<10>(a, layer, grid, stream); launch_phase<11>(a, layer, grid, stream); launch_phase<12>(a, layer, grid, stream); launch_phase<13>(a, layer, grid, stream);
    }
    return;
#else
    if (MK_SINGLE) { a.ph_lo = 0; a.ph_hi = 1 + 8 * DEPTH; hipLaunchKernelGGL(mk_fwd, dim3(grid), dim3(NTHR), LDS_BYTES, stream, a); }
    else for (int ph = 0; ph < 1 + 8 * DEPTH; ++ph) { if (ph == 3 || ph == 27) continue; a.ph_lo = ph; a.ph_hi = ph + 1; hipLaunchKernelGGL(mk_fwd, dim3(grid), dim3(NTHR), LDS_BYTES, stream, a); }
#endif
}
```

```cpp
#include <hip/hip_runtime.h>
#include <cstdio>
#include <cstdint>
namespace pg8 {
#define PG8_LAS __attribute__((address_space(3)))
typedef unsigned short bf16_t;
typedef short bf16x8 __attribute__((ext_vector_type(8)));
typedef float f32x4 __attribute__((ext_vector_type(4)));
typedef unsigned u32x4 __attribute__((ext_vector_type(4)));
constexpr int BM = 256, BK = 64, HALF = 128, HTB = HALF * BK * 2  , STAGE_BYTES = 8 * HTB, NXCD = 8, WGM = 8;

__host__ __device__ __forceinline__ int lds_byte(int r, int c) { const int st = (r >> 4) * 2 + (c >> 5), rr = r & 15, cc = c & 31, ob = rr * 64 + cc * 2; return st * 1024 + (ob ^ (((ob >> 9) & 1) << 5)); }
__host__ __device__ __forceinline__ void stage_rc(int b, int& R, int& C) { const int st = b / 1024, sb = b % 1024, swz = sb ^ (((sb >> 9) & 1) << 5); R = (st >> 1) * 16 + swz / 64; C = (st & 1) * 32 + (swz % 64) / 2; }
__host__ __device__ __forceinline__ int perm32(int rho) { const int n = rho >> 4, i = rho & 15; return 8 * (i >> 2) + 4 * n + (i & 3); }

struct Unit { int pm, pn, k0, nt, ks; };
struct Gemm { const bf16_t* A; const bf16_t* Bt; int M, N, K; };

struct StaticOrder {
    int nM, nN, nwg, G, c, Kt;
    __host__ __device__ void init(int M, int N, int G_, int c_, int K_) { nM = M / BM; nN = N / BM; nwg = nM * nN; G = G_; c = c_; Kt = K_ / BK; }
    __host__ __device__ bool next(int i, Unit& u) const {
        const long L = (long)i * G + c; if (L >= nwg) return false;
        int wgid = (int)L; { const int q = nwg / NXCD, r = nwg % NXCD, xcd = wgid % NXCD, off = wgid / NXCD; wgid = (xcd < r ? xcd * (q + 1) : r * (q + 1) + (xcd - r) * q) + off; }
        const int nig = WGM * nN, gid = wgid / nig, fm = gid * WGM, gsz = (nM - fm) < WGM ? (nM - fm) : WGM;
        u.pm = fm + ((wgid % nig) % gsz); u.pn = (wgid % nig) / gsz; u.k0 = 0; u.nt = Kt; u.ks = 0; return true;
    }
    __device__ __forceinline__ void a_ready(const Unit&) const {}
    __device__ __forceinline__ void done(const Unit&) const {}
};


struct SplitOrder {
    int c, Kt;
    __host__ __device__ void init(int c_, int K_) { c = c_; Kt = K_ / BK; }
    __host__ __device__ bool next(int i, Unit& u) const {
        if (i == 0) { const int xcd = c & 7, off = c >> 3;
            const int w = xcd * 32 + off; u.pm = (w >> 5) * 4 + (w & 3); u.pn = (w >> 2) & 7; u.k0 = 0; u.nt = Kt; u.ks = 0; return true; }
        if (i == 1) { u.pm = 32 + (c >> 7); u.pn = (c >> 4) & 7; u.ks = c & 15; u.nt = Kt / 16; u.k0 = u.ks * u.nt * BK; return true; }
        return false;
    }
    __device__ __forceinline__ void a_ready(const Unit&) const {}
    __device__ __forceinline__ void done(const Unit&) const {}
};
__device__ __forceinline__ unsigned cvt_pk_bf16(float lo, float hi) { unsigned r; asm volatile("v_cvt_pk_bf16_f32 %0, %1, %2" : "=v"(r) : "v"(lo), "v"(hi)); return r; }
template <class F> struct EpiF {
    static constexpr bool PERM = true, AFTER_DRAIN = false;
    F f;
    __device__ __forceinline__ void operator()(const f32x4 (&acc)[2][2][4][2], const Unit& u, int wr, int wc, int fr, int fq) const {
        const int row0 = u.pm * BM + wr * 64 + fr, col0 = u.pn * BM + wc * 32 + 8 * fq;
#pragma unroll
        for (int ai = 0; ai < 2; ++ai)
#pragma unroll
            for (int m = 0; m < 4; ++m)
#pragma unroll
                for (int bj = 0; bj < 2; ++bj) f(row0 + ai * HALF + m * 16, col0 + bj * HALF, acc[ai][bj][m][0], acc[ai][bj][m][1], u);
    }
};
template <class Epi, class Sched, bool ALIGN_EPI = false, bool SP2 = false>
__device__ __forceinline__ void gemm_phase(PG8_LAS unsigned char* lds, const Gemm g, const Sched& S, const Epi& E, const int tid  ) {
    const int wid = __builtin_amdgcn_readfirstlane(tid >> 6), lane = tid & 63, wr = wid >> 2, wc = wid & 3, fr = lane & 15, fq = lane >> 4;
    const int K = g.K;
    unsigned voffA[2], voffB[2];
#pragma unroll
    for (int i = 0; i < 2; ++i) { int R, C; stage_rc(tid * 16 + i * 8192, R, C); const int Rb = Epi::PERM ? ((R & ~31) + perm32(R & 31)) : R;
        voffA[i] = (unsigned)(R * K + C) * 2u; voffB[i] = (unsigned)(Rb * K + C) * 2u; }
    const size_t kstep = (size_t)(BK * 2);
    const size_t hstep = (size_t)HALF * K * 2;
    const size_t tstep = 2 * hstep;
    const unsigned ldsw = (unsigned)wid * 1024u;
    const int aoff = lds_byte(wr * 64 + fr, fq * 8), boff = lds_byte(wc * 32 + fr, fq * 8);
#define PG8_SA(b, h) (((b) * 2 + (h)) * HTB)
#define PG8_SB(b, h) ((4 + (b) * 2 + (h)) * HTB)
#define PG8_STAGE(bufoff, gbase, voff) do { _Pragma("unroll") for (int _i = 0; _i < 2; ++_i) \
        __builtin_amdgcn_global_load_lds((const unsigned*)((const char*)(gbase) + (voff)[_i]), (PG8_LAS unsigned*)(lds + (bufoff) + ldsw + _i * 8192), 16, 0, 0); } while (0)
#define PG8_LDA(dst, b, h) do { _Pragma("unroll") for (int m = 0; m < 4; ++m) _Pragma("unroll") for (int k = 0; k < 2; ++k) dst[m][k] = *(const PG8_LAS bf16x8*)(lds + PG8_SA(b, h) + aoff + m * 2048 + k * 1024); } while (0)
#define PG8_LDB(dst, b, h) do { _Pragma("unroll") for (int n = 0; n < 2; ++n) _Pragma("unroll") for (int k = 0; k < 2; ++k) dst[n][k] = *(const PG8_LAS bf16x8*)(lds + PG8_SB(b, h) + boff + n * 2048 + k * 1024); } while (0)
#define PG8_MMA(ai, bj, At, Bt) do { __builtin_amdgcn_s_setprio(1); _Pragma("unroll") for (int m = 0; m < 4; ++m) _Pragma("unroll") for (int n = 0; n < 2; ++n) _Pragma("unroll") for (int k = 0; k < 2; ++k) \
        acc[ai][bj][m][n] = __builtin_amdgcn_mfma_f32_16x16x32_bf16(Bt[n][k], At[m][k], acc[ai][bj][m][n], 0, 0, 0); __builtin_amdgcn_s_setprio(0); } while (0)
#define PG8_WAIT_V(n) asm volatile("s_waitcnt vmcnt(" #n ")" ::: "memory")
#define PG8_WAIT_L(n) asm volatile("s_waitcnt lgkmcnt(" #n ")" ::: "memory")
#define PG8_BAR __builtin_amdgcn_s_barrier()
#define PG8_SCHED __builtin_amdgcn_sched_barrier(0)
    Unit cur, nxt; int ui = 0;
    if (!S.next(0, cur)) return;
    f32x4 acc[2][2][4][2];
#pragma unroll
    for (int a = 0; a < 2; ++a)
#pragma unroll
        for (int b = 0; b < 2; ++b)
#pragma unroll
            for (int m = 0; m < 4; ++m)
#pragma unroll
                for (int n = 0; n < 2; ++n) acc[a][b][m][n] = (f32x4){0.f, 0.f, 0.f, 0.f};
    bf16x8 At[4][2], B0[2][2], B1[2][2];
    const char* cA = (const char*)g.A + (size_t)cur.pm * tstep + (size_t)cur.k0 * 2; const char* cB = (const char*)g.Bt + (size_t)cur.pn * tstep + (size_t)cur.k0 * 2;
    S.a_ready(cur);
    if constexpr (SP2) {
        PG8_STAGE(PG8_SB(0, 0), cB, voffB); PG8_STAGE(PG8_SB(0, 1), cB + hstep, voffB); PG8_STAGE(PG8_SA(0, 0), cA, voffA); PG8_STAGE(PG8_SA(0, 1), cA + hstep, voffA);
        if (wr == 1) PG8_BAR;
        PG8_WAIT_V(2); PG8_BAR;
        PG8_STAGE(PG8_SB(1, 0), cB + kstep, voffB); PG8_STAGE(PG8_SA(1, 0), cA + kstep, voffA); PG8_STAGE(PG8_SB(1, 1), cB + hstep + kstep, voffB);
        PG8_WAIT_V(6); PG8_BAR;
    } else {
        PG8_STAGE(PG8_SB(0, 0), cB, voffB); PG8_STAGE(PG8_SA(0, 0), cA, voffA); PG8_STAGE(PG8_SB(0, 1), cB + hstep, voffB); PG8_STAGE(PG8_SA(0, 1), cA + hstep, voffA);
        if (wr == 1) PG8_BAR;
        PG8_WAIT_V(4); PG8_BAR;
        PG8_STAGE(PG8_SB(1, 0), cB + kstep, voffB); PG8_STAGE(PG8_SA(1, 0), cA + kstep, voffA); PG8_STAGE(PG8_SB(1, 1), cB + hstep + kstep, voffB);
        PG8_WAIT_V(6); PG8_BAR;
    }
    for (;;) {
        const bool has_next = S.next(ui + 1, nxt);
        const char* nA = has_next ? (const char*)g.A + (size_t)nxt.pm * tstep + (size_t)nxt.k0 * 2 : cA; const char* nB = has_next ? (const char*)g.Bt + (size_t)nxt.pn * tstep + (size_t)nxt.k0 * 2 : cB;
        const int nt = cur.nt;
        for (int t = 0; t < nt; t += 2) {
            const bool last = (t == nt - 2);
            const char* a1 = cA + (size_t)(t + 1) * kstep;
            const char* a2 = last ? nA : cA + (size_t)(t + 2) * kstep; const char* b2 = last ? nB : cB + (size_t)(t + 2) * kstep;
            const char* a3 = a2 + kstep; const char* b3 = b2 + kstep;
            if (last && has_next) S.a_ready(nxt);
            if constexpr (SP2) {
            PG8_LDB(B0, 0, 0); PG8_LDB(B1, 0, 1); PG8_SCHED; PG8_LDA(At, 0, 0); PG8_STAGE(PG8_SA(1, 1), a1 + hstep, voffA);
            PG8_WAIT_V(8); PG8_WAIT_L(0); PG8_BAR; PG8_MMA(0, 0, At, B0); PG8_MMA(0, 1, At, B1); PG8_BAR; PG8_SCHED;
            PG8_LDA(At, 0, 1); PG8_STAGE(PG8_SB(0, 0), b2, voffB); PG8_STAGE(PG8_SB(0, 1), b2 + hstep, voffB); PG8_STAGE(PG8_SA(0, 0), a2, voffA);
            PG8_WAIT_V(8); PG8_WAIT_L(0); PG8_BAR; PG8_MMA(1, 0, At, B0); PG8_MMA(1, 1, At, B1); PG8_BAR; PG8_SCHED;
            PG8_LDB(B0, 1, 0); PG8_LDB(B1, 1, 1); PG8_SCHED; PG8_LDA(At, 1, 0); PG8_STAGE(PG8_SA(0, 1), a2 + hstep, voffA);
            PG8_WAIT_V(8); PG8_WAIT_L(0); PG8_BAR; PG8_MMA(0, 0, At, B0); PG8_MMA(0, 1, At, B1); PG8_BAR; PG8_SCHED;
            PG8_LDA(At, 1, 1); PG8_STAGE(PG8_SB(1, 0), b3, voffB); PG8_STAGE(PG8_SB(1, 1), b3 + hstep, voffB); PG8_STAGE(PG8_SA(1, 0), a3, voffA);
            PG8_WAIT_V(8); PG8_WAIT_L(0); PG8_BAR; PG8_MMA(1, 0, At, B0); PG8_MMA(1, 1, At, B1); PG8_BAR; PG8_SCHED;
            } else {
            PG8_LDB(B0, 0, 0); PG8_SCHED; PG8_LDA(At, 0, 0); PG8_STAGE(PG8_SA(1, 1), a1 + hstep, voffA);
            PG8_WAIT_L(8); PG8_BAR; PG8_WAIT_L(0); PG8_MMA(0, 0, At, B0); PG8_BAR; PG8_SCHED;
            PG8_LDB(B1, 0, 1); PG8_STAGE(PG8_SB(0, 0), b2, voffB);
            PG8_BAR; PG8_WAIT_L(0); PG8_MMA(0, 1, At, B1); PG8_BAR;
            PG8_LDA(At, 0, 1); PG8_STAGE(PG8_SA(0, 0), a2, voffA);
            PG8_BAR; PG8_WAIT_L(0); PG8_MMA(1, 0, At, B0); PG8_BAR; PG8_SCHED;
            PG8_STAGE(PG8_SB(0, 1), b2 + hstep, voffB);
            PG8_WAIT_V(6); PG8_BAR; PG8_MMA(1, 1, At, B1); PG8_BAR;
            PG8_LDB(B0, 1, 0); PG8_SCHED; PG8_LDA(At, 1, 0); PG8_STAGE(PG8_SA(0, 1), a2 + hstep, voffA);
            PG8_WAIT_L(8); PG8_BAR; PG8_WAIT_L(0); PG8_MMA(0, 0, At, B0); PG8_BAR; PG8_SCHED;
            PG8_LDB(B1, 1, 1); PG8_STAGE(PG8_SB(1, 0), b3, voffB);
            PG8_BAR; PG8_WAIT_L(0); PG8_MMA(0, 1, At, B1); PG8_BAR;
            PG8_LDA(At, 1, 1); PG8_STAGE(PG8_SA(1, 0), a3, voffA);
            PG8_BAR; PG8_WAIT_L(0); PG8_MMA(1, 0, At, B0); PG8_BAR; PG8_SCHED;
            PG8_STAGE(PG8_SB(1, 1), b3 + hstep, voffB);
            PG8_WAIT_V(6); PG8_BAR; PG8_MMA(1, 1, At, B1); PG8_BAR;
            }
        }
        if constexpr (ALIGN_EPI) { if (wr == 0) PG8_BAR; }
        if constexpr (!Epi::AFTER_DRAIN) { E(acc, cur, wr, wc, fr, fq); S.done(cur); }
        if (!has_next) break;
#pragma unroll
        for (int a = 0; a < 2; ++a)
#pragma unroll
            for (int b = 0; b < 2; ++b)
#pragma unroll
                for (int m = 0; m < 4; ++m)
#pragma unroll
                    for (int n = 0; n < 2; ++n) acc[a][b][m][n] = (f32x4){0.f, 0.f, 0.f, 0.f};
        cur = nxt; cA = nA; cB = nB; ++ui;
        if constexpr (ALIGN_EPI) { if (wr == 1) PG8_BAR; }
    }
    PG8_WAIT_V(0);
    if constexpr (!ALIGN_EPI) { if (wr == 0) PG8_BAR; }
    PG8_BAR;
    if constexpr (Epi::AFTER_DRAIN) { E.fused(acc, cur, wr, wc, fr, fq, lds, wid, lane); S.done(cur); }
#undef PG8_SA
#undef PG8_SB
#undef PG8_STAGE
#undef PG8_LDA
#undef PG8_LDB
#undef PG8_MMA
#undef PG8_WAIT_V
#undef PG8_WAIT_L
#undef PG8_BAR
#undef PG8_SCHED
}
}

constexpr int NP = 8192, NS = 512, NTOK = NP + NS, DM = 2048, DFF = 8192, SEQ = 4096, DEPTH = 4;
constexpr int A_N = 6144, B_N = 4176, B_NP = 4352, C_N = 12352, C_NP = 12544, C_VD = 4096;
constexpr int A_LD = A_N + 128, B_LD = B_NP + 128;
constexpr float ALPHA = 1.681792830507429f;
constexpr float LN_EPS = 1e-5f, RMS_EPS = 1e-6f;
constexpr size_t O_YP = 0, O_YS = O_YP + (size_t)NP * DM, O_AKP = O_YS + (size_t)NS * DM, O_AVP = O_AKP + 2ull * 2 * 512 * 2048, O_AKS = O_AVP + 2ull * 2 * 512 * 2048,
    O_AVS = O_AKS + 2ull * 16 * 32 * 2048, O_BKP = O_AVS + 2ull * 16 * 32 * 2048, O_BVP = O_BKP + (size_t)NP * 512, O_BIP = O_BVP + (size_t)NP * 512, O_BKS = O_BIP + (size_t)NP * 64,
    O_BVS = O_BKS + (size_t)NS * 512, O_BIS = O_BVS + (size_t)NS * 512, O_CCP = O_BIS + (size_t)NS * 64, O_CSP = O_CCP + 2ull * 3 * 8192, O_CCS = O_CSP + 2ull * 32 * 128 * 128,
    O_CSS = O_CCS + 16ull * 3 * 8192, O_END = O_CSS + 16ull * 32 * 128 * 128;
enum { I_XP = 0, I_XS, I_CAK, I_CAV, I_CBK, I_CBV, I_CBI, I_SCC, I_SCS, I_AWIN, I_ABIAS, I_AWOUT, I_BWIN, I_BWOUT, I_CWIN, I_CCONVW, I_CALOG, I_CDT, I_CNORM, I_CWOUT,
       I_LN1G, I_LN1B, I_W1, I_W2, I_LN2G, I_LN2B, N_IN };

constexpr size_t MiB = 1u << 20;
constexpr size_t WS_CTL = 0, CTL_ZERO_BYTES = 1 * MiB;
constexpr size_t WS_WA_IN = 1 * MiB;
constexpr size_t WS_WA_OUT = WS_WA_IN + 48 * MiB;
constexpr size_t WS_WB_IN = WS_WA_OUT + 16 * MiB;
constexpr size_t WS_WB_OUT = WS_WB_IN + 17 * MiB;
constexpr size_t WS_WC_IN = WS_WB_OUT + 8 * MiB;
constexpr size_t WS_WC_OUT = WS_WC_IN + 49 * MiB;
constexpr size_t WS_W1 = WS_WC_OUT + 16 * MiB;
constexpr size_t WS_W2 = WS_W1 + 128 * MiB;
constexpr size_t WS_XN = WS_W2 + 128 * MiB;
constexpr size_t WS_BIG = WS_XN + 34 * MiB;
constexpr size_t WS_ATT = WS_BIG + 209 * MiB;
constexpr size_t WS_MIX = WS_ATT + 68 * MiB;
constexpr size_t WS_SIDE = WS_MIX + 68 * MiB;
constexpr size_t WS_SCR = WS_SIDE + 4 * MiB;
constexpr size_t WS_S0COPY = WS_SCR + 330 * MiB;
constexpr size_t WS_PART = WS_S0COPY + 32 * MiB;
constexpr size_t WS_END = WS_PART + 64 * MiB;
constexpr int A_CATROWS = 640;
constexpr size_t SA_CATK = WS_SCR, SA_CATV = SA_CATK + 16ull * A_CATROWS * 2048 * 2;
constexpr int B_CATROWS = 1152;
constexpr size_t SB_CATK = WS_SCR, SB_CATV = SB_CATK + 16ull * B_CATROWS * 512 * 2, SB_CATI = SB_CATV + 16ull * B_CATROWS * 512 * 2,
    SB_SCORE = SB_CATI + 16ull * B_CATROWS * 64 * 2 + MiB / 2, SB_MASK = SB_SCORE + (size_t)NTOK * 4096 * 4, SB_END = SB_MASK + (size_t)NTOK * 512;
static_assert(SB_END <= WS_S0COPY && SA_CATV + 16ull * A_CATROWS * 2048 * 2 <= WS_S0COPY, "scratch map");
constexpr int CW_BAR = 4096, CW_QB = 8192, CW_TF = 16384;

#define GAS __attribute__((address_space(1)))
#define LAS __attribute__((address_space(3)))
typedef unsigned short bf16;
typedef unsigned v4u __attribute__((ext_vector_type(4)));
typedef unsigned v2u __attribute__((ext_vector_type(2)));
typedef float f32x4 __attribute__((ext_vector_type(4)));
typedef float f32x2 __attribute__((ext_vector_type(2)));
typedef short bf16x8 __attribute__((ext_vector_type(8)));
typedef GAS unsigned gu32;
#define LDS_WAIT() asm volatile("s_waitcnt lgkmcnt(0)" ::: "memory")
#define VM_WAIT() asm volatile("s_waitcnt vmcnt(0)" ::: "memory")
constexpr int NWAVES = 8, NTHR = 512;
__device__ __forceinline__ unsigned pk2(float lo, float hi) { return pg8::cvt_pk_bf16(lo, hi); }
__device__ __forceinline__ float bf2f(bf16 b) { return __uint_as_float((unsigned)b << 16); }
__device__ __forceinline__ float wave_sum(float v) {
#pragma unroll
    for (int o = 1; o < 64; o <<= 1) v += __shfl_xor(v, o);
    return v;
}
__device__ __forceinline__ void store8_bf16(bf16* p, f32x4 v0, f32x4 v1) { v4u w; w.x = pk2(v0[0], v0[1]); w.y = pk2(v0[2], v0[3]); w.z = pk2(v1[0], v1[1]); w.w = pk2(v1[2], v1[3]); *(v4u*)p = w; }
__device__ __forceinline__ void store8_f32(float* p, f32x4 v0, f32x4 v1) { *(f32x4*)p = v0; *(f32x4*)(p + 4) = v1; }

#define XB_TMO      128
#define XB_XCNT(j)  (256  + 64 * (j))
#define XB_XSUB(j)  (1280 + 64 * (j))
#define XB_XGEN(j)  (2304 + 64 * (j))
#define XB_TOP      3328
#define XB_TOPGEN   3392
#define XCD_BAR_WORDS 3456
#define XB_SPIN_CAP (1u << 18)

__device__ __forceinline__ unsigned xb_ld(unsigned* p)              { return __hip_atomic_load(p, __ATOMIC_RELAXED, __HIP_MEMORY_SCOPE_AGENT); }
__device__ __forceinline__ unsigned xb_add(unsigned* p, unsigned v) { return __hip_atomic_fetch_add(p, v, __ATOMIC_RELAXED, __HIP_MEMORY_SCOPE_AGENT); }
__device__ __forceinline__ unsigned xb_xcc_id() { return (unsigned)__builtin_amdgcn_s_getreg((3 << 11) | 20) & 0xFu; }
#define XB_SPIN(cond, bar) do { unsigned _sp = 0; while (cond) { __builtin_amdgcn_s_sleep(1); \
    if ((++_sp & 255u) == 0u) { if (xb_ld(&(bar)[XB_TMO])) break; if (_sp > XB_SPIN_CAP) { atomicAdd(&(bar)[XB_TMO], 1u); break; } } } } while (0)

struct XcdBarrier {
    unsigned* bar; unsigned x;
    volatile LAS unsigned* st;
};

__device__ __forceinline__ XcdBarrier xcd_barrier_post(unsigned* bar, volatile LAS unsigned* st) {
    XcdBarrier b; b.bar = bar; b.x = xb_xcc_id(); b.st = st;
    if (threadIdx.x == 0) (void)xb_add(&bar[XB_XCNT(b.x)], 1u);
    return b;
}
__device__ __forceinline__ void xcd_barrier_complete(unsigned* bar, unsigned x, unsigned& nloc, unsigned& nx) {
    const unsigned G = gridDim.x * gridDim.y * gridDim.z;
    unsigned sum, cnt, mine, sp = 0u;
    for (;;) {
        sum = 0u; cnt = 0u; mine = 0u;
#pragma unroll
        for (unsigned j = 0; j < 16; ++j) { const unsigned c = xb_ld(&bar[XB_XCNT(j)]); sum += c; cnt += (c > 0u) ? 1u : 0u; mine = (j == x) ? c : mine; }
        if (sum == G) break;
        __builtin_amdgcn_s_sleep(1);
        if ((++sp & 255u) == 0u) { if (xb_ld(&bar[XB_TMO])) break; if (sp > XB_SPIN_CAP) { atomicAdd(&bar[XB_TMO], 1u); break; } }
    }
    nloc = mine > 0u ? mine : 1u; nx = cnt > 0u ? cnt : 1u;
}

__device__ __forceinline__ void xcd_barrier(const XcdBarrier& b) {
    asm volatile("s_waitcnt vmcnt(0)" ::: "memory");
    __syncthreads();
    if (threadIdx.x == 0) {
        unsigned* bar = b.bar;
        __builtin_amdgcn_s_waitcnt(0);
        unsigned nloc = b.st[0], nx = b.st[1];
        if (nloc == 0u) { xcd_barrier_complete(bar, b.x, nloc, nx); b.st[0] = nloc; b.st[1] = nx; }
        const unsigned old = xb_add(&bar[XB_XSUB(b.x)], 1u);
        const unsigned gen = old / nloc;
        if (old + 1u == (gen + 1u) * nloc) {
            __builtin_amdgcn_fence(__ATOMIC_RELEASE, "agent");
            asm volatile("s_waitcnt vmcnt(0)" ::: "memory");
            const unsigned og = xb_add(&bar[XB_TOP], 1u);
            const unsigned tg = og / nx;
            if (og + 1u == (tg + 1u) * nx) xb_add(&bar[XB_TOPGEN], 1u);
            else XB_SPIN(xb_ld(&bar[XB_TOPGEN]) == tg, bar);
            __builtin_amdgcn_fence(__ATOMIC_ACQUIRE, "agent");
            xb_add(&bar[XB_XGEN(b.x)], 1u);
            asm volatile("s_waitcnt vmcnt(0)" ::: "memory");
        } else {
            XB_SPIN(xb_ld(&bar[XB_XGEN(b.x)]) == gen, bar);
            __builtin_amdgcn_fence(__ATOMIC_ACQUIRE, "agent");
            asm volatile("s_waitcnt vmcnt(0)" ::: "memory");
        }
    }
    __syncthreads();
}

namespace att {
constexpr int D = 128, NW = 8, QBLK = 32, KVBLK = 64;
constexpr float SCALE = 0.088388347648318440f;
constexpr float THR = 8.f;
constexpr size_t SHM_V = KVBLK * D * 2, SHM_K = KVBLK * D * 2, SHM_ATTN = 2 * SHM_V + 2 * SHM_K + NW * 64 * 4;
constexpr size_t SHM_BIAS = SHM_ATTN;
using s16x4  = __attribute__((ext_vector_type(4))) short;
using f32x16 = __attribute__((ext_vector_type(16))) float;
using u32x4  = __attribute__((ext_vector_type(4))) unsigned;
#define KSWZ(row, colB) ((row) * 256 + ((colB) ^ (((row) & 7) << 4)))
#define SBAR() __builtin_amdgcn_sched_barrier(0)
__device__ __forceinline__ int crow(int r, int hi) { return (r & 3) + 8 * (r >> 2) + 4 * hi; }
__device__ __forceinline__ unsigned cvtpk(float lo, float hi) { unsigned r; asm volatile("v_cvt_pk_bf16_f32 %0, %1, %2" : "=v"(r) : "v"(lo), "v"(hi)); return r; }

__device__ __forceinline__ void partialSM(f32x16& p0, f32x16& p1, float& m_reg, float& mn, float& alpha) {
  constexpr float C = SCALE * 1.4426950408889634f;
  float pmax = p0[0];
#pragma unroll
  for (int r = 1; r < 16; ++r) pmax = fmaxf(pmax, p0[r]);
#pragma unroll
  for (int r = 0; r < 16; ++r) pmax = fmaxf(pmax, p1[r]);
  { auto rr = __builtin_amdgcn_permlane32_swap(__float_as_uint(pmax), __float_as_uint(pmax), false, false);
    pmax = fmaxf(__uint_as_float(rr[0]), __uint_as_float(rr[1])); }
  if (__builtin_expect(__all(pmax - m_reg <= THR / SCALE), 1)) { mn = m_reg; alpha = 1.f; }
  else { mn = fmaxf(m_reg, pmax); alpha = __builtin_amdgcn_exp2f((m_reg - mn) * C); m_reg = mn; }
  float mnC = -mn * C;
#pragma unroll
  for (int r = 0; r < 16; ++r) p0[r] = fmaf(p0[r], C, mnC);
#pragma unroll
  for (int r = 0; r < 16; ++r) p1[r] = fmaf(p1[r], C, mnC);
#pragma unroll
  for (int r = 0; r < 16; ++r) p0[r] = __builtin_amdgcn_exp2f(p0[r]);
}
__device__ __forceinline__ void finishSM(f32x16& p0, f32x16& p1, float alpha, float& l_reg, bf16x8& pa0, bf16x8& pa1, bf16x8& pa2, bf16x8& pa3) {
#pragma unroll
  for (int r = 0; r < 16; ++r) p1[r] = __builtin_amdgcn_exp2f(p1[r]);
  float ps = 0;
#pragma unroll
  for (int r = 0; r < 16; ++r) ps += p0[r];
#pragma unroll
  for (int r = 0; r < 16; ++r) ps += p1[r];
  { auto rr = __builtin_amdgcn_permlane32_swap(__float_as_uint(ps), __float_as_uint(ps), false, false);
    ps = __uint_as_float(rr[0]) + __uint_as_float(rr[1]); }
  l_reg = l_reg * alpha + ps;
#define PK4(P, BASE, OUT) do { unsigned a0 = cvtpk(P[BASE + 0], P[BASE + 1]), a1 = cvtpk(P[BASE + 2], P[BASE + 3]);   \
    unsigned b0 = cvtpk(P[BASE + 4], P[BASE + 5]), b1 = cvtpk(P[BASE + 6], P[BASE + 7]);                              \
    auto r0 = __builtin_amdgcn_permlane32_swap(a0, b0, false, false); auto r1 = __builtin_amdgcn_permlane32_swap(a1, b1, false, false); \
    u32x4 w = {r0[0], r1[0], r0[1], r1[1]}; OUT = *reinterpret_cast<bf16x8*>(&w); } while (0)
  PK4(p0, 0, pa0); PK4(p0, 8, pa1); PK4(p1, 0, pa2); PK4(p1, 8, pa3);
#undef PK4
}
__device__ __forceinline__ void qkt(f32x16& p0, f32x16& p1, const bf16* Ks, const bf16x8* qr, int r32, int hi) {
  p0 = f32x16{}; p1 = f32x16{};
#pragma unroll
  for (int d0 = 0; d0 < 8; ++d0) { int cb = (d0 * 16 + hi * 8) * 2;
    bf16x8 b0 = *reinterpret_cast<const bf16x8*>((const char*)Ks + KSWZ(r32, cb));
    bf16x8 b1 = *reinterpret_cast<const bf16x8*>((const char*)Ks + KSWZ(32 + r32, cb));
    p0 = __builtin_amdgcn_mfma_f32_32x32x16_bf16(b0, qr[d0], p0, 0, 0, 0);
    p1 = __builtin_amdgcn_mfma_f32_32x32x16_bf16(b1, qr[d0], p1, 0, 0, 0); }
}
__device__ __forceinline__ int v_st(int k, int c) { const int kk = (k & ~0xC) | ((k & 4) << 1) | ((k & 8) >> 1); return ((kk >> 3) * 4 + (c >> 5)) * 512 + ((kk & 7) * 32 + (c & 31)) * 2; }
__device__ __forceinline__ int v_rd_base(int lane) { return ((lane & 3) << 3) | (((lane >> 2) & 3) << 6) | (((lane >> 4) & 1) << 5) | (((lane >> 5) & 1) << 8); }
constexpr int v_rd_off(int d0, int ks, int half) { return d0 * 512 + ks * 4096 + half * 2048; }
template <int OFF> __device__ __forceinline__ s16x4 tr_read(int vb) {
  s16x4 r; asm volatile("ds_read_b64_tr_b16 %0, %1 offset:%2" : "=&v"(r) : "v"(vb), "i"(OFF) : "memory"); return r;
}
template <int D0> __device__ __forceinline__ void pv_one(f32x16& od, int vb, bf16x8 pa0, bf16x8 pa1, bf16x8 pa2, bf16x8 pa3) {
  const s16x4 l0 = tr_read<v_rd_off(D0, 0, 0)>(vb), h0 = tr_read<v_rd_off(D0, 0, 1)>(vb), l1 = tr_read<v_rd_off(D0, 1, 0)>(vb), h1 = tr_read<v_rd_off(D0, 1, 1)>(vb);
  const s16x4 l2 = tr_read<v_rd_off(D0, 2, 0)>(vb), h2 = tr_read<v_rd_off(D0, 2, 1)>(vb), l3 = tr_read<v_rd_off(D0, 3, 0)>(vb), h3 = tr_read<v_rd_off(D0, 3, 1)>(vb);
  asm volatile("s_waitcnt lgkmcnt(0)" ::: "memory"); SBAR();
#define PK(L, H) (bf16x8){L[0], L[1], L[2], L[3], H[0], H[1], H[2], H[3]}
  od = __builtin_amdgcn_mfma_f32_32x32x16_bf16(pa0, PK(l0, h0), od, 0, 0, 0);
  od = __builtin_amdgcn_mfma_f32_32x32x16_bf16(pa1, PK(l1, h1), od, 0, 0, 0);
  od = __builtin_amdgcn_mfma_f32_32x32x16_bf16(pa2, PK(l2, h2), od, 0, 0, 0);
  od = __builtin_amdgcn_mfma_f32_32x32x16_bf16(pa3, PK(l3, h3), od, 0, 0, 0);
#undef PK
}
__device__ __forceinline__ void pv_d0(f32x16* o, int vb, bf16x8 pa0, bf16x8 pa1, bf16x8 pa2, bf16x8 pa3) {
  pv_one<0>(o[0], vb, pa0, pa1, pa2, pa3); pv_one<1>(o[1], vb, pa0, pa1, pa2, pa3); pv_one<2>(o[2], vb, pa0, pa1, pa2, pa3); pv_one<3>(o[3], vb, pa0, pa1, pa2, pa3);
}

template <class Mask>
__device__ __forceinline__ void attn_body(const bf16* __restrict__ Qw, int ldq, const bf16* __restrict__ Kh, const bf16* __restrict__ Vh, int ldk,
                                          bf16* __restrict__ Ow, int ldo, bool active, int NT, char* lds, const Mask& Mk, int tid) {
  const int wid = tid >> 6, lane = tid & 63, r32 = lane & 31, hi = lane >> 5;
  bf16* V_lds = (bf16*)lds; bf16* K_lds = (bf16*)(lds + 2 * SHM_V);
  float* ws = (float*)(lds + 2 * SHM_V + 2 * SHM_K) + wid * 64; float* li_l = ws; float* al_l = ws + 32;
  float m_reg = -1e30f, l_reg = 0; f32x16 o[4] = {}; bf16x8 qr[8];
  const bf16* Qp = Qw + (long)r32 * ldq + hi * 8;
#pragma unroll
  for (int d0 = 0; d0 < 8; ++d0) qr[d0] = *reinterpret_cast<const bf16x8*>(Qp + d0 * 16);
  const int sr = tid >> 4, sc = (tid & 15) * 8, vst0 = v_st(sr, sc), vst1 = v_st(32 + sr, sc);
  const int vb0 = (int)(uintptr_t)V_lds + v_rd_base(lane);
  struct { bf16x8 vs0, vs1, ks0, ks1; } sr_[1];
#define SLOAD(i, k0) do { sr_[i].vs0 = *reinterpret_cast<const bf16x8*>(&Vh[(long)((k0) + sr) * ldk + sc]); sr_[i].vs1 = *reinterpret_cast<const bf16x8*>(&Vh[(long)((k0) + 32 + sr) * ldk + sc]); \
    sr_[i].ks0 = *reinterpret_cast<const bf16x8*>(&Kh[(long)((k0) + sr) * ldk + sc]); sr_[i].ks1 = *reinterpret_cast<const bf16x8*>(&Kh[(long)((k0) + 32 + sr) * ldk + sc]); } while (0)
#define SWRITE(b, i) do { *(bf16x8*)((char*)V_lds + (b) * SHM_V + vst0) = sr_[i].vs0;          \
    *(bf16x8*)((char*)V_lds + (b) * SHM_V + vst1) = sr_[i].vs1; int kc = sc * 2;               \
    *(bf16x8*)((char*)K_lds + (b) * SHM_K + KSWZ(sr, kc)) = sr_[i].ks0;                       \
    *(bf16x8*)((char*)K_lds + (b) * SHM_K + KSWZ(32 + sr, kc)) = sr_[i].ks1; } while (0)
#define SWAIT() asm volatile("s_waitcnt vmcnt(0)" ::: "memory")
#define RESC(a) do { if (__any((a) < 1.f)) { if (hi == 0) al_l[r32] = (a); asm volatile("s_waitcnt lgkmcnt(0)" ::: "memory"); \
    _Pragma("unroll") for (int d = 0; d < 4; ++d) _Pragma("unroll") for (int r = 0; r < 16; ++r) o[d][r] *= al_l[crow(r, hi)]; } } while (0)
  f32x16 pA0, pA1, pB0, pB1; float mnA, mnB, alA, alB; bf16x8 pa0, pa1, pa2, pa3;
  constexpr int SE = 0, SO = 0;
  SLOAD(SE, 0); asm volatile("s_waitcnt vmcnt(0)" ::: "memory"); SWRITE(0, SE); __syncthreads();
  qkt(pA0, pA1, K_lds, qr, r32, hi); Mk.apply(pA0, pA1, 0, r32, hi); partialSM(pA0, pA1, m_reg, mnA, alA);
  SLOAD(SO, KVBLK);
  SWAIT(); SWRITE(1, SO); __syncthreads();
  for (int j = 1; j + 1 < NT; j += 2) {
    SBAR(); qkt(pB0, pB1, (bf16*)((char*)K_lds + SHM_K), qr, r32, hi); Mk.apply(pB0, pB1, j, r32, hi);
    finishSM(pA0, pA1, alA, l_reg, pa0, pa1, pa2, pa3); SBAR();
    SLOAD(SO, (j + 1) * KVBLK); SBAR();
    pv_d0(o, vb0, pa0, pa1, pa2, pa3); partialSM(pB0, pB1, m_reg, mnB, alB);
    __syncthreads(); SWAIT(); SWRITE(0, SE);
    RESC(alB); __syncthreads();
    SBAR(); qkt(pA0, pA1, K_lds, qr, r32, hi); Mk.apply(pA0, pA1, j + 1, r32, hi);
    finishSM(pB0, pB1, alB, l_reg, pa0, pa1, pa2, pa3); SBAR();
    SLOAD(SE, (j + 2) * KVBLK); SBAR();
    pv_d0(o, vb0 + (int)SHM_V, pa0, pa1, pa2, pa3); partialSM(pA0, pA1, m_reg, mnA, alA);
    __syncthreads(); SWAIT(); SWRITE(1, SO);
    RESC(alA); __syncthreads();
  }
  SBAR(); qkt(pB0, pB1, (bf16*)((char*)K_lds + SHM_K), qr, r32, hi); Mk.apply(pB0, pB1, NT - 1, r32, hi);
  finishSM(pA0, pA1, alA, l_reg, pa0, pa1, pa2, pa3); SBAR();
  pv_d0(o, vb0, pa0, pa1, pa2, pa3); partialSM(pB0, pB1, m_reg, mnB, alB);
  __syncthreads(); RESC(alB);
  finishSM(pB0, pB1, alB, l_reg, pa0, pa1, pa2, pa3); SBAR();
  pv_d0(o, vb0 + (int)SHM_V, pa0, pa1, pa2, pa3);
  if (hi == 0) li_l[r32] = l_reg; asm volatile("s_waitcnt lgkmcnt(0)" ::: "memory");
  float rli[16];
#pragma unroll
  for (int r = 0; r < 16; ++r) rli[r] = __builtin_amdgcn_rcpf(li_l[crow(r, hi)]);
  if (active) {
    bf16* Ob = Ow + r32; int hi_e = hi; asm volatile("" : "+v"(Ob), "+v"(hi_e));
#pragma unroll
    for (int r = 0; r < 16; ++r) { const int orow = crow(r, hi_e);
#pragma unroll
      for (int d0 = 0; d0 < 4; ++d0) { const float v = o[d0][r] * rli[r]; Ob[(long)orow * ldo + d0 * 32] = (bf16)(cvtpk(v, v) & 0xffffu); } }
  }
  __syncthreads();
#undef SLOAD
#undef SWRITE
#undef SWAIT
#undef RESC
}

struct MaskAPrompt {
  const float* bias;
  int qc, kc0, qoff;
  __device__ __forceinline__ void apply(f32x16& p0, f32x16& p1, int j, int r32, int hi) const {
    const int dc = qc - (kc0 + j);
    if (dc < 0 || dc > 8) {
#pragma unroll
      for (int r = 0; r < 16; ++r) { p0[r] = -INFINITY; p1[r] = -INFINITY; }
    } else if (dc >= 3) { const float b = bias[256];
#pragma unroll
      for (int r = 0; r < 16; ++r) { p0[r] += b; p1[r] += b; }
    } else { int base = dc * 64 + qoff + r32 + 128; asm volatile("" : "+v"(base));
#pragma unroll
      for (int r = 0; r < 16; ++r) { const int i0 = base - crow(r, hi), i1 = i0 - 32;
        p0[r] += bias[min(max(i0, 0), 256)]; p1[r] += bias[min(max(i1, 0), 256)]; }
    }
  }
};
struct MaskASample {
  const float* bias;
  __device__ __forceinline__ void apply(f32x16& p0, f32x16& p1, int j, int r32, int hi) const {
    int base = 512 + r32 + 128 - 64 * j; asm volatile("" : "+v"(base));
#pragma unroll
    for (int r = 0; r < 16; ++r) { const int k0 = crow(r, hi), i0 = base - k0, i1 = i0 - 32;
      p0[r] = (64 * j + k0 < 544) ? p0[r] + bias[min(max(i0, 0), 256)] : -INFINITY;
      p1[r] = (64 * j + 32 + k0 < 544) ? p1[r] + bias[min(max(i1, 0), 256)] : -INFINITY; }
  }
};
struct MaskBits {
  const unsigned* mrow;
  __device__ __forceinline__ void apply(f32x16& p0, f32x16& p1, int j, int r32, int hi) const {
    const unsigned w0 = mrow[2 * j], w1 = mrow[2 * j + 1];
#pragma unroll
    for (int r = 0; r < 16; ++r) { const int k0 = crow(r, hi);
      p0[r] = ((w0 >> k0) & 1u) ? p0[r] : -INFINITY; p1[r] = ((w1 >> k0) & 1u) ? p1[r] : -INFINITY; }
  }
};
#undef KSWZ
#undef SBAR
}

struct Args { const float* in[N_IN]; float* out; unsigned char* ws; int ph_lo, ph_hi; };
typedef const __attribute__((address_space(4))) Args* KArgs;
__device__ __forceinline__ KArgs kargs() { KArgs k = (KArgs)__builtin_amdgcn_kernarg_segment_ptr(); asm volatile("" : "+s"(k)); return k; }
struct Frame {
    LAS unsigned char* lds;
    int tid, lane, wave, G, vcu;
};
__device__ __forceinline__ Frame relaunder(Frame F) { int l = __builtin_amdgcn_mbcnt_hi(~0u, __builtin_amdgcn_mbcnt_lo(~0u, 0u)); asm volatile("" : "+v"(l)); F.lane = l; F.tid = F.wave * 64 + l; return F; }
__device__ __forceinline__ int launder_s(int x) { asm volatile("" : "+s"(x)); return x; }
#ifndef EXP_WJ
#define EXP_WJ j
#endif
#ifndef EXP_S0MUL
#define EXP_S0MUL
#endif
#ifndef PROBE_SCALE
#define PROBE_SCALE 1.0f
#endif

__device__ __forceinline__ void transpose_item(const float* __restrict__ W, int K, int N, bf16* __restrict__ WT, LAS float* scr, int item, int nblk, int lane) {
    const int kb = item / nblk, nb = item - kb * nblk, k0 = 64 * kb, n0 = 32 * nb;
    const int kr = lane >> 3, nq = (lane & 7) * 4; const bool ok = n0 + nq < N;
    f32x4 v[8];
#pragma unroll
    for (int i = 0; i < 8; ++i) v[i] = ok ? *(const f32x4*)(W + (size_t)(k0 + 8 * i + kr) * N + n0 + nq) : (f32x4){0.f, 0.f, 0.f, 0.f};
#pragma unroll
    for (int i = 0; i < 8; ++i) { LAS float* d = scr + (8 * i + kr) * 33 + nq; d[0] = v[i][0]; d[1] = v[i][1]; d[2] = v[i][2]; d[3] = v[i][3]; }
    LDS_WAIT(); asm volatile("" ::: "memory");
    const int c = lane & 7;
#pragma unroll
    for (int j = 0; j < 4; ++j) { const int nn = (lane >> 3) + 8 * j; const LAS float* s = scr + (8 * c) * 33 + nn;
        v4u o; o.x = pk2(s[0 * 33], s[1 * 33]); o.y = pk2(s[2 * 33], s[3 * 33]); o.z = pk2(s[4 * 33], s[5 * 33]); o.w = pk2(s[6 * 33], s[7 * 33]);
        *(v4u*)(WT + (size_t)(n0 + nn) * K + k0 + 8 * c) = o; }
    LDS_WAIT(); asm volatile("" ::: "memory");
}
__device__ __forceinline__ void cvt_rows(const Frame& F0, const float* __restrict__ src, bf16* __restrict__ dst, size_t n8) {
    const Frame F = relaunder(F0);
    for (size_t i = (size_t)blockIdx.x * NTHR + F.tid; i < n8; i += (size_t)F.G * NTHR) {
        const f32x4 a = *(const f32x4*)(src + i * 8), b = *(const f32x4*)(src + i * 8 + 4); store8_bf16(dst + i * 8, a, b); }
}
__device__ __forceinline__ void copy_f32(const Frame& F0, const float* __restrict__ src, float* __restrict__ dst, size_t n4) {
    const Frame F = relaunder(F0);
    for (size_t i = (size_t)blockIdx.x * NTHR + F.tid; i < n4; i += (size_t)F.G * NTHR) *(f32x4*)(dst + i * 4) = *(const f32x4*)(src + i * 4);
}
__device__ __forceinline__ void cat_rows(const Frame& F0, const float* __restrict__ src, bf16* __restrict__ dst, int nb, int rows, int w, int dst_rows, int zero_lo, const int rank, const int nblk) {
    if (rank < 0) return;
    const Frame F = relaunder(F0);
    const int w8 = w / 8; const size_t per_b = (size_t)rows * w8, n = per_b * nb;
    for (size_t i = (size_t)rank * NTHR + F.tid; i < n; i += (size_t)nblk * NTHR) {
        const size_t b = i / per_b, r = i - b * per_b;
        const f32x4 x = *(const f32x4*)(src + i * 8), y = *(const f32x4*)(src + i * 8 + 4); store8_bf16(dst + (b * dst_rows) * w + r * 8, x, y); }
    const size_t zper = (size_t)(dst_rows - zero_lo) * w8, zn = zper * nb;
    unsigned z0 = 0u; asm volatile("" : "+v"(z0)); const v4u zz = {z0, z0, z0, z0};
    for (size_t i = (size_t)rank * NTHR + F.tid; i < zn; i += (size_t)nblk * NTHR) {
        const size_t b = i / zper, r = i - b * zper; *(v4u*)(dst + (b * dst_rows + zero_lo) * w + r * 8) = zz; }
}

template <bool DEFERRED> __device__ __forceinline__ void convert_weights(const Frame& F, KArgs a, const int gw, const int NGW, const int lo = 0, const int hi = 1 << 30) {
    LAS float* scr = (LAS float*)(F.lds + F.wave * 16384);
    unsigned char* ws = a->ws;
    constexpr int I_AIN = 32 * 192, I_AOUT = 32 * 64, I_BIN = 32 * (B_NP / 32), I_BOUT = 32 * 64, I_CIN = 32 * (C_NP / 32), I_COUT = 64 * 64, I_M1 = 32 * 256, I_M2 = 128 * 64;
    if constexpr (!DEFERRED) {
        constexpr int NITEMS = I_AIN + I_AOUT + I_BIN + I_BOUT + I_CIN + 2 * I_M1 + 2 * I_M2;
        for (int it = gw; it < NITEMS; it += NGW) {
            int r = it;
            if (r < I_AIN) { transpose_item(a->in[I_AWIN], DM, A_N, (bf16*)(ws + WS_WA_IN), scr, r, 192, F.lane); continue; } r -= I_AIN;
            if (r < I_AOUT) { transpose_item(a->in[I_AWOUT], DM, DM, (bf16*)(ws + WS_WA_OUT), scr, r, 64, F.lane); continue; } r -= I_AOUT;
            if (r < I_BIN) { transpose_item(a->in[I_BWIN], DM, B_N, (bf16*)(ws + WS_WB_IN), scr, r, B_NP / 32, F.lane); continue; } r -= I_BIN;
            if (r < I_BOUT) { transpose_item(a->in[I_BWOUT], DM, DM, (bf16*)(ws + WS_WB_OUT), scr, r, 64, F.lane); continue; } r -= I_BOUT;
            if (r < I_CIN) { transpose_item(a->in[I_CWIN], DM, C_N, (bf16*)(ws + WS_WC_IN), scr, r, C_NP / 32, F.lane); continue; } r -= I_CIN;
            if (r < 2 * I_M1) { const int j = r / I_M1; r -= j * I_M1; transpose_item(a->in[I_W1] + (size_t)j * DM * DFF, DM, DFF, (bf16*)(ws + WS_W1) + (size_t)j * DFF * DM, scr, r, 256, F.lane); continue; } r -= 2 * I_M1;
            { const int j = r / I_M2; r -= j * I_M2; transpose_item(a->in[I_W2] + (size_t)j * DFF * DM, DFF, DM, (bf16*)(ws + WS_W2) + (size_t)j * DM * DFF, scr, r, 64, F.lane); }
        }
    } else {
        constexpr int NITEMS = I_COUT + I_AIN + I_AOUT + 2 * I_M1 + 2 * I_M2;
        for (int it = lo + gw; it < (hi < NITEMS ? hi : NITEMS); it += NGW) {
            int r = it;
            if (r < I_COUT) { transpose_item(a->in[I_CWOUT], C_VD, DM, (bf16*)(ws + WS_WC_OUT), scr, r, 64, F.lane); continue; } r -= I_COUT;
            if (r < I_AIN) { transpose_item(a->in[I_AWIN] + (size_t)DM * A_N, DM, A_N, (bf16*)(ws + WS_WA_IN) + (size_t)A_N * DM, scr, r, 192, F.lane); continue; } r -= I_AIN;
            if (r < I_AOUT) { transpose_item(a->in[I_AWOUT] + (size_t)DM * DM, DM, DM, (bf16*)(ws + WS_WA_OUT) + (size_t)DM * DM, scr, r, 64, F.lane); continue; } r -= I_AOUT;
            if (r < 2 * I_M1) { const int j = 2 + r / I_M1; r -= (j - 2) * I_M1; transpose_item(a->in[I_W1] + (size_t)j * DM * DFF, DM, DFF, (bf16*)(ws + WS_W1) + (size_t)j * DFF * DM, scr, r, 256, F.lane); continue; } r -= 2 * I_M1;
            { const int j = 2 + r / I_M2; r -= (j - 2) * I_M2; transpose_item(a->in[I_W2] + (size_t)j * DFF * DM, DFF, DM, (bf16*)(ws + WS_W2) + (size_t)j * DM * DFF, scr, r, 64, F.lane); }
        }
    }
}
__device__ __forceinline__ void p0_prologue(const Frame& F0, KArgs a) {
    const Frame F = relaunder(F0);
    unsigned char* ws = a->ws;
    convert_weights<false>(F, a, blockIdx.x * NWAVES + F.wave, F.G * NWAVES);
    cvt_rows(F, a->in[I_XP], (bf16*)(ws + WS_XN), (size_t)NP * DM / 8);
    cvt_rows(F, a->in[I_XS], (bf16*)(ws + WS_XN) + (size_t)NP * DM, (size_t)NS * DM / 8);
#ifdef TEST_IN8
    if (blockIdx.x == 0 && F.tid == 0) { const float* p = a->in[I_SCS]; ((float*)(ws + WS_SIDE))[0] = p[0] + p[TEST_IN8]; }
#endif
}

struct FnAqkv {
    bf16* qkv; float* out; bf16* catk; bf16* catv; int j;
    __device__ __forceinline__ void operator()(int row, int col, f32x4 v0, f32x4 v1, const pg8::Unit& u) const {
        store8_bf16(qkv + (size_t)row * A_N + col, v0, v1);
        if (u.pn >= 8) {
            const bool isV = u.pn >= 16; const int c = col - (isV ? 4096 : 2048);
            if (u.pm >= 32) {
                const int r = row - NP;
                store8_f32(out + (isV ? O_AVS : O_AKS) + ((size_t)j * 512 + r) * 2048 + c, v0, v1);
                store8_bf16((isV ? catv : catk) + ((size_t)(r >> 5) * A_CATROWS + 512 + (r & 31)) * 2048 + c, v0, v1);
            } else if ((u.pm & 15) >= 14) {
                const int b = u.pm >> 4, tp = (row & 4095) - 3584;
                store8_f32(out + (isV ? O_AVP : O_AKP) + (((size_t)j * 2 + b) * 512 + tp) * 2048 + c, v0, v1);
            }
        }
    }
};
struct FnMix {
    float* mix; float* part;
    __device__ __forceinline__ void operator()(int row, int col, f32x4 v0, f32x4 v1, const pg8::Unit& u) const {
        if (u.pm >= 32) store8_bf16((bf16*)part + ((size_t)u.ks * NS + (row - NP)) * DM + col, v0, v1);
        else store8_bf16((bf16*)mix + (size_t)row * DM + col, v0, v1);
    }
};
struct FnRelu2 {
    bf16* h;
    __device__ __forceinline__ void operator()(int row, int col, f32x4 v0, f32x4 v1, const pg8::Unit&) const {
#pragma unroll
        for (int i = 0; i < 4; ++i) { const float a = fmaxf(v0[i], 0.f), b = fmaxf(v1[i], 0.f); v0[i] = a * a; v1[i] = b * b; }
        store8_bf16(h + (size_t)row * DFF + col, v0, v1);
    }
};
struct FnBproj {
    bf16* big; float* out; float* wi; bf16* catk; bf16* catv; bf16* cati;
    __device__ __forceinline__ void operator()(int row, int col, f32x4 v0, f32x4 v1, const pg8::Unit& u) const {
        store8_bf16(big + (size_t)row * B_NP + col, v0, v1);
        const bool smp = u.pm >= 32; const int r = row - NP;
        if (u.pn >= 8 && u.pn < 12) {
            const bool isV = u.pn >= 10; const int c = col - (isV ? 2560 : 2048);
            if (smp) { store8_f32(out + (isV ? O_BVS : O_BKS) + (size_t)r * 512 + c, v0 * PROBE_SCALE, v1 * PROBE_SCALE);
                       store8_bf16((isV ? catv : catk) + ((size_t)(r >> 5) * B_CATROWS + 1024 + (r & 31)) * 512 + c, v0, v1); }
            else store8_f32(out + (isV ? O_BVP : O_BKP) + (size_t)row * 512 + c, v0 * PROBE_SCALE, v1 * PROBE_SCALE);
        } else if (u.pn == 16) {
            const int c = col - 4096;
            if (c < 64) {
                if (smp) { store8_f32(out + O_BIS + (size_t)r * 64 + c, v0 * PROBE_SCALE, v1 * PROBE_SCALE);
                           store8_bf16(cati + ((size_t)(r >> 5) * B_CATROWS + 1024 + (r & 31)) * 64 + c, v0, v1); }
                else store8_f32(out + O_BIP + (size_t)row * 64 + c, v0 * PROBE_SCALE, v1 * PROBE_SCALE);
            } else if (c < 80) store8_f32(wi + (size_t)row * 16 + (c - 64), v0, v1);
        }
    }
};

struct FnCproj {
    bf16* big; float* out; float* side;
    __device__ __forceinline__ void operator()(int row, int col, f32x4 v0, f32x4 v1, const pg8::Unit& u) const {
        if (col < 12288) {
            store8_bf16(big + (size_t)row * C_NP + col, v0, v1);
            if (col < 8192) {
                if (u.pm >= 32) { const int r = row - NP, s = r & 31; if (s >= 29) store8_f32(out + O_CCS + ((size_t)(r >> 5) * 3 + (s - 29)) * 8192 + col, v0, v1); }
                else { const int t = row & 4095; if (t >= 4093) store8_f32(out + O_CCP + ((size_t)(row >> 12) * 3 + (t - 4093)) * 8192 + col, v0, v1); }
            }
        } else if (col < 12352) store8_f32(side + (size_t)row * 64 + (col - 12288), v0, v1);
    }
};

__device__ __forceinline__ void ln_phase(const Frame& F0, const float* __restrict__ xin_p, const float* __restrict__ xin_s, const bool x_f32, const float* __restrict__ mix, const float* __restrict__ part,
                                         const float* __restrict__ g, const float* __restrict__ bb, float* __restrict__ yout  , bf16* __restrict__ xn) {
    const Frame F = relaunder(F0);
    const int gw = blockIdx.x * NWAVES + F.wave, NGW = F.G * NWAVES;
    for (int row = gw; row < NTOK; row += NGW) {
        const float* xr = row < NP ? xin_p + (size_t)row * DM : xin_s + (size_t)(row - NP) * DM;
        f32x4 v[8]; float s = 0.f;
#pragma unroll
        for (int i = 0; i < 8; ++i) { const int c = (i * 64 + F.lane) * 4; f32x4 x, m;
            if (x_f32) x = *(const f32x4*)(xr + c);
            else { const v2u xb = *(const v2u*)(xn + (size_t)row * DM + c); x = (f32x4){__uint_as_float(xb.x << 16), __uint_as_float(xb.x & 0xffff0000u), __uint_as_float(xb.y << 16), __uint_as_float(xb.y & 0xffff0000u)}; }
            if (row < NP) { const v2u mb = *(const v2u*)((const bf16*)mix + (size_t)row * DM + c); m = (f32x4){__uint_as_float(mb.x << 16), __uint_as_float(mb.x & 0xffff0000u), __uint_as_float(mb.y << 16), __uint_as_float(mb.y & 0xffff0000u)}; }
            else { const bf16* pr = (const bf16*)part + (size_t)(row - NP) * DM + c; m = (f32x4){0.f, 0.f, 0.f, 0.f};
#pragma unroll
                for (int sl = 0; sl < 16; ++sl) { const v2u pb = *(const v2u*)(pr + (size_t)sl * NS * DM); m += (f32x4){__uint_as_float(pb.x << 16), __uint_as_float(pb.x & 0xffff0000u), __uint_as_float(pb.y << 16), __uint_as_float(pb.y & 0xffff0000u)}; } }
            v[i] = x * ALPHA + m; s += (v[i][0] + v[i][1]) + (v[i][2] + v[i][3]); }
        const float mean = wave_sum(s) * (1.f / DM); float q = 0.f;
#pragma unroll
        for (int i = 0; i < 8; ++i) { v[i] = v[i] - mean; q += (v[i][0] * v[i][0] + v[i][1] * v[i][1]) + (v[i][2] * v[i][2] + v[i][3] * v[i][3]); }
        const float rstd = 1.f / sqrtf(wave_sum(q) * (1.f / DM) + LN_EPS);
#pragma unroll
        for (int i = 0; i < 8; ++i) { const int c = (i * 64 + F.lane) * 4; const f32x4 gg = *(const f32x4*)(g + c), be = *(const f32x4*)(bb + c);
            const f32x4 y = v[i] * rstd * gg + be; if (yout) *(f32x4*)(yout + (size_t)row * DM + c) = y;
            v2u w; w.x = pk2(y[0], y[1]); w.y = pk2(y[2], y[3]); *(v2u*)(xn + (size_t)row * DM + c) = w; }
    }
}

__device__ __forceinline__ void attn_a_phase(const Frame& F0, unsigned char* ws, const float* __restrict__ rel_bias  ) {
    char* lds = (char*)F0.lds;
    float* bias_l = (float*)(lds + att::SHM_BIAS);
    const bf16* qkv = (const bf16*)(ws + WS_BIG); bf16* ao = (bf16*)(ws + WS_ATT);
    for (int u = blockIdx.x; u < 512; u += F0.G) {
        const Frame F = relaunder(F0);
        const int c4 = u & 15, h = (u >> 4) & 15, b = u >> 8, c0 = 4 * c4, kc0 = c0 >= 8 ? c0 - 8 : 0, NT = c0 + 4 - kc0;
        if (F.tid < 257) bias_l[F.tid] = rel_bias[h * 257 + F.tid] * (1.0f / att::SCALE);
        const size_t qrow = (size_t)b * SEQ + c0 * 64 + F.wave * 32;
        att::MaskAPrompt Mk{bias_l, c0 + (F.wave >> 1), kc0, (F.wave & 1) * 32};
        att::attn_body(qkv + qrow * A_N + h * 128, A_N, qkv + ((size_t)b * SEQ + kc0 * 64) * A_N + 2048 + h * 128, qkv + ((size_t)b * SEQ + kc0 * 64) * A_N + 4096 + h * 128, A_N,
                       ao + qrow * DM + h * 128, DM, true, NT, lds, Mk, F.tid);
    }
    for (int u = blockIdx.x; u < 256; u += F0.G) {
        const Frame F = relaunder(F0);
        const int h = u & 15, b = u >> 4;
        if (F.tid < 257) bias_l[F.tid] = rel_bias[h * 257 + F.tid] * (1.0f / att::SCALE);
        const size_t qrow = (size_t)NP + b * 32;
        att::MaskASample Mk{bias_l};
        att::attn_body(qkv + qrow * A_N + h * 128, A_N, (const bf16*)(ws + SA_CATK) + (size_t)b * A_CATROWS * 2048 + h * 128, (const bf16*)(ws + SA_CATV) + (size_t)b * A_CATROWS * 2048 + h * 128, 2048,
                       ao + qrow * DM + h * 128, DM, F.wave == 0, 10, lds, Mk, F.tid);
    }
}


typedef float f32x4m __attribute__((ext_vector_type(4)));
__device__ __forceinline__ unsigned fkey(float f) { const unsigned u = __float_as_uint(f); return (u & 0x80000000u) ? ~u : (u | 0x80000000u); }

__device__ __forceinline__ void idx_score_row(const bf16* __restrict__ qi  , const float* __restrict__ wi  , const bf16* __restrict__ kbase, int ldki, int ngrp,
                                              float* __restrict__ srow, int lane) {
    const int c = lane & 15, g = lane >> 4;
    const bf16x8 a0 = *(const bf16x8*)(qi + c * 64 + 8 * g), a1 = *(const bf16x8*)(qi + c * 64 + 32 + 8 * g);
    float w[4];
#pragma unroll
    for (int i = 0; i < 4; ++i) w[i] = wi[4 * g + i] * (0.25f * 0.125f);
    for (int gi = 0; gi < ngrp; ++gi) {
        float p[4];
#pragma unroll
        for (int t = 0; t < 4; ++t) {
            const bf16* kr = kbase + (size_t)(gi * 64 + t * 16 + c) * ldki + 8 * g;
            const bf16x8 b0 = *(const bf16x8*)kr, b1 = *(const bf16x8*)(kr + 32);
            f32x4m d = {0.f, 0.f, 0.f, 0.f};
            d = __builtin_amdgcn_mfma_f32_16x16x32_bf16(a0, b0, d, 0, 0, 0);
            d = __builtin_amdgcn_mfma_f32_16x16x32_bf16(a1, b1, d, 0, 0, 0);
            float s = w[0] * fmaxf(d[0], 0.f); s = fmaf(w[1], fmaxf(d[1], 0.f), s); s = fmaf(w[2], fmaxf(d[2], 0.f), s); s = fmaf(w[3], fmaxf(d[3], 0.f), s);
            s += __shfl_xor(s, 16); s += __shfl_xor(s, 32);
            p[t] = s;
        }
        const float mine = g == 0 ? p[0] : g == 1 ? p[1] : g == 2 ? p[2] : p[3];
        srow[gi * 64 + lane] = mine;
    }
}

__device__ __forceinline__ int wave_sum_i(int v) {
    { auto r = __builtin_amdgcn_permlane32_swap((unsigned)v, (unsigned)v, false, false); v = (int)r[0] + (int)r[1]; }
    { auto r = __builtin_amdgcn_permlane16_swap((unsigned)v, (unsigned)v, false, false); v = (int)r[0] + (int)r[1]; }
    v += __builtin_amdgcn_update_dpp(0, v, 0x128, 0xf, 0xf, false);
    v += __builtin_amdgcn_update_dpp(0, v, 0x124, 0xf, 0xf, false);
    v += __builtin_amdgcn_update_dpp(0, v, 0x122, 0xf, 0xf, false);
    v += __builtin_amdgcn_update_dpp(0, v, 0x121, 0xf, 0xf, false);
    return __builtin_amdgcn_readfirstlane(v);
}
__device__ __forceinline__ void idx_select_row(const float* __restrict__ srow, int L, unsigned* __restrict__ mrow, int nwords, int lane) {
    const int nj = (L + 63) >> 6;
    if (L <= 256) {
        for (int wd = lane; wd < nwords; wd += 64) { const int lo = wd * 32; mrow[wd] = (lo + 32 <= L) ? 0xffffffffu : (lo >= L ? 0u : ((1u << (L - lo)) - 1u)); }
        return;
    }
    unsigned key[64];
#pragma unroll
    for (int jb = 0; jb < 64; jb += 16) {
        if (jb < nj) {
            float sv[16];
#pragma unroll
            for (int j = 0; j < 16; ++j) { const int idx = (jb + j) * 64 + lane; sv[j] = __hip_atomic_load(srow + (idx < L ? idx : 0), __ATOMIC_RELAXED, __HIP_MEMORY_SCOPE_AGENT); }
#pragma unroll
            for (int j = 0; j < 16; ++j) { const int idx = (jb + j) * 64 + lane; key[jb + j] = idx < L ? fkey(sv[j]) : 0u; }
        } else {
#pragma unroll
            for (int j = 0; j < 16; ++j) key[jb + j] = 0u;
        }
    }
    unsigned T = 0u;
    for (int bit = 31; bit >= 0; --bit) {
        const unsigned cand = T | (1u << bit); int cn = 0;
#pragma unroll
        for (int jb = 0; jb < 64; jb += 16) if (jb < nj) {
#pragma unroll
            for (int j = 0; j < 16; ++j) cn += __popcll(__ballot(key[jb + j] >= cand)); }
        if (cn >= 256) T = cand;
        if (cn == 256) break;
    }
    int gv = 0;
#pragma unroll
    for (int j = 0; j < 64; ++j) gv += (key[j] > T) ? 1 : 0;
    int need = 256 - wave_sum_i(gv);
#pragma unroll
    for (int j = 0; j < 64; ++j) {
        unsigned long long sel = 0ull;
        if (j < nj) {
            sel = __ballot(key[j] > T);
            const unsigned long long tb = __ballot(key[j] == T && (j * 64 + lane) < L);
            if (need > 0 && tb != 0ull) { const int cc = __popcll(tb);
                if (cc <= need) { sel |= tb; need -= cc; }
                else { const unsigned long long below = tb & ((1ull << lane) - 1ull); sel |= __ballot(key[j] == T && (j * 64 + lane) < L && __popcll(below) < need); need = 0; } }
        }
        if (2 * j < nwords && lane == 0) { mrow[2 * j] = (unsigned)sel; mrow[2 * j + 1] = (unsigned)(sel >> 32); }
        __builtin_amdgcn_sched_barrier(0);
    }
}

constexpr int IDX_KROW = 144, IDX_KBUF = 64 * IDX_KROW;
__device__ __forceinline__ float xsum16_32(float s) {
    { auto r = __builtin_amdgcn_permlane16_swap(__float_as_uint(s), __float_as_uint(s), false, false); s = __uint_as_float(r[0]) + __uint_as_float(r[1]); }
    { auto r = __builtin_amdgcn_permlane32_swap(__float_as_uint(s), __float_as_uint(s), false, false); s = __uint_as_float(r[0]) + __uint_as_float(r[1]); }
    return s;
}
__device__ __forceinline__ void idx_phase(const Frame& F0, unsigned char* ws) {
    const bf16* big = (const bf16*)(ws + WS_BIG); const float* wi = (const float*)(ws + WS_SIDE);
    float* score = (float*)(ws + SB_SCORE); unsigned* mask = (unsigned*)(ws + SB_MASK);
    char* lds = (char*)F0.lds;
    for (int i = 0, u = blockIdx.x; u < 544; ++i, u += F0.G) {
        const Frame F = relaunder(F0);
        const int tid = F.tid, lane = F.lane;
        int uu = u; if (u < 512 && (i & 1)) uu = (u & ~255) + 255 - (u & 255);
        int rowb, L, ngrp, nwords, ldki; const bf16* kbase;
        if (uu < 512) { rowb = uu * 16; const int b = rowb >> 12, c = (rowb & 4095) >> 6; L = 64 * (c + 1); ngrp = c + 1; nwords = 128; kbase = big + (size_t)b * SEQ * B_NP + 4096; ldki = B_NP; }
        else { rowb = NP + (uu - 512) * 16; const int b = (rowb - NP) >> 5; L = 1056; ngrp = 17; nwords = 36; kbase = (const bf16*)(ws + SB_CATI) + (size_t)b * B_CATROWS * 64; ldki = 64; }
        const int row0 = rowb + 2 * F.wave;
        if (L > 256) {
            const int c = lane & 15, g = lane >> 4;
            bf16x8 a00, a01, a10, a11; float w0[4], w1[4];
            { const bf16* q0 = big + (size_t)row0 * B_NP + 3072 + c * 64 + 8 * g; const bf16* q1 = q0 + B_NP;
              a00 = *(const bf16x8*)q0; a01 = *(const bf16x8*)(q0 + 32); a10 = *(const bf16x8*)q1; a11 = *(const bf16x8*)(q1 + 32);
#pragma unroll
              for (int k = 0; k < 4; ++k) { w0[k] = wi[(size_t)row0 * 16 + 4 * g + k] * (0.25f * 0.125f); w1[k] = wi[(size_t)(row0 + 1) * 16 + 4 * g + k] * (0.25f * 0.125f); } }
            float* s0 = score + (size_t)row0 * 4096; float* s1 = s0 + 4096;
            const int skey = tid >> 3, sseg = tid & 7;
            const bf16* gsrc = kbase + (size_t)skey * ldki + sseg * 8;
            v4u stg = *(const v4u*)gsrc;
            *(v4u*)(lds + skey * IDX_KROW + sseg * 16) = stg;
            __syncthreads();
            for (int gi = 0; gi < ngrp; ++gi) {
                if (gi + 1 < ngrp) stg = *(const v4u*)(gsrc + (size_t)(gi + 1) * 64 * ldki);
                const char* kb = lds + (gi & 1) * IDX_KBUF + c * IDX_KROW + 16 * g;
                float p0[4], p1[4];
#pragma unroll
                for (int t = 0; t < 4; ++t) {
                    const bf16x8 b0 = *(const bf16x8*)(kb + t * 16 * IDX_KROW), b1 = *(const bf16x8*)(kb + t * 16 * IDX_KROW + 64);
                    f32x4m d0 = {0.f, 0.f, 0.f, 0.f}, d1 = {0.f, 0.f, 0.f, 0.f};
                    d0 = __builtin_amdgcn_mfma_f32_16x16x32_bf16(a00, b0, d0, 0, 0, 0); d0 = __builtin_amdgcn_mfma_f32_16x16x32_bf16(a01, b1, d0, 0, 0, 0);
                    d1 = __builtin_amdgcn_mfma_f32_16x16x32_bf16(a10, b0, d1, 0, 0, 0); d1 = __builtin_amdgcn_mfma_f32_16x16x32_bf16(a11, b1, d1, 0, 0, 0);
                    float x0 = w0[0] * fmaxf(d0[0], 0.f); x0 = fmaf(w0[1], fmaxf(d0[1], 0.f), x0); x0 = fmaf(w0[2], fmaxf(d0[2], 0.f), x0); x0 = fmaf(w0[3], fmaxf(d0[3], 0.f), x0);
                    float x1 = w1[0] * fmaxf(d1[0], 0.f); x1 = fmaf(w1[1], fmaxf(d1[1], 0.f), x1); x1 = fmaf(w1[2], fmaxf(d1[2], 0.f), x1); x1 = fmaf(w1[3], fmaxf(d1[3], 0.f), x1);
                    p0[t] = xsum16_32(x0); p1[t] = xsum16_32(x1);
                }
                s0[gi * 64 + lane] = g == 0 ? p0[0] : g == 1 ? p0[1] : g == 2 ? p0[2] : p0[3];
                s1[gi * 64 + lane] = g == 0 ? p1[0] : g == 1 ? p1[1] : g == 2 ? p1[2] : p1[3];
                if (gi + 1 < ngrp) *(v4u*)(lds + ((gi + 1) & 1) * IDX_KBUF + skey * IDX_KROW + sseg * 16) = stg;
                __syncthreads();
            }
            VM_WAIT();
        }
        for (int rr = 0; rr < 2; ++rr) idx_select_row(score + (size_t)(row0 + rr) * 4096, L, mask + (size_t)(row0 + rr) * 128, nwords, lane);
    }
}

__device__ __forceinline__ void attn_b_phase(const Frame& F0, unsigned char* ws) {
    char* lds = (char*)F0.lds;
    const bf16* big = (const bf16*)(ws + WS_BIG); bf16* ao = (bf16*)(ws + WS_ATT); const unsigned* mask = (const unsigned*)(ws + SB_MASK);
    for (int u = blockIdx.x; u < 512; u += F0.G) {
        const Frame F = relaunder(F0);
        const int bg = (u & 255) >> 5, c = (u < 256) ? (u & 31) : 63 - (u & 31), b = bg >> 2, g = bg & 3;
        const int NT = (c + 2) & ~1, head = 4 * g + (F.wave >> 1);
        const size_t qrow = (size_t)b * SEQ + c * 64 + (F.wave & 1) * 32;
        att::MaskBits Mk{mask + (qrow + (F.lane & 31)) * 128};
        att::attn_body(big + qrow * B_NP + head * 128, B_NP, big + (size_t)b * SEQ * B_NP + 2048 + g * 128, big + (size_t)b * SEQ * B_NP + 2560 + g * 128, B_NP,
                       ao + qrow * DM + head * 128, DM, true, NT, lds, Mk, F.tid);
    }
    for (int u = blockIdx.x; u < 64; u += F0.G) {
        const Frame F = relaunder(F0);
        const int b = u >> 2, g = u & 3, head = 4 * g + (F.wave & 3);
        const size_t qrow = (size_t)NP + b * 32;
        att::MaskBits Mk{mask + (qrow + (F.lane & 31)) * 128};
        att::attn_body(big + qrow * B_NP + head * 128, B_NP, (const bf16*)(ws + SB_CATK) + (size_t)b * B_CATROWS * 512 + g * 128, (const bf16*)(ws + SB_CATV) + (size_t)b * B_CATROWS * 512 + g * 128, 512,
                       ao + qrow * DM + head * 128, DM, F.wave < 4, 18, lds, Mk, F.tid);
    }
}

constexpr int C_UNITS = 4096 + 512;
constexpr size_t CU_W = 0, CU_U0T = 16384, CU_QG = 32768, CU_KT = 49152, CU_AQK = 65536, CU_BYTES = 73728;
constexpr size_t SC_UNITS = WS_SCR, SC_DECAY = SC_UNITS + (size_t)C_UNITS * CU_BYTES, SC_END = SC_DECAY + C_UNITS * 4;
static_assert(SC_END <= WS_S0COPY, "C scratch");
typedef float f32x16c __attribute__((ext_vector_type(16)));
__device__ __forceinline__ int crow16(int r, int h) { return (r & 3) + 8 * (r >> 2) + 4 * h; }
__device__ __forceinline__ float sigmoidf_(float x) { return __builtin_amdgcn_rcpf(1.f + __expf(-x)); }
__device__ __forceinline__ float siluf_(float x) { return x * __builtin_amdgcn_rcpf(1.f + __expf(-x)); }

constexpr int PL_QN = 0;
constexpr int PL_KN = PL_QN + 64 * 272;
constexpr int PL_KB = PL_KN + 64 * 272;
constexpr int PL_M = PL_KB + 64 * 272;
constexpr int PL_RHS = PL_M + 64 * 256;
constexpr int PL_VEC = PL_RHS + 64 * 1040;
constexpr int PL_END = PL_VEC + 5 * 256;
static_assert(PL_END <= 147456, "prep LDS");

constexpr int C_DEF_SPLIT = 7168, C_DEF_SPLIT2 = 7168 + 10752;
constexpr int C_TLATE = 44, C_NEARLY = 2 * C_TLATE * 32 + 512, C_NLATE = 2 * (64 - C_TLATE) * 32;
template <int MODE> __device__ __forceinline__ void c_prep_phase(const Frame& F0, KArgs a, const int first, const int stride, const int count) {
    unsigned char* ws = a->ws;
    const bf16* big = (const bf16*)(ws + WS_BIG); const float* side = (const float*)(ws + WS_SIDE);
    const float* convw = a->in[I_CCONVW]; const float* cbuf = a->in[I_SCC];
    char* lds = (char*)F0.lds;
    for (int it = first; it < count; it += stride) {
        const Frame F = relaunder(F0);
        const int tid = F.tid, lane = F.lane, wave = F.wave;
        int uid = it;
        if constexpr (MODE == 0) { const int pe = 2 * C_TLATE * 32, per = C_TLATE * 32; const int sq = it >= per ? 1 : 0, rem = it - sq * per; uid = it < pe ? (sq * 64 + (rem >> 5)) * 32 + (it & 31) : 4096 + (it - pe); }
        if constexpr (MODE == 1) { const int per = (64 - C_TLATE) * 32; const int sq = it >= per ? 1 : 0, rem = it - sq * per; uid = (sq * 64 + C_TLATE + (rem >> 5)) * 32 + (it & 31); }
        const bool smp = uid >= 4096;
        const int hv = uid & 31, hq = hv >> 1;
        const int seq = smp ? (uid - 4096) >> 5 : uid >> 11, chunk = smp ? 0 : (uid >> 5) & 63;
        const int row0 = smp ? NP + seq * 32 : seq * SEQ + chunk * 64, nvalid = smp ? 32 : 64;
        bf16* qn = (bf16*)(lds + PL_QN); bf16* kn = (bf16*)(lds + PL_KN); bf16* kb = (bf16*)(lds + PL_KB);
        float* mL = (float*)(lds + PL_M); float* rhs = (float*)(lds + PL_RHS);
        float* Gv = (float*)(lds + PL_VEC); float* betav = Gv + 64; float* eGv = Gv + 128; float* rqv = Gv + 192; float* rkv = Gv + 256;
        unsigned char* ub = ws + SC_UNITS + (size_t)uid * CU_BYTES;
        if (wave == 7) {
            float beta = 0.f, g = 0.f;
            if (lane < nvalid) { const float* sr = side + (size_t)(row0 + lane) * 64;
                beta = sigmoidf_(sr[hv]); const float x = sr[32 + hv] + a->in[I_CDT][hv]; const float sp = x > 20.f ? x : __logf(1.f + __expf(x)); g = -__expf(a->in[I_CALOG][hv]) * sp; }
            float G = g;
#pragma unroll
            for (int o = 1; o < 64; o <<= 1) { const float t = __shfl_up(G, o); if (lane >= o) G += t; }
            Gv[lane] = G; betav[lane] = beta; eGv[lane] = __expf(G);
        }
        if (tid < 384) {
            const int grp = tid % 48, tb = tid / 48, part = grp >> 4, c8 = (grp & 15) * 8;
            const int ch = part == 0 ? hq * 128 + c8 : part == 1 ? 2048 + hq * 128 + c8 : 4096 + hv * 128 + c8;
            float* dst = part == 2 ? (float*)(lds + PL_QN) + c8 : rhs + (part == 1 ? 128 : 0) + c8; const int dstride = part == 2 ? 132 : 260;
            if (8 * tb < nvalid) {
                float w[4][8], xr[11][8];
#pragma unroll
                for (int j = 0; j < 4; ++j) { const f32x4 a0 = *(const f32x4*)(convw + (size_t)j * 8192 + ch), a1 = *(const f32x4*)(convw + (size_t)j * 8192 + ch + 4);
                    w[j][0] = a0[0]; w[j][1] = a0[1]; w[j][2] = a0[2]; w[j][3] = a0[3]; w[j][4] = a1[0]; w[j][5] = a1[1]; w[j][6] = a1[2]; w[j][7] = a1[3]; }
                bf16x8 xv[11];
#pragma unroll
                for (int i = 0; i < 11; ++i) { const int tt = 8 * tb - 3 + i; const bool ok = tt >= 0 || (!smp && chunk > 0);
                    xv[i] = *(const bf16x8*)(big + (size_t)(row0 + (ok ? tt : 0)) * C_NP + ch); }
#pragma unroll
                for (int i = 0; i < 11; ++i) { const int tt = 8 * tb - 3 + i; const bool ok = tt >= 0 || (!smp && chunk > 0);
#pragma unroll
                    for (int e = 0; e < 8; ++e) xr[i][e] = ok ? bf2f((bf16)xv[i][e]) : 0.f; }
                if (smp) {
#pragma unroll
                    for (int i = 0; i < 3; ++i) { const int tt = 8 * tb - 3 + i; const int r = tt < 0 ? 3 + tt : 0;
                        const float* cb = cbuf + ((size_t)seq * 3 + r) * 8192 + ch; const f32x4 a0 = *(const f32x4*)cb, a1 = *(const f32x4*)(cb + 4);
                        if (tt < 0) { xr[i][0] = a0[0]; xr[i][1] = a0[1]; xr[i][2] = a0[2]; xr[i][3] = a0[3]; xr[i][4] = a1[0]; xr[i][5] = a1[1]; xr[i][6] = a1[2]; xr[i][7] = a1[3]; } }
                }
#pragma unroll
                for (int t8 = 0; t8 < 8; ++t8) { f32x4 y0, y1;
#pragma unroll
                    for (int e = 0; e < 8; ++e) { float y = xr[t8][e] * w[0][e]; y = fmaf(xr[t8 + 1][e], w[1][e], y); y = fmaf(xr[t8 + 2][e], w[2][e], y); y = fmaf(xr[t8 + 3][e], w[3][e], y); y = siluf_(y);
                        if (e < 4) y0[e] = y; else y1[e - 4] = y; }
                    float* d = dst + (8 * tb + t8) * dstride; *(f32x4*)d = y0; *(f32x4*)(d + 4) = y1; }
            } else {
#pragma unroll
                for (int t8 = 0; t8 < 8; ++t8) { float* d = dst + (8 * tb + t8) * dstride; *(f32x4*)d = (f32x4){0.f, 0.f, 0.f, 0.f}; *(f32x4*)(d + 4) = (f32x4){0.f, 0.f, 0.f, 0.f}; }
            }
        }
        __syncthreads();
        { const int t = tid >> 3, sub = tid & 7; float sq = 0.f, sk = 0.f;
#pragma unroll
          for (int e = 0; e < 16; ++e) { const float q = rhs[t * 260 + sub * 16 + e], k = rhs[t * 260 + 128 + sub * 16 + e]; sq = fmaf(q, q, sq); sk = fmaf(k, k, sk); }
          sq += __shfl_xor(sq, 1); sq += __shfl_xor(sq, 2); sq += __shfl_xor(sq, 4); sk += __shfl_xor(sk, 1); sk += __shfl_xor(sk, 2); sk += __shfl_xor(sk, 4);
          if (sub == 0) { rqv[t] = rsqrtf(sq + RMS_EPS) * 0.08838834764831845f; rkv[t] = rsqrtf(sk + RMS_EPS); } }
        __syncthreads();
        { const int t = tid >> 3, sub = tid & 7; float q[16], k[16], vb[16];
          const float* vpark = (const float*)(lds + PL_QN) + t * 132 + sub * 16;
#pragma unroll
          for (int e = 0; e < 16; ++e) { q[e] = rhs[t * 260 + sub * 16 + e] * rqv[t]; k[e] = rhs[t * 260 + 128 + sub * 16 + e] * rkv[t]; vb[e] = vpark[e] * betav[t]; }
          __syncthreads();
          const float be = betav[t], eg = eGv[t];
#pragma unroll
          for (int e = 0; e < 16; e += 2) {
              *(unsigned*)(qn + t * 136 + sub * 16 + e) = pk2(q[e], q[e + 1]); *(unsigned*)(kn + t * 136 + sub * 16 + e) = pk2(k[e], k[e + 1]);
              *(unsigned*)(kb + t * 136 + sub * 16 + e) = pk2(k[e] * be, k[e + 1] * be); }
#pragma unroll
          for (int e = 0; e < 16; ++e) { rhs[t * 260 + sub * 16 + e] = vb[e]; rhs[t * 260 + 128 + sub * 16 + e] = k[e] * be * eg; }
        }
        __syncthreads();
        { const int r32 = lane & 31, h = lane >> 5, tile = wave & 3, mt = tile >> 1, nt = tile & 1;
          const bf16* Ab = (wave < 4 ? kb : qn) + (mt * 32 + r32) * 136 + 8 * h; const bf16* Bb = kn + (nt * 32 + r32) * 136 + 8 * h;
          f32x16c d = {};
#pragma unroll
          for (int s = 0; s < 8; ++s) d = __builtin_amdgcn_mfma_f32_32x32x16_bf16(*(const bf16x8*)(Ab + 16 * s), *(const bf16x8*)(Bb + 16 * s), d, 0, 0, 0);
          const int j = nt * 32 + r32; const float Gj = Gv[j];
          bf16* aqk = (bf16*)(ub + CU_AQK);
#pragma unroll
          for (int r = 0; r < 16; ++r) { const int i = mt * 32 + crow16(r, h); const float dec = __expf(fminf(Gv[i] - Gj, 0.f));
              if (wave < 4) mL[i * 64 + j] = (j < i) ? d[r] * dec : 0.f;
              else aqk[i * 64 + j] = (bf16)(pk2((j <= i) ? d[r] * dec : 0.f, 0.f) & 0xffffu); }
        }
        __syncthreads();
        if (wave < 4) {
            const int c = tid; float x[64];
            const LAS float* mLv = (const LAS float*)mL; asm volatile("" : "+v"(mLv));
#ifdef EXP_SOLVE2
            for (int rep_ = 0; rep_ < 2; ++rep_) { asm volatile("" ::: "memory");
#endif
#pragma unroll
            for (int ib = 0; ib < 16; ++ib) {
                float a0 = rhs[(4 * ib + 0) * 260 + c], a1 = rhs[(4 * ib + 1) * 260 + c], a2 = rhs[(4 * ib + 2) * 260 + c], a3 = rhs[(4 * ib + 3) * 260 + c];
#pragma unroll
                for (int jb = 0; jb < ib; ++jb) {
                    const f32x4 m0 = *(const LAS f32x4*)(mLv + (4 * ib + 0) * 64 + 4 * jb), m1 = *(const LAS f32x4*)(mLv + (4 * ib + 1) * 64 + 4 * jb),
                                m2 = *(const LAS f32x4*)(mLv + (4 * ib + 2) * 64 + 4 * jb), m3 = *(const LAS f32x4*)(mLv + (4 * ib + 3) * 64 + 4 * jb);
#pragma unroll
                    for (int e = 0; e < 4; ++e) { const float xv = x[4 * jb + e]; a0 = fmaf(-m0[e], xv, a0); a1 = fmaf(-m1[e], xv, a1); a2 = fmaf(-m2[e], xv, a2); a3 = fmaf(-m3[e], xv, a3); }
                }
                const f32x4 d1 = *(const LAS f32x4*)(mLv + (4 * ib + 1) * 64 + 4 * ib), d2 = *(const LAS f32x4*)(mLv + (4 * ib + 2) * 64 + 4 * ib), d3 = *(const LAS f32x4*)(mLv + (4 * ib + 3) * 64 + 4 * ib);
                x[4 * ib] = a0;
                a1 = fmaf(-d1[0], a0, a1); x[4 * ib + 1] = a1;
                a2 = fmaf(-d2[0], a0, a2); a2 = fmaf(-d2[1], a1, a2); x[4 * ib + 2] = a2;
                a3 = fmaf(-d3[0], a0, a3); a3 = fmaf(-d3[1], a1, a3); a3 = fmaf(-d3[2], a2, a3); x[4 * ib + 3] = a3;
            }
#ifdef EXP_SOLVE2
            }
#endif
#pragma unroll
            for (int i = 0; i < 64; ++i) rhs[i * 260 + c] = x[i];
        } else {
            const int t2 = tid - 256;
            bf16* qg = (bf16*)(ub + CU_QG); bf16* kt = (bf16*)(ub + CU_KT);
            const float Glast = Gv[63];
            for (int it = t2; it < 64 * 16; it += 256) { const int t = it >> 4, c8 = (it & 15) * 8; const float eg = eGv[t];
                const bf16x8 v = *(const bf16x8*)(qn + t * 136 + c8); v4u o;
                o.x = pk2(bf2f((bf16)v[0]) * eg, bf2f((bf16)v[1]) * eg); o.y = pk2(bf2f((bf16)v[2]) * eg, bf2f((bf16)v[3]) * eg); o.z = pk2(bf2f((bf16)v[4]) * eg, bf2f((bf16)v[5]) * eg); o.w = pk2(bf2f((bf16)v[6]) * eg, bf2f((bf16)v[7]) * eg);
                *(v4u*)(qg + t * 128 + c8) = o; }
            for (int it = t2; it < 128 * 8; it += 256) { const int dk = it & 127, t8 = (it >> 7) * 8; float f[8];
#pragma unroll
                for (int e = 0; e < 8; ++e) f[e] = bf2f(kn[(t8 + e) * 136 + dk]) * __expf(Glast - Gv[t8 + e]);
                v4u o; o.x = pk2(f[0], f[1]); o.y = pk2(f[2], f[3]); o.z = pk2(f[4], f[5]); o.w = pk2(f[6], f[7]);
                *(v4u*)(kt + dk * 64 + t8) = o; }
            if (t2 == 0) ((float*)(ws + SC_DECAY))[uid] = __expf(Glast);
        }
        __syncthreads();
        { bf16* Wg = (bf16*)(ub + CU_W); bf16* U0t = (bf16*)(ub + CU_U0T);
          for (int it = tid; it < 64 * 16; it += NTHR) { const int t = it >> 4, c8 = (it & 15) * 8; const float* s = rhs + t * 260 + 128 + c8;
              v4u o; o.x = pk2(s[0], s[1]); o.y = pk2(s[2], s[3]); o.z = pk2(s[4], s[5]); o.w = pk2(s[6], s[7]); *(v4u*)(Wg + t * 128 + c8) = o; }
          for (int it = tid; it < 128 * 8; it += NTHR) { const int dv = it & 127, t8 = (it >> 7) * 8; const float* s = rhs + t8 * 260 + dv;
              v4u o; o.x = pk2(s[0], s[260]); o.y = pk2(s[520], s[780]); o.z = pk2(s[1040], s[1300]); o.w = pk2(s[1560], s[1820]); *(v4u*)(U0t + dv * 64 + t8) = o; } }
        __syncthreads();
    }
}

constexpr int SL_W = 0, SL_QG = SL_W + 64 * 272, SL_KT = SL_QG + 64 * 272, SL_AQK = SL_KT + 128 * 144, SL_ST = SL_AQK + 64 * 144, SL_UT = SL_ST + 128 * 272, SL_END = SL_UT + 128 * 144;
constexpr int SL_O = 0;
static_assert(64 * 132 * 4 <= SL_KT && SL_END <= 147456, "scan LDS");

struct ScanPf { v4u w0, w1, q0, q1, k0, k1, aq; v2u u0, u1, u2, u3; v4u z0, z1; float decay; };
__device__ __forceinline__ void c_scan_phase(const Frame& F0, KArgs a) {
    unsigned char* ws = a->ws; char* lds = (char*)F0.lds;
    const bf16* big = (const bf16*)(ws + WS_BIG); bf16* og = (bf16*)(ws + WS_ATT); const float* normw = a->in[I_CNORM];
    const int G = F0.G; const bool few = G <= 64;
    gu32* lpw = (gu32*)((unsigned*)(ws + WS_CTL) + CW_QB);
    if (!few && blockIdx.x >= 64) {
        c_prep_phase<1>(F0, a, (int)blockIdx.x - 64, G - 64, C_NLATE);
        asm volatile("s_waitcnt vmcnt(0)" ::: "memory");
        __syncthreads();
        if (relaunder(F0).tid == 0) { __builtin_amdgcn_fence(__ATOMIC_RELEASE, "agent"); asm volatile("s_waitcnt vmcnt(0)" ::: "memory"); (void)__hip_atomic_fetch_add(lpw, 1u, __ATOMIC_RELAXED, __HIP_MEMORY_SCOPE_AGENT); }
    }
    for (int pass = 0; pass < 2; ++pass) {
        int first, stride, count;
        if (pass == 0) { first = blockIdx.x; stride = G; count = 64; if (!few && blockIdx.x >= 64) count = 0; }
        else { if (few) { first = blockIdx.x; stride = G; } else { first = (int)blockIdx.x - 64; stride = G - 64; } count = 512; if (first < 0) { first = 0; count = 0; } }
        for (int ch = first; ch < count; ch += stride) {
            const Frame F = relaunder(F0);
            const int tid = F.tid, lane = F.lane, wave = F.wave, r32 = lane & 31, h = lane >> 5;
            const bool smp = pass == 1;
            const int seq = ch >> 5, hv = ch & 31, nsteps = smp ? 1 : 64, nvalid = smp ? 32 : 64;
            const int mt = wave & 1, nt = wave >> 1;
            const int dvc = nt * 32 + r32;
            const int tn = tid >> 3, sub = tid & 7;
            f32x16c S0 = {}, S1 = {};
            if (smp) { const float* s0 = a->in[I_SCS] + ((size_t)(seq * 32 + hv) * 128) * 128;
#pragma unroll
                for (int r = 0; r < 16; ++r) { S0[r] = s0[(size_t)((2 * mt) * 32 + crow16(r, h)) * 128 + dvc]; S1[r] = s0[(size_t)((2 * mt + 1) * 32 + crow16(r, h)) * 128 + dvc]; } }
            bf16* Wl = (bf16*)(lds + SL_W); bf16* Ql = (bf16*)(lds + SL_QG); bf16* Kl = (bf16*)(lds + SL_KT); bf16* Al = (bf16*)(lds + SL_AQK);
            bf16* St = (bf16*)(lds + SL_ST); bf16* ut = (bf16*)(lds + SL_UT); float* ol = (float*)(lds + SL_O);
#define SCAN_FETCH(P, st) do { const int uid_ = smp ? 4096 + ch : (seq * 64 + (st)) * 32 + hv; const int row0_ = smp ? NP + seq * 32 : seq * SEQ + (st) * 64;                 \
                const unsigned char* ub_ = ws + SC_UNITS + (size_t)uid_ * CU_BYTES;                                                                                                  \
                { const int t_ = tid >> 4, c8_ = (tid & 15) * 8; P.w0 = *(const v4u*)((const bf16*)(ub_ + CU_W) + t_ * 128 + c8_); P.w1 = *(const v4u*)((const bf16*)(ub_ + CU_W) + (t_ + 32) * 128 + c8_);        \
                  P.q0 = *(const v4u*)((const bf16*)(ub_ + CU_QG) + t_ * 128 + c8_); P.q1 = *(const v4u*)((const bf16*)(ub_ + CU_QG) + (t_ + 32) * 128 + c8_); }                                                 \
                { const int dk_ = tid >> 3, c8_ = (tid & 7) * 8; P.k0 = *(const v4u*)((const bf16*)(ub_ + CU_KT) + dk_ * 64 + c8_); P.k1 = *(const v4u*)((const bf16*)(ub_ + CU_KT) + (dk_ + 64) * 64 + c8_);       \
                  P.aq = *(const v4u*)((const bf16*)(ub_ + CU_AQK) + dk_ * 64 + c8_); }                                                                                              \
                { const bf16* U0t_ = (const bf16*)(ub_ + CU_U0T) + dvc * 64 + mt * 32 + 4 * h; P.u0 = *(const v2u*)(U0t_); P.u1 = *(const v2u*)(U0t_ + 8); P.u2 = *(const v2u*)(U0t_ + 16); P.u3 = *(const v2u*)(U0t_ + 24); } \
                { const int tz_ = tn < nvalid ? tn : 0; const bf16* zr_ = big + (size_t)(row0_ + tz_) * C_NP + 8192 + hv * 128 + sub * 16; P.z0 = *(const v4u*)zr_; P.z1 = *(const v4u*)(zr_ + 8); }          \
                P.decay = ((const float*)(ws + SC_DECAY))[uid_]; } while (0)
#define SCAN_STAGE(P) do { { const int t_ = tid >> 4, c8_ = (tid & 15) * 8; *(v4u*)(Wl + t_ * 136 + c8_) = P.w0; *(v4u*)(Wl + (t_ + 32) * 136 + c8_) = P.w1; *(v4u*)(Ql + t_ * 136 + c8_) = P.q0; *(v4u*)(Ql + (t_ + 32) * 136 + c8_) = P.q1; } \
                { const int dk_ = tid >> 3, c8_ = (tid & 7) * 8; *(v4u*)(Kl + dk_ * 72 + c8_) = P.k0; *(v4u*)(Kl + (dk_ + 64) * 72 + c8_) = P.k1; *(v4u*)(Al + dk_ * 72 + c8_) = P.aq; } } while (0)
            ScanPf cur, nxt;
            SCAN_FETCH(cur, 0);
            SCAN_STAGE(cur);
            nxt = cur;
            for (int step = 0; step < nsteps; ++step) {
                const int row0 = smp ? NP + seq * 32 : seq * SEQ + step * 64;
                if (!smp && !few && step + 1 == C_TLATE) {
                    if (tid == 0) { unsigned sp = 0u; while (__hip_atomic_load(lpw, __ATOMIC_RELAXED, __HIP_MEMORY_SCOPE_AGENT) < (unsigned)(G - 64) && ++sp < (1u << 20)) __builtin_amdgcn_s_sleep(2);
                        __builtin_amdgcn_fence(__ATOMIC_ACQUIRE, "agent"); asm volatile("s_waitcnt vmcnt(0)" ::: "memory"); }
                    __syncthreads();
                }
                if (step + 1 < nsteps) SCAN_FETCH(nxt, step + 1);
#pragma unroll
                for (int q = 0; q < 4; ++q) {
                    v2u w0, w1; w0.x = pk2(S0[4 * q], S0[4 * q + 1]); w0.y = pk2(S0[4 * q + 2], S0[4 * q + 3]); w1.x = pk2(S1[4 * q], S1[4 * q + 1]); w1.y = pk2(S1[4 * q + 2], S1[4 * q + 3]);
                    *(v2u*)(St + dvc * 136 + (2 * mt) * 32 + 8 * q + 4 * h) = w0; *(v2u*)(St + dvc * 136 + (2 * mt + 1) * 32 + 8 * q + 4 * h) = w1; }
                f32x16c u;
#define SCAN_U0(q, W) do { u[4 * q] = __uint_as_float(W.x << 16); u[4 * q + 1] = __uint_as_float(W.x & 0xffff0000u); u[4 * q + 2] = __uint_as_float(W.y << 16); u[4 * q + 3] = __uint_as_float(W.y & 0xffff0000u); } while (0)
                SCAN_U0(0, cur.u0); SCAN_U0(1, cur.u1); SCAN_U0(2, cur.u2); SCAN_U0(3, cur.u3);
                __syncthreads();
                f32x16c ws_acc = {}, o = {};
#pragma unroll
                for (int s = 0; s < 8; ++s) { const bf16x8 bS = *(const bf16x8*)(St + dvc * 136 + 16 * s + 8 * h);
                    ws_acc = __builtin_amdgcn_mfma_f32_32x32x16_bf16(*(const bf16x8*)(Wl + (mt * 32 + r32) * 136 + 16 * s + 8 * h), bS, ws_acc, 0, 0, 0);
                    o = __builtin_amdgcn_mfma_f32_32x32x16_bf16(*(const bf16x8*)(Ql + (mt * 32 + r32) * 136 + 16 * s + 8 * h), bS, o, 0, 0, 0); }
#pragma unroll
                for (int r = 0; r < 16; ++r) u[r] -= ws_acc[r];
#pragma unroll
                for (int q = 0; q < 4; ++q) { v2u w; w.x = pk2(u[4 * q], u[4 * q + 1]); w.y = pk2(u[4 * q + 2], u[4 * q + 3]); *(v2u*)(ut + dvc * 72 + mt * 32 + 8 * q + 4 * h) = w; }
                __syncthreads();
                const float decay = cur.decay;
#pragma unroll
                for (int r = 0; r < 16; ++r) { S0[r] *= decay; S1[r] *= decay; }
#pragma unroll
                for (int s = 0; s < 4; ++s) { const bf16x8 bU = *(const bf16x8*)(ut + dvc * 72 + 16 * s + 8 * h);
                    o = __builtin_amdgcn_mfma_f32_32x32x16_bf16(*(const bf16x8*)(Al + (mt * 32 + r32) * 72 + 16 * s + 8 * h), bU, o, 0, 0, 0);
                    S0 = __builtin_amdgcn_mfma_f32_32x32x16_bf16(*(const bf16x8*)(Kl + ((2 * mt) * 32 + r32) * 72 + 16 * s + 8 * h), bU, S0, 0, 0, 0);
                    S1 = __builtin_amdgcn_mfma_f32_32x32x16_bf16(*(const bf16x8*)(Kl + ((2 * mt + 1) * 32 + r32) * 72 + 16 * s + 8 * h), bU, S1, 0, 0, 0); }
#pragma unroll
                for (int r = 0; r < 16; ++r) ol[(mt * 32 + crow16(r, h)) * 132 + dvc] = o[r];
                __syncthreads();
                { float v[16]; float ss = 0.f;
#pragma unroll
                  for (int e = 0; e < 16; ++e) { v[e] = ol[tn * 132 + sub * 16 + e]; ss = fmaf(v[e], v[e], ss); }
                  ss += __shfl_xor(ss, 1); ss += __shfl_xor(ss, 2); ss += __shfl_xor(ss, 4);
                  const float rs = rsqrtf(ss * (1.f / 128.f) + RMS_EPS);
                  if (tn < nvalid) {
                      const unsigned zw[8] = {cur.z0.x, cur.z0.y, cur.z0.z, cur.z0.w, cur.z1.x, cur.z1.y, cur.z1.z, cur.z1.w};
                      float y[16];
#pragma unroll
                      for (int e = 0; e < 16; ++e) { const float z = (e & 1) ? __uint_as_float(zw[e >> 1] & 0xffff0000u) : __uint_as_float(zw[e >> 1] << 16); y[e] = v[e] * rs * normw[sub * 16 + e] * siluf_(z); }
                      v4u o0, o1; o0.x = pk2(y[0], y[1]); o0.y = pk2(y[2], y[3]); o0.z = pk2(y[4], y[5]); o0.w = pk2(y[6], y[7]); o1.x = pk2(y[8], y[9]); o1.y = pk2(y[10], y[11]); o1.z = pk2(y[12], y[13]); o1.w = pk2(y[14], y[15]);
                      bf16* dst = og + (size_t)(row0 + tn) * C_VD + hv * 128 + sub * 16; *(v4u*)dst = o0; *(v4u*)(dst + 8) = o1; } }
                __syncthreads();
                if (step + 1 < nsteps) { SCAN_STAGE(nxt); cur = nxt; }
            }
            { float* so = a->out + (smp ? O_CSS : O_CSP) + ((size_t)(seq * 32 + hv) * 128) * 128;
#pragma unroll
              for (int r = 0; r < 16; ++r) { so[(size_t)((2 * mt) * 32 + crow16(r, h)) * 128 + dvc] = S0[r]; so[(size_t)((2 * mt + 1) * 32 + crow16(r, h)) * 128 + dvc] = S1[r]; } }
#undef SCAN_FETCH
#undef SCAN_STAGE
#undef SCAN_U0
        }
    }
    { const Frame F = relaunder(F0); __syncthreads();
      if (few) convert_weights<true>(F, a, blockIdx.x * NWAVES + F.wave, G * NWAVES);
      else if (blockIdx.x >= 64) convert_weights<true>(F, a, ((int)blockIdx.x - 64) * NWAVES + F.wave, (G - 64) * NWAVES, G == 256 ? C_DEF_SPLIT2 : 0); }
}

template <int PH> __device__ __forceinline__ void run_phase(const Frame& F, const int layer) {
    const KArgs KA = kargs();
    unsigned char* ws = KA->ws;
    const int kind = layer % 3, j = layer / 3;
    if constexpr (PH == 0) { p0_prologue(F, KA); }
    if constexpr (PH == 1) {
        pg8::Gemm g{(const bf16*)(ws + WS_XN), (const bf16*)(ws + WS_WA_IN) + (size_t)j * A_N * DM, NTOK, A_N, DM};
        pg8::StaticOrder S; S.init(NTOK, A_N, F.G, launder_s((int)blockIdx.x), DM);
        pg8::EpiF<FnAqkv> E{{(bf16*)(ws + WS_BIG), KA->out, (bf16*)(ws + SA_CATK), (bf16*)(ws + SA_CATV), j}};
        pg8::gemm_phase<pg8::EpiF<FnAqkv>, pg8::StaticOrder, true, true>(F.lds, g, S, E, relaunder(F).tid);
        { const int ntail = (NTOK / 256) * (A_N / 256) % F.G, rk = F.G == 256 ? (int)blockIdx.x - ntail : (int)blockIdx.x, nbk = F.G == 256 ? F.G - ntail : F.G;
          cat_rows(F, KA->in[I_CAK] + (size_t)j * 16 * 512 * 2048, (bf16*)(ws + SA_CATK), 16, 512, 2048, A_CATROWS, 544, rk, nbk);
          cat_rows(F, KA->in[I_CAV] + (size_t)j * 16 * 512 * 2048, (bf16*)(ws + SA_CATV), 16, 512, 2048, A_CATROWS, 544, rk, nbk); }
    }
    if constexpr (PH == 2) attn_a_phase(F, ws, KA->in[I_ABIAS] + (size_t)j * 16 * 257);
    if constexpr (PH == 3) {
        pg8::Gemm g{(const bf16*)(ws + WS_XN), (const bf16*)(ws + WS_WB_IN), NTOK, B_NP, DM};
        pg8::StaticOrder S; S.init(NTOK, B_NP, F.G, launder_s((int)blockIdx.x), DM);
        pg8::EpiF<FnBproj> E{{(bf16*)(ws + WS_BIG), KA->out, (float*)(ws + WS_SIDE), (bf16*)(ws + SB_CATK), (bf16*)(ws + SB_CATV), (bf16*)(ws + SB_CATI)}};
        pg8::gemm_phase<pg8::EpiF<FnBproj>, pg8::StaticOrder, true, true>(F.lds, g, S, E, relaunder(F).tid);
        { const int ntail = (NTOK / 256) * (B_NP / 256) % F.G, rk = F.G == 256 ? (int)blockIdx.x - ntail : (int)blockIdx.x, nbk = F.G == 256 ? F.G - ntail : F.G;
          cat_rows(F, KA->in[I_CBK], (bf16*)(ws + SB_CATK), 16, 1024, 512, B_CATROWS, 1056, rk, nbk);
          cat_rows(F, KA->in[I_CBV], (bf16*)(ws + SB_CATV), 16, 1024, 512, B_CATROWS, 1056, rk, nbk);
          cat_rows(F, KA->in[I_CBI], (bf16*)(ws + SB_CATI), 16, 1024, 64, B_CATROWS, 1056, rk, nbk); }
    }
    if constexpr (PH == 4) idx_phase(F, ws);
    if constexpr (PH == 5) attn_b_phase(F, ws);
    if constexpr (PH == 6) {
        pg8::Gemm g{(const bf16*)(ws + WS_XN), (const bf16*)(ws + WS_WC_IN), NTOK, C_NP, DM};
        pg8::StaticOrder S; S.init(NTOK, C_NP, F.G, launder_s((int)blockIdx.x), DM);
        pg8::EpiF<FnCproj> E{{(bf16*)(ws + WS_BIG), KA->out, (float*)(ws + WS_SIDE)}};
        pg8::gemm_phase<pg8::EpiF<FnCproj>, pg8::StaticOrder, true, true>(F.lds, g, S, E, relaunder(F).tid);
        { const int ntail = (NTOK / 256) * (C_NP / 256) % F.G; if (F.G == 256 && (int)blockIdx.x >= ntail) { const Frame Fc = relaunder(F); convert_weights<true>(Fc, KA, ((int)blockIdx.x - ntail) * NWAVES + Fc.wave, (F.G - ntail) * NWAVES, 0, C_DEF_SPLIT); } }
    }
    if constexpr (PH == 7) { if (F.G > 64) c_prep_phase<0>(F, KA, (int)blockIdx.x, F.G, C_NEARLY); else c_prep_phase<2>(F, KA, (int)blockIdx.x, F.G, C_UNITS); }
    if constexpr (PH == 8) c_scan_phase(F, KA);
    if constexpr (PH == 9) {
        const bf16* wout = kind == 0 ? (const bf16*)(ws + WS_WA_OUT) + (size_t)j * DM * DM : kind == 1 ? (const bf16*)(ws + WS_WB_OUT) : (const bf16*)(ws + WS_WC_OUT);
        pg8::Gemm g{(const bf16*)(ws + WS_ATT), wout, NTOK, DM, kind == 2 ? C_VD : DM};
        pg8::SplitOrder S; S.init(launder_s((int)blockIdx.x), g.K);
        pg8::EpiF<FnMix> E{{(float*)(ws + WS_MIX), (float*)(ws + WS_PART)}};
        pg8::gemm_phase<pg8::EpiF<FnMix>, pg8::SplitOrder, true, true>(F.lds, g, S, E, relaunder(F).tid);
    }
    if constexpr (PH == 10) {
        ln_phase(F, KA->in[I_XP], KA->in[I_XS], layer == 0, (const float*)(ws + WS_MIX), (const float*)(ws + WS_PART), KA->in[I_LN1G] + layer * DM, KA->in[I_LN1B] + layer * DM, nullptr, (bf16*)(ws + WS_XN));
    }
    if constexpr (PH == 11) {
        pg8::Gemm g{(const bf16*)(ws + WS_XN), (const bf16*)(ws + WS_W1) + (size_t)layer * DFF * DM, NTOK, DFF, DM};
        pg8::StaticOrder S; S.init(NTOK, DFF, F.G, launder_s((int)blockIdx.x), DM);
        pg8::EpiF<FnRelu2> E{{(bf16*)(ws + WS_BIG)}};
        pg8::gemm_phase<pg8::EpiF<FnRelu2>, pg8::StaticOrder, true, true>(F.lds, g, S, E, relaunder(F).tid);
        { const int ntail = (NTOK / 256) * (DFF / 256) % F.G; if (layer == 1 && F.G == 256 && (int)blockIdx.x >= ntail) { const Frame Fc = relaunder(F); convert_weights<true>(Fc, KA, ((int)blockIdx.x - ntail) * NWAVES + Fc.wave, (F.G - ntail) * NWAVES, C_DEF_SPLIT, C_DEF_SPLIT2); } }
    }
    if constexpr (PH == 12) {
        pg8::Gemm g{(const bf16*)(ws + WS_BIG), (const bf16*)(ws + WS_W2) + (size_t)layer * DM * DFF, NTOK, DM, DFF};
        pg8::SplitOrder S; S.init(launder_s((int)blockIdx.x), DFF);
        pg8::EpiF<FnMix> E{{(float*)(ws + WS_MIX), (float*)(ws + WS_PART)}};
        pg8::gemm_phase<pg8::EpiF<FnMix>, pg8::SplitOrder, true, true>(F.lds, g, S, E, relaunder(F).tid);
    }
    if constexpr (PH == 13) ln_phase(F, KA->in[I_XP], KA->in[I_XS], false, (const float*)(ws + WS_MIX), (const float*)(ws + WS_PART), KA->in[I_LN2G] + layer * DM, KA->in[I_LN2B] + layer * DM, layer == DEPTH - 1 ? KA->out + O_YP : nullptr, (bf16*)(ws + WS_XN));
}

constexpr int LDS_BYTES = 147456, MISC_OFF = LDS_BYTES - 64;
#ifndef MK_SINGLE
#define MK_SINGLE 1
#endif
#ifndef MULTIK
__global__ void __launch_bounds__(NTHR, 2) mk_fwd(Args args) {
    extern __shared__ __attribute__((aligned(16))) unsigned char lds_raw[];
    Frame F; F.lds = (LAS unsigned char*)lds_raw;
    F.tid = threadIdx.x; F.lane = F.tid & 63; F.wave = __builtin_amdgcn_readfirstlane(F.tid >> 6);
    F.G = gridDim.x; { const int bx = blockIdx.x; F.vcu = (F.G % 8 == 0) ? (bx % 8) * (F.G / 8) + bx / 8 : bx; }
    const int lo = args.ph_lo, hi = args.ph_hi;
    volatile LAS unsigned* misc = (volatile LAS unsigned*)(F.lds + MISC_OFF);
    if (F.tid < 16) misc[F.tid] = 0u;
    __syncthreads();
    XcdBarrier bar; bar.bar = (unsigned*)(args.ws + WS_CTL) + CW_BAR; bar.x = 0; bar.st = misc;
    if (MK_SINGLE) bar = xcd_barrier_post((unsigned*)(args.ws + WS_CTL) + CW_BAR, misc);
#define IN(k) (lo <= (k) && (k) < hi)
#define SEAM(k) do { if (MK_SINGLE && hi > (k) + 1) xcd_barrier(bar); } while (0)
    if (IN(0)) { run_phase<0>(F, 0); SEAM(0); }
    for (int layer = 0; layer < DEPTH; ++layer) {
        const int kind = layer % 3, base = 1 + 8 * layer;
        if (kind == 0) {
            if (IN(base + 0)) { run_phase<1>(F, layer); SEAM(base + 0); }
            if (IN(base + 1)) { run_phase<2>(F, layer); SEAM(base + 1); }
        } else if (kind == 1) {
            if (IN(base + 0)) { run_phase<3>(F, layer); SEAM(base + 0); }
            if (IN(base + 1)) { run_phase<4>(F, layer); SEAM(base + 1); }
            if (IN(base + 2)) { run_phase<5>(F, layer); SEAM(base + 2); }
        } else {
            if (IN(base + 0)) { run_phase<6>(F, layer); SEAM(base + 0); }
            if (IN(base + 1)) { run_phase<7>(F, layer); SEAM(base + 1); }
            if (IN(base + 2)) { run_phase<8>(F, layer); SEAM(base + 2); }
        }
        if (IN(base + 3)) { run_phase<9>(F, layer); SEAM(base + 3); }
        if (IN(base + 4)) { run_phase<10>(F, layer); SEAM(base + 4); }
        if (IN(base + 5)) { run_phase<11>(F, layer); SEAM(base + 5); }
        if (IN(base + 6)) { run_phase<12>(F, layer); SEAM(base + 6); }
        if (IN(base + 7)) { run_phase<13>(F, layer); SEAM(base + 7); }
    }
#undef IN
#undef SEAM
}
#endif

#ifdef MULTIK
template <int PH> __global__ void __launch_bounds__(NTHR, 2) k_phase(Args args, int layer) {
    extern __shared__ __attribute__((aligned(16))) unsigned char lds_raw[];
    Frame F; F.lds = (LAS unsigned char*)lds_raw;
    F.tid = threadIdx.x; F.lane = F.tid & 63; F.wave = __builtin_amdgcn_readfirstlane(F.tid >> 6);
    F.G = gridDim.x; F.vcu = blockIdx.x;
    run_phase<PH>(F, layer);
}
template <int PH> static void launch_phase(const Args& a, int layer, int grid, hipStream_t stream) {
    static bool attr = false;
    if (!attr) { (void)hipFuncSetAttribute((const void*)k_phase<PH>, hipFuncAttributeMaxDynamicSharedMemorySize, LDS_BYTES); attr = true; }
    hipLaunchKernelGGL(k_phase<PH>, dim3(grid), dim3(NTHR), LDS_BYTES, stream, a, layer);
#ifdef DBL_K
    if (PH == DBL_K) hipLaunchKernelGGL(k_phase<PH>, dim3(grid), dim3(NTHR), LDS_BYTES, stream, a, layer);
#endif
}
#endif
extern "C" void kernel_launch(void* const* d_in, const int* in_sizes, int n_in, void* d_out, int out_size, void* d_ws, size_t ws_size, hipStream_t stream) {
    static int grid = 0;
    if (grid == 0) {
        if (n_in != N_IN || (size_t)out_size != O_END || ws_size < WS_END) { fprintf(stderr, "kernel_launch: shape mismatch n_in %d out %d ws %zu (need %zu)\n", n_in, out_size, ws_size, (size_t)WS_END); grid = -1; return; }
        { const long exp_sz[N_IN] = {(long)NP * DM, (long)NS * DM, 2L * 16 * 512 * 2048, 2L * 16 * 512 * 2048, 16L * 1024 * 512, 16L * 1024 * 512, 16L * 1024 * 64, 16L * 3 * 8192, 16L * 32 * 128 * 128,
                                       2L * DM * A_N, 2L * 16 * 257, 2L * DM * DM, (long)DM * B_N, (long)DM * DM, (long)DM * C_N, 4L * 8192, 32, 32, 128, (long)C_VD * DM,
                                       4L * DM, 4L * DM, 4L * DM * DFF, 4L * DFF * DM, 4L * DM, 4L * DM};
          for (int i = 0; i < N_IN; ++i) if ((long)in_sizes[i] != exp_sz[i]) { fprintf(stderr, "kernel_launch: input %d has %d elements, expected %ld\n", i, in_sizes[i], exp_sz[i]); grid = -1; return; } }
        int dev = 0, cus = 0, per_cu = 0;
        if (hipGetDevice(&dev) != hipSuccess || hipDeviceGetAttribute(&cus, hipDeviceAttributeMultiprocessorCount, dev) != hipSuccess) { grid = -1; return; }
#ifndef MULTIK
        if (hipFuncSetAttribute((const void*)mk_fwd, hipFuncAttributeMaxDynamicSharedMemorySize, LDS_BYTES) != hipSuccess) { grid = -1; return; }
        if (hipOccupancyMaxActiveBlocksPerMultiprocessor(&per_cu, (const void*)mk_fwd, NTHR, LDS_BYTES) != hipSuccess || per_cu < 1) fprintf(stderr, "kernel_launch: occupancy query says %d workgroups per CU\n", per_cu);
#endif
        (void)hipGetLastError();
        grid = cus;
        if (grid != 256) { fprintf(stderr, "kernel_launch: built for a 256-CU device (split-K deal), found %d CUs; nothing launched\n", grid); grid = -1; return; }
    }
    if (grid < 0) return;
    (void)hipMemsetAsync((char*)d_ws + WS_CTL, 0, CTL_ZERO_BYTES, stream);
    Args a{};
    for (int i = 0; i < N_IN; ++i) a.in[i] = (const float*)d_in[i];
    a.out = (float*)d_out; a.ws = (unsigned char*)d_ws;
#ifdef MULTIK
    launch_phase<0>(a, 0, grid, stream);
    for (int layer = 0; layer < DEPTH; ++layer) {
        const int kind = layer % 3;
        if (kind == 0) { launch_phase<1>(a, layer, grid, stream); launch_phase<2>(a, layer, grid, stream); }
        else if (kind == 1) { launch_phase<3>(a, layer, grid, stream); launch_phase<4>(a, layer, grid, stream); launch_phase<5>(a, layer, grid, stream); }
        else { launch_phase<6>(a, layer, grid, stream); launch_phase<7>(a, layer, grid, stream); launch_phase<8>(a, layer, grid, stream); }
        launch_phase<9>(a, layer, grid, stream); launch_phase<10>(a, layer, grid, stream); launch_phase<11>(a, layer, grid, stream); launch_phase<12>(a, layer, grid, stream); launch_phase<13>(a, layer, grid, stream);
    }
    return;
#else
    if (MK_SINGLE) { a.ph_lo = 0; a.ph_hi = 1 + 8 * DEPTH; hipLaunchKernelGGL(mk_fwd, dim3(grid), dim3(NTHR), LDS_BYTES, stream, a); }
    else for (int ph = 0; ph < 1 + 8 * DEPTH; ++ph) { if (ph == 3 || ph == 27) continue; a.ph_lo = ph; a.ph_hi = ph + 1; hipLaunchKernelGGL(mk_fwd, dim3(grid), dim3(NTHR), LDS_BYTES, stream, a); }
#endif
}
```
